# Optimizing an MI355X kernel written in HIP

```python
import jax
import jax.numpy as jnp
from jax import lax
import numpy as np

D_MODEL = 1024
BATCH = 8
SEQ = 4096
DEPTH = 2

N_EVEN = (DEPTH + 1) // 2
N_ODD = DEPTH // 2
D_FF = 2816
GROUP_W = D_MODEL // 2
MIX_W = 2 * GROUP_W
EPS = 1e-6

RET_HEADS = 4
RET_DK = GROUP_W // RET_HEADS
RET_DV = GROUP_W // RET_HEADS
RET_CHUNK = 128
ROPE_BASE = 10000.0

GLA_HEADS = 4
GLA_DK = GROUP_W // (2 * GLA_HEADS)
GLA_DV = GROUP_W // GLA_HEADS
GLA_RANK = 16
GLA_TAU = 16.0
GLA_CHUNK = 64

LRU_W = GROUP_W
LRU_BLOCKS = 8
LRU_BS = LRU_W // LRU_BLOCKS
LRU_C = 8.0
CONV_W = 4

ML_HEADS = 4
ML_DH = GROUP_W // ML_HEADS
ML_CHUNK = 128

EVEN_SPLITS = (RET_HEADS * RET_DK, RET_HEADS * RET_DK, RET_HEADS * RET_DV, RET_HEADS * RET_DV,
               GLA_HEADS * GLA_DK, GLA_HEADS * GLA_DK, GLA_HEADS * GLA_DV, GLA_HEADS * GLA_DV, GLA_RANK)
EVEN_IN = sum(EVEN_SPLITS)
ODD_SPLITS = (LRU_W, LRU_W, GROUP_W, GROUP_W, GROUP_W, ML_HEADS, ML_HEADS)
ODD_IN = sum(ODD_SPLITS)

kernel_name = 'hybrid_retnet_gla_rglru_mlstm_macaron'


def rmsnorm(x, w):
    xf = x.astype(jnp.float32)
    y = xf * lax.rsqrt(jnp.mean(xf * xf, axis=-1, keepdims=True) + EPS)
    return (y * w.astype(jnp.float32)).astype(x.dtype)


def head_rms(x):
    xf = x.astype(jnp.float32)
    return xf * lax.rsqrt(jnp.mean(xf * xf, axis=-1, keepdims=True) + EPS)


def swiglu(x, w_gu, w_down):
    g, u = jnp.split(x @ w_gu, 2, axis=-1)
    return (jax.nn.silu(g) * u) @ w_down


def split_cols(y, sizes):
    return jnp.split(y, np.cumsum(sizes)[:-1].tolist(), axis=-1)


def to_chunks(x, chunk):
    B, S, H, d = x.shape
    return x.reshape(B, S // chunk, chunk, H, d).transpose(0, 3, 1, 2, 4)


def from_chunks(x):
    B, H, N, L, d = x.shape
    return x.transpose(0, 2, 3, 1, 4).reshape(B, N * L, H, d)


def scan_states(decay, upd):
    def step(s, du):
        d, u = du
        return d * s + u, s
    _, states = lax.scan(step, jnp.zeros_like(upd[0]), (decay, upd))
    return states


def rotary(x, pos):
    half = x.shape[-1] // 2
    inv = ROPE_BASE ** (-jnp.arange(half, dtype=jnp.float32) / half)
    ang = pos.astype(jnp.float32)[:, None] * inv[None, :]
    cos = jnp.cos(ang)[None, :, None, :]
    sin = jnp.sin(ang)[None, :, None, :]
    x1, x2 = x[..., :half], x[..., half:]
    return jnp.concatenate([x1 * cos - x2 * sin, x1 * sin + x2 * cos], axis=-1)


def causal_dwconv(x, w, b):
    out = lax.conv_general_dilated(x, w[:, None, :].astype(x.dtype), window_strides=(1,),
                                   padding=[(CONV_W - 1, 0)], dimension_numbers=('NWC', 'WIO', 'NWC'),
                                   feature_group_count=x.shape[-1])
    return out + b.astype(x.dtype)


def retention(q, k, v):
    B, S, H, _ = q.shape
    L = RET_CHUNK
    N = S // L
    log_g = jnp.log1p(-jnp.exp2(-5.0 - jnp.arange(H, dtype=jnp.float32)))
    qc, kc, vc = to_chunks(q, L), to_chunks(k, L), to_chunks(v, L)
    idx = jnp.arange(L, dtype=jnp.float32)
    rel = idx[:, None] - idx[None, :]
    causal = rel >= 0
    dmat = jnp.where(causal, jnp.exp(log_g[:, None, None] * jnp.where(causal, rel, 0.0)), 0.0)
    s = jnp.einsum('bhnld,bhnsd->bhnls', qc, kc) * dmat[None, :, None]
    intra = jnp.einsum('bhnls,bhnsv->bhnlv', s, vc)
    w_end = jnp.exp(log_g[:, None] * (L - 1.0 - idx)[None, :])
    upd = jnp.einsum('bhnsd,hs,bhnsv->nbhdv', kc, w_end, vc)
    decay = jnp.broadcast_to(jnp.exp(log_g * L)[None, None, :, None, None], (N, 1, H, 1, 1))
    states = scan_states(decay, upd)
    w_in = jnp.exp(log_g[:, None] * (idx + 1.0)[None, :])
    inter = jnp.einsum('bhnld,nbhdv->bhnlv', qc, states) * w_in[None, :, None, :, None]
    return from_chunks(intra + inter)


def gla(q, k, v, log_a):
    B, S, H, _ = q.shape
    L = GLA_CHUNK
    qc, kc, vc, gc = to_chunks(q, L), to_chunks(k, L), to_chunks(v, L), to_chunks(log_a, L)
    b = jnp.cumsum(gc, axis=3)
    b_mid = b[:, :, :, L // 2 - 1:L // 2]
    causal = jnp.tril(jnp.ones((L, L), dtype=bool))
    s = jnp.einsum('bhnld,bhnsd->bhnls', qc * jnp.exp(b - b_mid), kc * jnp.exp(b_mid - b))
    s = jnp.where(causal, s, 0.0)
    intra = jnp.einsum('bhnls,bhnsv->bhnlv', s, vc)
    b_end = b[:, :, :, -1:]
    upd = jnp.einsum('bhnsd,bhnsv->nbhdv', kc * jnp.exp(b_end - b), vc)
    decay = jnp.exp(b_end[:, :, :, 0]).transpose(2, 0, 1, 3)[..., None]
    states = scan_states(decay, upd)
    inter = jnp.einsum('bhnld,nbhdv->bhnlv', qc * jnp.exp(b), states)
    return from_chunks(intra + inter)


def rg_lru(xc, w_a, b_a, w_x, b_x, lam):
    B, S, C = xc.shape
    xb = xc.reshape(B, S, LRU_BLOCKS, LRU_BS)
    r = jax.nn.sigmoid(jnp.einsum('bsgi,gij->bsgj', xb, w_a).reshape(B, S, C) + b_a)
    i = jax.nn.sigmoid(jnp.einsum('bsgi,gij->bsgj', xb, w_x).reshape(B, S, C) + b_x)
    log_a = -LRU_C * r * jax.nn.softplus(-lam)
    a = jnp.exp(log_a)
    u = jnp.sqrt(-jnp.expm1(2.0 * log_a)) * (i * xc)

    def combine(left, right):
        a1, b1 = left
        a2, b2 = right
        return a1 * a2, a2 * b1 + b2

    _, h = lax.associative_scan(combine, (a, u), axis=1)
    return h


def mlstm(q, k, v, i_pre, f_pre):
    B, S, H, _ = q.shape
    L = ML_CHUNK
    N = S // L
    qc, kc, vc = to_chunks(q, L), to_chunks(k, L), to_chunks(v, L)
    ic = i_pre.reshape(B, N, L, H).transpose(0, 3, 1, 2)
    bc = jnp.cumsum(jax.nn.log_sigmoid(f_pre).reshape(B, N, L, H).transpose(0, 3, 1, 2), axis=-1)
    causal = jnp.tril(jnp.ones((L, L), dtype=bool))
    log_w = jnp.where(causal, bc[..., :, None] - bc[..., None, :] + ic[..., None, :], -jnp.inf)
    m_intra = jnp.max(log_w, axis=-1)
    b_end = bc[..., -1]
    a = b_end[..., None] - bc + ic
    a_max = jnp.max(a, axis=-1)
    w_end = jnp.exp(a - a_max[..., None])
    upd_c = jnp.einsum('bhns,bhnsd,bhnsv->nbhdv', w_end, kc, vc)
    upd_n = jnp.einsum('bhns,bhnsd->nbhd', w_end, kc)

    def step(carry, xs):
        c, n, m = carry
        uc, un, be, am = xs
        m_new = jnp.maximum(be + m, am)
        g_old = jnp.exp(be + m - m_new)
        g_new = jnp.exp(am - m_new)
        c_new = g_old[..., None, None] * c + g_new[..., None, None] * uc
        n_new = g_old[..., None] * n + g_new[..., None] * un
        return (c_new, n_new, m_new), (c, n, m)

    init = (jnp.zeros_like(upd_c[0]), jnp.zeros_like(upd_n[0]), jnp.zeros_like(b_end[:, :, 0]))
    _, (cs, ns, ms) = lax.scan(step, init, (upd_c, upd_n, b_end.transpose(2, 0, 1), a_max.transpose(2, 0, 1)))
    m_inter = bc + ms.transpose(1, 2, 0)[..., None]
    m_t = jnp.maximum(m_inter, m_intra)
    s = jnp.einsum('bhnld,bhnsd->bhnls', qc, kc) * jnp.exp(log_w - m_t[..., None])
    w_inter = jnp.exp(m_inter - m_t)
    num = jnp.einsum('bhnls,bhnsv->bhnlv', s, vc) + w_inter[..., None] * jnp.einsum('bhnld,nbhdv->bhnlv', qc, cs)
    den = jnp.sum(s, axis=-1) + w_inter * jnp.einsum('bhnld,nbhd->bhnl', qc, ns)
    h = num / jnp.maximum(jnp.abs(den), jnp.exp(-m_t))[..., None]
    return from_chunks(h)


def even_mixer(hn, w_in, w_lr_up, b_lr, head_norm_w, w_out):
    B, S, _ = hn.shape
    f32 = lambda t: t.astype(jnp.float32)
    rq, rk, rv, rg, gq, gk, gv, gg, glr = split_cols(hn @ w_in, EVEN_SPLITS)
    pos = jnp.arange(S)
    rq = rotary(f32(rq).reshape(B, S, RET_HEADS, RET_DK), pos)
    rk = rotary(f32(rk).reshape(B, S, RET_HEADS, RET_DK), pos) * (RET_DK ** -0.5)
    ret = retention(rq, rk, f32(rv).reshape(B, S, RET_HEADS, RET_DV))
    log_a = jax.nn.log_sigmoid(f32(glr) @ f32(w_lr_up) + f32(b_lr)) / GLA_TAU
    go = gla(f32(gq).reshape(B, S, GLA_HEADS, GLA_DK),
             f32(gk).reshape(B, S, GLA_HEADS, GLA_DK) * (GLA_DK ** -0.5),
             f32(gv).reshape(B, S, GLA_HEADS, GLA_DV),
             log_a.reshape(B, S, GLA_HEADS, GLA_DK))
    o = jnp.concatenate([head_rms(ret).reshape(B, S, -1) * jax.nn.silu(f32(rg)),
                         head_rms(go).reshape(B, S, -1) * jax.nn.silu(f32(gg))], axis=-1)
    o = o * f32(head_norm_w)
    return o.astype(hn.dtype) @ w_out


def odd_mixer(hn, w_in, lru_conv_w, lru_conv_b, lru_wa, lru_ba, lru_wx, lru_bx, lru_lambda,
              ml_conv_w, ml_conv_b, ml_wq, ml_wk, ml_bi, ml_bf, ml_norm_w, w_out):
    B, S, _ = hn.shape
    f32 = lambda t: t.astype(jnp.float32)
    ly, lx, mu, mv, mo, mi, mf = split_cols(hn @ w_in, ODD_SPLITS)
    lxc = causal_dwconv(f32(lx), f32(lru_conv_w), lru_conv_b)
    lru = rg_lru(lxc, f32(lru_wa), f32(lru_ba), f32(lru_wx), f32(lru_bx), f32(lru_lambda))
    lru = lru * jax.nn.gelu(f32(ly))
    mc = jax.nn.silu(causal_dwconv(f32(mu), f32(ml_conv_w), ml_conv_b)).reshape(B, S, ML_HEADS, ML_DH)
    q = jnp.einsum('bshi,hij->bshj', mc, f32(ml_wq))
    k = jnp.einsum('bshi,hij->bshj', mc, f32(ml_wk)) * (ML_DH ** -0.5)
    hm = mlstm(q, k, f32(mv).reshape(B, S, ML_HEADS, ML_DH), f32(mi) + f32(ml_bi), f32(mf) + f32(ml_bf))
    hm = jax.nn.sigmoid(f32(mo)).reshape(B, S, ML_HEADS, ML_DH) * hm
    hm = head_rms(hm).reshape(B, S, -1) * f32(ml_norm_w)
    o = jnp.concatenate([lru, hm], axis=-1)
    return o.astype(hn.dtype) @ w_out


def setup_inputs(seed: int = 0) -> dict:
    key = jax.random.key(seed)
    ks = jax.random.split(key, 40)
    nrm = lambda k, shape, scale: jax.random.normal(k, shape, dtype=jnp.float32) * scale
    gain = lambda k, shape: 1.0 + 0.02 * jax.random.normal(k, shape, dtype=jnp.float32)
    a8 = jax.random.uniform(ks[30], (N_ODD, LRU_W), minval=0.9, maxval=0.999, dtype=jnp.float32)
    a1 = a8 ** (1.0 / LRU_C)
    lam = jnp.log(a1) - jnp.log1p(-a1)
    bf = jnp.broadcast_to(jnp.linspace(3.0, 6.0, ML_HEADS, dtype=jnp.float32), (N_ODD, ML_HEADS))
    return {
        'x': nrm(ks[0], (BATCH, SEQ, D_MODEL), 1.0),
        'ffn1_norm': gain(ks[1], (DEPTH, D_MODEL)),
        'ffn1_wgu': nrm(ks[2], (DEPTH, D_MODEL, 2 * D_FF), D_MODEL ** -0.5),
        'ffn1_wd': nrm(ks[3], (DEPTH, D_FF, D_MODEL), D_FF ** -0.5),
        'mix_norm': gain(ks[4], (DEPTH, D_MODEL)),
        'ffn2_norm': gain(ks[5], (DEPTH, D_MODEL)),
        'ffn2_wgu': nrm(ks[6], (DEPTH, D_MODEL, 2 * D_FF), D_MODEL ** -0.5),
        'ffn2_wd': nrm(ks[7], (DEPTH, D_FF, D_MODEL), D_FF ** -0.5),
        'e_w_in': nrm(ks[8], (N_EVEN, D_MODEL, EVEN_IN), D_MODEL ** -0.5),
        'e_w_lr_up': nrm(ks[9], (N_EVEN, GLA_RANK, GLA_HEADS * GLA_DK), GLA_RANK ** -0.5),
        'e_b_lr': nrm(ks[10], (N_EVEN, GLA_HEADS * GLA_DK), 0.1),
        'e_head_norm': gain(ks[11], (N_EVEN, MIX_W)),
        'e_w_out': nrm(ks[12], (N_EVEN, MIX_W, D_MODEL), MIX_W ** -0.5),
        'o_w_in': nrm(ks[13], (N_ODD, D_MODEL, ODD_IN), D_MODEL ** -0.5),
        'o_lru_conv_w': nrm(ks[14], (N_ODD, CONV_W, LRU_W), CONV_W ** -0.5),
        'o_lru_conv_b': nrm(ks[15], (N_ODD, LRU_W), 0.01),
        'o_lru_wa': nrm(ks[16], (N_ODD, LRU_BLOCKS, LRU_BS, LRU_BS), LRU_BS ** -0.5),
        'o_lru_ba': nrm(ks[17], (N_ODD, LRU_W), 0.01),
        'o_lru_wx': nrm(ks[18], (N_ODD, LRU_BLOCKS, LRU_BS, LRU_BS), LRU_BS ** -0.5),
        'o_lru_bx': nrm(ks[19], (N_ODD, LRU_W), 0.01),
        'o_lru_lambda': lam,
        'o_ml_conv_w': nrm(ks[20], (N_ODD, CONV_W, GROUP_W), CONV_W ** -0.5),
        'o_ml_conv_b': nrm(ks[21], (N_ODD, GROUP_W), 0.01),
        'o_ml_wq': nrm(ks[22], (N_ODD, ML_HEADS, ML_DH, ML_DH), ML_DH ** -0.5),
        'o_ml_wk': nrm(ks[23], (N_ODD, ML_HEADS, ML_DH, ML_DH), ML_DH ** -0.5),
        'o_ml_bi': nrm(ks[24], (N_ODD, ML_HEADS), 0.1),
        'o_ml_bf': bf + nrm(ks[25], (N_ODD, ML_HEADS), 0.01),
        'o_ml_norm': gain(ks[26], (N_ODD, GROUP_W)),
        'o_w_out': nrm(ks[27], (N_ODD, MIX_W, D_MODEL), MIX_W ** -0.5),
        'final_norm': gain(ks[28], (D_MODEL,)),
    }


def reference(x, ffn1_norm, ffn1_wgu, ffn1_wd, mix_norm, ffn2_norm, ffn2_wgu, ffn2_wd,
              e_w_in, e_w_lr_up, e_b_lr, e_head_norm, e_w_out,
              o_w_in, o_lru_conv_w, o_lru_conv_b, o_lru_wa, o_lru_ba, o_lru_wx, o_lru_bx, o_lru_lambda,
              o_ml_conv_w, o_ml_conv_b, o_ml_wq, o_ml_wk, o_ml_bi, o_ml_bf, o_ml_norm, o_w_out,
              final_norm):
    h = x
    for layer in range(DEPTH):
        h = h + 0.5 * swiglu(rmsnorm(h, ffn1_norm[layer]), ffn1_wgu[layer], ffn1_wd[layer])
        hn = rmsnorm(h, mix_norm[layer])
        j = layer // 2
        if layer % 2 == 0:
            h = h + even_mixer(hn, e_w_in[j], e_w_lr_up[j], e_b_lr[j], e_head_norm[j], e_w_out[j])
        else:
            h = h + odd_mixer(hn, o_w_in[j], o_lru_conv_w[j], o_lru_conv_b[j], o_lru_wa[j], o_lru_ba[j],
                              o_lru_wx[j], o_lru_bx[j], o_lru_lambda[j], o_ml_conv_w[j], o_ml_conv_b[j],
                              o_ml_wq[j], o_ml_wk[j], o_ml_bi[j], o_ml_bf[j], o_ml_norm[j], o_w_out[j])
        h = h + 0.5 * swiglu(rmsnorm(h, ffn2_norm[layer]), ffn2_wgu[layer], ffn2_wd[layer])
    return rmsnorm(h, final_norm)
```

```cpp
#include <hip/hip_runtime.h>
#include <hip/hip_cooperative_groups.h>
#include <cstdio>
namespace cg = cooperative_groups;
#ifndef MK_N_LAUNCHES
#define MK_N_LAUNCHES 20
#endif
#ifndef PH_MASK
#define PH_MASK 0xFFFF
#endif
#ifndef EXPER
#define EXPER 0
#endif
namespace pg8 {
#define PG8_LAS __attribute__((address_space(3)))
typedef unsigned short bf16_t;
typedef short bf16x8 __attribute__((ext_vector_type(8)));
typedef float f32x4 __attribute__((ext_vector_type(4)));
typedef unsigned u32x4 __attribute__((ext_vector_type(4)));
constexpr int BM = 256, BK = 64, HALF = 128, HTB = HALF * BK * 2  , STAGE_BYTES = 8 * HTB, NXCD = 8, WGM = 8;

__host__ __device__ __forceinline__ int lds_byte(int r, int c) { const int st = (r >> 4) * 2 + (c >> 5), rr = r & 15, cc = c & 31, ob = rr * 64 + cc * 2; return st * 1024 + (ob ^ (((ob >> 9) & 1) << 5)); }
__host__ __device__ __forceinline__ void stage_rc(int b, int& R, int& C) { const int st = b / 1024, sb = b % 1024, swz = sb ^ (((sb >> 9) & 1) << 5); R = (st >> 1) * 16 + swz / 64; C = (st & 1) * 32 + (swz % 64) / 2; }
__host__ __device__ __forceinline__ int perm32(int rho) { const int n = rho >> 4, i = rho & 15; return 8 * (i >> 2) + 4 * n + (i & 3); }

struct Unit { int pm, pn; };
struct Gemm { const bf16_t* A; const bf16_t* Bt; int M, N, K; };

struct StaticOrder {
    int nM, nN, nwg, G, c;
    __host__ __device__ void init(int M, int N, int G_, int c_) { nM = M / BM; nN = N / BM; nwg = nM * nN; G = G_; c = c_; }
    __host__ __device__ bool next(int i, Unit& u) const {
        const long L = (long)i * G + c; if (L >= nwg) return false;
        int wgid = (int)L; { const int q = nwg / NXCD, r = nwg % NXCD, xcd = wgid % NXCD, off = wgid / NXCD; wgid = (xcd < r ? xcd * (q + 1) : r * (q + 1) + (xcd - r) * q) + off; }
        const int nig = WGM * nN, gid = wgid / nig, fm = gid * WGM, gsz = (nM - fm) < WGM ? (nM - fm) : WGM;
        u.pm = fm + ((wgid % nig) % gsz); u.pn = (wgid % nig) / gsz; return true;
    }
    __device__ __forceinline__ void a_ready(const Unit&) const {}
    __device__ __forceinline__ void done(const Unit&) const {}
};
__device__ __forceinline__ unsigned cvt_pk_bf16(float lo, float hi) { unsigned r; asm volatile("v_cvt_pk_bf16_f32 %0, %1, %2" : "=v"(r) : "v"(lo), "v"(hi)); return r; }
typedef float f32x2 __attribute__((ext_vector_type(2)));
template <class Epi, class Sched, bool STAMP = false>
__device__ __forceinline__ void gemm_phase(PG8_LAS unsigned char* lds, const Gemm g, const Sched& S, const Epi& E, unsigned long long* stamps) {
    const int tid = threadIdx.x, wid = __builtin_amdgcn_readfirstlane(tid >> 6), lane = tid & 63, wr = wid >> 2, wc = wid & 3, fr = lane & 15, fq = lane >> 4;
    const int K = g.K, nt = K / BK;
    int ts_lo = 0, ts_hi = 0, nts = 0; const unsigned long long rt_entry = STAMP ? (unsigned long long)wall_clock64() : 0ull;
#define PG8_STAMP() do { if (STAMP && wid == 0 && nts < 64) { const unsigned long long _c = (unsigned long long)clock64(); \
        ts_lo = (lane == nts) ? (int)(unsigned)_c : ts_lo; ts_hi = (lane == nts) ? (int)(unsigned)(_c >> 32) : ts_hi; ++nts; } } while (0)
    PG8_STAMP();
    unsigned voffA[2], voffB[2];
#pragma unroll
    for (int i = 0; i < 2; ++i) { int R, C; stage_rc(tid * 16 + i * 8192, R, C); const int Rb = Epi::PERM ? ((R & ~31) + perm32(R & 31)) : R;
        voffA[i] = (unsigned)(R * K + C) * 2u; voffB[i] = (unsigned)(Rb * K + C) * 2u; }
    const size_t kstep = (size_t)(BK * 2);
    const size_t hstep = (size_t)HALF * K * 2;
    const size_t tstep = 2 * hstep;
    const unsigned ldsw = (unsigned)wid * 1024u;
    const int aoff = lds_byte(wr * 64 + fr, fq * 8), boff = lds_byte(wc * 32 + fr, fq * 8);
#define PG8_SA(b, h) (((b) * 2 + (h)) * HTB)
#define PG8_SB(b, h) ((4 + (b) * 2 + (h)) * HTB)
#define PG8_STAGE(bufoff, gbase, voff) do { _Pragma("unroll") for (int _i = 0; _i < 2; ++_i) \
        __builtin_amdgcn_global_load_lds((const unsigned*)((const char*)(gbase) + (voff)[_i]), (PG8_LAS unsigned*)(lds + (bufoff) + ldsw + _i * 8192), 16, 0, 0); } while (0)
#define PG8_LDA(dst, b, h) do { _Pragma("unroll") for (int m = 0; m < 4; ++m) _Pragma("unroll") for (int k = 0; k < 2; ++k) dst[m][k] = *(const PG8_LAS bf16x8*)(lds + PG8_SA(b, h) + aoff + m * 2048 + k * 1024); } while (0)
#define PG8_LDB(dst, b, h) do { _Pragma("unroll") for (int n = 0; n < 2; ++n) _Pragma("unroll") for (int k = 0; k < 2; ++k) dst[n][k] = *(const PG8_LAS bf16x8*)(lds + PG8_SB(b, h) + boff + n * 2048 + k * 1024); } while (0)
#define PG8_MMA(ai, bj, At, Bt) do { __builtin_amdgcn_s_setprio(1); _Pragma("unroll") for (int m = 0; m < 4; ++m) _Pragma("unroll") for (int n = 0; n < 2; ++n) _Pragma("unroll") for (int k = 0; k < 2; ++k) \
        acc[ai][bj][m][n] = __builtin_amdgcn_mfma_f32_16x16x32_bf16(Bt[n][k], At[m][k], acc[ai][bj][m][n], 0, 0, 0); __builtin_amdgcn_s_setprio(0); } while (0)
#define PG8_WAIT_V(n) asm volatile("s_waitcnt vmcnt(" #n ")" ::: "memory")
#define PG8_WAIT_L(n) asm volatile("s_waitcnt lgkmcnt(" #n ")" ::: "memory")
#define PG8_BAR __builtin_amdgcn_s_barrier()
#define PG8_SCHED __builtin_amdgcn_sched_barrier(0)
    Unit cur, nxt; int ui = 0;
    if (!S.next(0, cur)) return;
    f32x4 acc[2][2][4][2];
#pragma unroll
    for (int a = 0; a < 2; ++a)
#pragma unroll
        for (int b = 0; b < 2; ++b)
#pragma unroll
            for (int m = 0; m < 4; ++m)
#pragma unroll
                for (int n = 0; n < 2; ++n) acc[a][b][m][n] = (f32x4){0.f, 0.f, 0.f, 0.f};
    bf16x8 At[4][2], B0[2][2], B1[2][2];
    const char* cA = (const char*)g.A + (size_t)cur.pm * tstep; const char* cB = (const char*)g.Bt + (size_t)cur.pn * tstep;
    S.a_ready(cur);
    PG8_STAGE(PG8_SB(0, 0), cB, voffB); PG8_STAGE(PG8_SA(0, 0), cA, voffA); PG8_STAGE(PG8_SB(0, 1), cB + hstep, voffB); PG8_STAGE(PG8_SA(0, 1), cA + hstep, voffA);
    if (wr == 1) PG8_BAR;
    PG8_WAIT_V(4); PG8_BAR;
    PG8_STAGE(PG8_SB(1, 0), cB + kstep, voffB); PG8_STAGE(PG8_SA(1, 0), cA + kstep, voffA); PG8_STAGE(PG8_SB(1, 1), cB + hstep + kstep, voffB);
    PG8_WAIT_V(6); PG8_BAR;
    PG8_STAMP();
    for (;;) {
        const bool has_next = S.next(ui + 1, nxt);
        const char* nA = has_next ? (const char*)g.A + (size_t)nxt.pm * tstep : cA; const char* nB = has_next ? (const char*)g.Bt + (size_t)nxt.pn * tstep : cB;
        for (int t = 0; t < nt; t += 2) {
            const bool last = (t == nt - 2);
            const char* a1 = cA + (size_t)(t + 1) * kstep;
            const char* a2 = last ? nA : cA + (size_t)(t + 2) * kstep; const char* b2 = last ? nB : cB + (size_t)(t + 2) * kstep;
            const char* a3 = a2 + kstep; const char* b3 = b2 + kstep;
            if (last && has_next) S.a_ready(nxt);
            PG8_LDB(B0, 0, 0); PG8_SCHED; PG8_LDA(At, 0, 0); PG8_STAGE(PG8_SA(1, 1), a1 + hstep, voffA);
            PG8_WAIT_L(8); PG8_BAR; PG8_WAIT_L(0); PG8_MMA(0, 0, At, B0); PG8_BAR; PG8_SCHED;
            PG8_LDB(B1, 0, 1); PG8_STAGE(PG8_SB(0, 0), b2, voffB);
            PG8_BAR; PG8_WAIT_L(0); PG8_MMA(0, 1, At, B1); PG8_BAR;
            PG8_LDA(At, 0, 1); PG8_STAGE(PG8_SA(0, 0), a2, voffA);
            PG8_BAR; PG8_WAIT_L(0); PG8_MMA(1, 0, At, B0); PG8_BAR; PG8_SCHED;
            PG8_STAGE(PG8_SB(0, 1), b2 + hstep, voffB);
            PG8_WAIT_V(6); PG8_BAR; PG8_MMA(1, 1, At, B1); PG8_BAR;
            PG8_LDB(B0, 1, 0); PG8_SCHED; PG8_LDA(At, 1, 0); PG8_STAGE(PG8_SA(0, 1), a2 + hstep, voffA);
            PG8_WAIT_L(8); PG8_BAR; PG8_WAIT_L(0); PG8_MMA(0, 0, At, B0); PG8_BAR; PG8_SCHED;
            PG8_LDB(B1, 1, 1); PG8_STAGE(PG8_SB(1, 0), b3, voffB);
            PG8_BAR; PG8_WAIT_L(0); PG8_MMA(0, 1, At, B1); PG8_BAR;
            PG8_LDA(At, 1, 1); PG8_STAGE(PG8_SA(1, 0), a3, voffA);
            PG8_BAR; PG8_WAIT_L(0); PG8_MMA(1, 0, At, B0); PG8_BAR; PG8_SCHED;
            PG8_STAGE(PG8_SB(1, 1), b3 + hstep, voffB);
            PG8_WAIT_V(6); PG8_BAR; PG8_MMA(1, 1, At, B1); PG8_BAR;
        }
        PG8_STAMP();
        if constexpr (!Epi::AFTER_DRAIN) { E(acc, cur, wr, wc, fr, fq); S.done(cur); }
        PG8_STAMP();
        if (!has_next) break;
#pragma unroll
        for (int a = 0; a < 2; ++a)
#pragma unroll
            for (int b = 0; b < 2; ++b)
#pragma unroll
                for (int m = 0; m < 4; ++m)
#pragma unroll
                    for (int n = 0; n < 2; ++n) acc[a][b][m][n] = (f32x4){0.f, 0.f, 0.f, 0.f};
        cur = nxt; cA = nA; cB = nB; ++ui;
    }
    PG8_WAIT_V(0);
    if (wr == 0) PG8_BAR;
    PG8_BAR;
    if constexpr (Epi::AFTER_DRAIN) { E.fused(acc, cur, wr, wc, fr, fq, lds, wid, lane); S.done(cur); }
    PG8_STAMP();
    if (STAMP && wid == 0) { stamps[lane] = lane < nts ? (((unsigned long long)(unsigned)ts_hi << 32) | (unsigned)ts_lo) : 0ull;
        if (lane == 62) stamps[62] = rt_entry; if (lane == 63) stamps[63] = (unsigned long long)wall_clock64(); }
#undef PG8_STAMP
#undef PG8_SA
#undef PG8_SB
#undef PG8_STAGE
#undef PG8_LDA
#undef PG8_LDB
#undef PG8_MMA
#undef PG8_WAIT_V
#undef PG8_WAIT_L
#undef PG8_BAR
#undef PG8_SCHED
}
}

using pg8::bf16_t; using pg8::bf16x8; using pg8::f32x4; using pg8::u32x4;
typedef unsigned u32x2 __attribute__((ext_vector_type(2)));
#define LAS __attribute__((address_space(3)))
typedef LAS unsigned char* ldsp_t;

constexpr int M = 32768, NPE = 3840, NPO = 2816;
constexpr float EPS = 1e-6f;
constexpr int LDS_BYTES = 135168;

constexpr size_t SZ_WGU = (size_t)5632 * 1024 * 2, SZ_WD = (size_t)1024 * 2816 * 2;
constexpr size_t WS_WGU = 0;
constexpr size_t WS_WD = WS_WGU + 4 * SZ_WGU;
constexpr size_t WS_EWIN = WS_WD + 4 * SZ_WD;
constexpr size_t WS_OWIN = WS_EWIN + (size_t)NPE * 1024 * 2;
constexpr size_t WS_EWOUT = WS_OWIN + (size_t)NPO * 1024 * 2;
constexpr size_t WS_OWOUT = WS_EWOUT + (size_t)1024 * 1024 * 2;
constexpr size_t WS_MLQK = WS_OWOUT + (size_t)1024 * 1024 * 2;
constexpr size_t WS_ROPE = WS_MLQK + (size_t)1024 * 512 * 2;
constexpr size_t WS_SS = WS_ROPE + (size_t)2 * 4096 * 64 * 4;
constexpr size_t WS_DEN = WS_SS + (size_t)7 * 16 * M * 4;
constexpr size_t WS_EN = WS_DEN + (size_t)M * 4 * 4;
constexpr size_t WS_XB = WS_EN + (size_t)M * 4 * 4;
constexpr size_t WS_OB = WS_XB + (size_t)M * 1024 * 2;
constexpr size_t WS_R = WS_OB + (size_t)M * 1024 * 2;
constexpr size_t WS_QKB = WS_R + (size_t)M * NPO * 2;
constexpr size_t WS_END = WS_R + (size_t)M * NPE * 2;

struct Params { const float* in[30]; float* out; unsigned char* ws; int ph_lo, ph_hi; };

__device__ __forceinline__ float bflo(unsigned w) { return __uint_as_float(w << 16); }
__device__ __forceinline__ float bfhi(unsigned w) { return __uint_as_float(w & 0xffff0000u); }
__device__ __forceinline__ float bf2f(bf16_t b) { return __uint_as_float(((unsigned)b) << 16); }
__device__ __forceinline__ bf16_t f2bf(float f) { return (bf16_t)(pg8::cvt_pk_bf16(f, 0.f) & 0xffffu); }
__device__ __forceinline__ float sigmoid_f(float x) { return 1.f / (1.f + __expf(-x)); }
__device__ __forceinline__ float silu_f(float x) { return x / (1.f + __expf(-x)); }
__device__ __forceinline__ float logsigmoid_f(float z) { return fminf(z, 0.f) - log1pf(__expf(-fabsf(z))); }
__device__ __forceinline__ void unpack8(const u32x4 w, float (&f)[8]) {
    f[0] = bflo(w.x); f[1] = bfhi(w.x); f[2] = bflo(w.y); f[3] = bfhi(w.y); f[4] = bflo(w.z); f[5] = bfhi(w.z); f[6] = bflo(w.w); f[7] = bfhi(w.w);
}
__device__ __forceinline__ u32x4 pack8(const float (&f)[8]) {
    u32x4 w; w.x = pg8::cvt_pk_bf16(f[0], f[1]); w.y = pg8::cvt_pk_bf16(f[2], f[3]); w.z = pg8::cvt_pk_bf16(f[4], f[5]); w.w = pg8::cvt_pk_bf16(f[6], f[7]); return w;
}

__device__ __forceinline__ float row_rs(const float* ssb, int row) {
    float s = 0.f;
#pragma unroll
    for (int k = 0; k < 16; ++k) s += ssb[(size_t)k * M + row];
    return rsqrtf(s * (1.0f / 1024.0f) + EPS);
}
struct EpiSwiGLU {
    static constexpr bool PERM = true, AFTER_DRAIN = false;
    bf16_t* G; const float* ss;
    __device__ __forceinline__ void operator()(const f32x4 (&acc)[2][2][4][2], const pg8::Unit& u, int wr, int wc, int fr, int fq) const {
        const int row0 = u.pm * 256 + wr * 64 + fr, col0 = u.pn * 128 + wc * 32 + 8 * fq;
#pragma unroll
        for (int ai = 0; ai < 2; ++ai)
#pragma unroll
            for (int m = 0; m < 4; ++m) {
                const int row = row0 + ai * 128 + m * 16;
                const float rs = row_rs(ss, row);
                float o[8];
#pragma unroll
                for (int n = 0; n < 2; ++n)
#pragma unroll
                    for (int j = 0; j < 4; ++j) { const float g = acc[ai][0][m][n][j] * rs, uu = acc[ai][1][m][n][j] * rs; o[n * 4 + j] = silu_f(g) * uu; }
                *(u32x4*)(G + (size_t)row * 2816 + col0) = pack8(o);
            }
    }
};
struct EpiResid {
    static constexpr bool PERM = false, AFTER_DRAIN = false;
    const float* resid; float* hf; bf16_t* xb; float* ssn; float scale;
    __device__ __forceinline__ void operator()(const f32x4 (&acc)[2][2][4][2], const pg8::Unit& u, int wr, int wc, int fr, int fq) const {
        const int row0 = u.pm * 256 + wr * 64 + fr, col0 = u.pn * 256 + wc * 32 + 4 * fq;
#pragma unroll
        for (int ai = 0; ai < 2; ++ai)
#pragma unroll
            for (int m = 0; m < 4; ++m) {
                const int row = row0 + ai * 128 + m * 16;
                float part = 0.f;
#pragma unroll
                for (int bj = 0; bj < 2; ++bj)
#pragma unroll
                    for (int n = 0; n < 2; ++n) {
                        const size_t off = (size_t)row * 1024 + col0 + bj * 128 + n * 16;
                        const f32x4 r = *(const f32x4*)(resid + off);
                        const f32x4 h = r + acc[ai][bj][m][n] * scale;
                        *(f32x4*)(hf + off) = h;
                        u32x2 pk; pk.x = pg8::cvt_pk_bf16(h[0], h[1]); pk.y = pg8::cvt_pk_bf16(h[2], h[3]);
                        *(u32x2*)(xb + off) = pk;
                        part += (h[0] * h[0] + h[1] * h[1]) + (h[2] * h[2] + h[3] * h[3]);
                    }
                part += __shfl_xor(part, 16); part += __shfl_xor(part, 32);
                if (fq == 0) ssn[(size_t)(u.pn * 4 + wc) * M + row] = part;
            }
    }
};
struct EpiProj {
    static constexpr bool PERM = true, AFTER_DRAIN = false;
    bf16_t* P; int ld; const float* ss;
    __device__ __forceinline__ void operator()(const f32x4 (&acc)[2][2][4][2], const pg8::Unit& u, int wr, int wc, int fr, int fq) const {
        const int row0 = u.pm * 256 + wr * 64 + fr, col0 = u.pn * 256 + wc * 32 + 8 * fq;
#pragma unroll
        for (int ai = 0; ai < 2; ++ai)
#pragma unroll
            for (int m = 0; m < 4; ++m) {
                const int row = row0 + ai * 128 + m * 16;
                const float rs = ss ? row_rs(ss, row) : 1.0f;
#pragma unroll
                for (int bj = 0; bj < 2; ++bj) {
                    float o[8];
#pragma unroll
                    for (int n = 0; n < 2; ++n)
#pragma unroll
                        for (int j = 0; j < 4; ++j) o[n * 4 + j] = acc[ai][bj][m][n][j] * rs;
                    *(u32x4*)(P + (size_t)row * ld + col0 + bj * 128) = pack8(o);
                }
            }
    }
};
template <class Epi> __device__ __forceinline__ void run_gemm(ldsp_t lds, const bf16_t* A, const bf16_t* Bt, int N, int K, const Epi& E) {
    pg8::Gemm g{A, Bt, M, N, K}; pg8::StaticOrder S; S.init(M, N, (int)gridDim.x, (int)blockIdx.x);
    pg8::gemm_phase<Epi, pg8::StaticOrder>(lds, g, S, E, nullptr);
}

struct CvtJob { const float* src; const float* scale; bf16_t* dst; int K, N, mode; };
__device__ __forceinline__ void get_job(const Params& p, int j, CvtJob& J) {
    unsigned char* ws = p.ws;
    if (j < 4) { const int l = j >> 1, f = j & 1; J.src = (f ? p.in[6] : p.in[2]) + (size_t)l * 1024 * 5632; J.scale = (f ? p.in[5] : p.in[1]) + l * 1024;
        J.dst = (bf16_t*)(ws + WS_WGU + (size_t)j * SZ_WGU); J.K = 1024; J.N = 5632; J.mode = 1; }
    else if (j < 8) { const int jj = j - 4, l = jj >> 1, f = jj & 1; J.src = (f ? p.in[7] : p.in[3]) + (size_t)l * 2816 * 1024; J.scale = nullptr;
        J.dst = (bf16_t*)(ws + WS_WD + (size_t)jj * SZ_WD); J.K = 2816; J.N = 1024; J.mode = 0; }
    else if (j == 8) { J.src = p.in[8]; J.scale = p.in[4]; J.dst = (bf16_t*)(ws + WS_EWIN); J.K = 1024; J.N = 3600; J.mode = 0; }
    else if (j == 9) { J.src = p.in[13]; J.scale = p.in[4] + 1024; J.dst = (bf16_t*)(ws + WS_OWIN); J.K = 1024; J.N = 2568; J.mode = 0; }
    else if (j == 10) { J.src = p.in[12]; J.scale = nullptr; J.dst = (bf16_t*)(ws + WS_EWOUT); J.K = 1024; J.N = 1024; J.mode = 0; }
    else { J.src = p.in[28]; J.scale = nullptr; J.dst = (bf16_t*)(ws + WS_OWOUT); J.K = 1024; J.N = 1024; J.mode = 0; }
}
__device__ __forceinline__ void phase_prep(const Params& p, ldsp_t lds) {
    const int tid = threadIdx.x, lane = tid & 63, w = tid >> 6;
    LAS float* tb = (LAS float*)lds;
    for (int t = blockIdx.x; t < 10624; t += gridDim.x) {
        int j, tt;
        if (t < 5632) { j = t / 1408; tt = t % 1408; }
        else if (t < 8448) { j = 4 + (t - 5632) / 704; tt = (t - 5632) % 704; }
        else if (t < 9408) { j = 8; tt = t - 8448; }
        else if (t < 10112) { j = 9; tt = t - 9408; }
        else if (t < 10368) { j = 10; tt = t - 10112; }
        else { j = 11; tt = t - 10368; }
        CvtJob J; get_job(p, j, J);
        const int kbn = J.K >> 6, nb = tt / kbn, kb = tt % kbn;
        const int srccol0 = (J.mode == 1) ? (((nb & 3) < 2) ? 128 * (nb >> 2) + 64 * (nb & 3) : 2816 + 128 * (nb >> 2) + 64 * ((nb & 3) - 2)) : 64 * nb;
        {
            const int r = tid >> 4, c4 = (tid & 15) * 4;
#pragma unroll
            for (int i = 0; i < 2; ++i) {
                const int kl = r + 32 * i, k = kb * 64 + kl, col = srccol0 + c4;
                f32x4 v = (f32x4){0.f, 0.f, 0.f, 0.f};
                if (col < J.N) v = *(const f32x4*)(J.src + (size_t)k * J.N + col);
                const float s = J.scale ? J.scale[k] : 1.0f;
                tb[kl * 65 + c4 + 0] = v[0] * s; tb[kl * 65 + c4 + 1] = v[1] * s; tb[kl * 65 + c4 + 2] = v[2] * s; tb[kl * 65 + c4 + 3] = v[3] * s;
            }
        }
        __syncthreads();
        {
            const int nl = tid >> 3, kc = (tid & 7) * 8;
            float o[8];
#pragma unroll
            for (int e = 0; e < 8; ++e) o[e] = tb[(kc + e) * 65 + nl];
            *(u32x4*)(J.dst + (size_t)(nb * 64 + nl) * J.K + kb * 64 + kc) = pack8(o);
        }
        __syncthreads();
    }
    {
        const float* x = p.in[0]; bf16_t* XB = (bf16_t*)(p.ws + WS_XB); float* SS = (float*)(p.ws + WS_SS);
        for (int row = blockIdx.x * 8 + w; row < M; row += gridDim.x * 8) {
            const f32x4* xr = (const f32x4*)(x + (size_t)row * 1024);
            float ss = 0.f;
#pragma unroll
            for (int i = 0; i < 4; ++i) {
                const f32x4 v = xr[lane + 64 * i];
                ss += (v[0] * v[0] + v[1] * v[1]) + (v[2] * v[2] + v[3] * v[3]);
                u32x2 pk; pk.x = pg8::cvt_pk_bf16(v[0], v[1]); pk.y = pg8::cvt_pk_bf16(v[2], v[3]);
                *(u32x2*)(XB + (size_t)row * 1024 + (lane + 64 * i) * 4) = pk;
            }
#pragma unroll
            for (int o = 32; o >= 1; o >>= 1) ss += __shfl_xor(ss, o);
            if (lane < 16) SS[(size_t)lane * M + row] = (lane == 0) ? ss : 0.f;
        }
    }
    {
        float* rc = (float*)(p.ws + WS_ROPE); float* rsn = rc + 4096 * 64;
        for (int i = blockIdx.x * 512 + tid; i < 4096 * 64; i += gridDim.x * 512) {
            const int pos = i >> 6, j = i & 63;
            const float inv = exp2f(-(float)j * (13.287712379549449f / 64.0f));
            double rev = (double)pos * (double)inv * 0.15915494309189535;
            rev -= rint(rev);
            const float r = (float)(rev * 6.283185307179586);
            rc[i] = cosf(r); rsn[i] = sinf(r);
        }
    }
    {
        bf16_t* W = (bf16_t*)(p.ws + WS_MLQK);
        for (int i = blockIdx.x * 512 + tid; i < 1024 * 512; i += gridDim.x * 512) {
            const int n = i >> 9, k = i & 511, h = (n & 511) >> 7, j = n & 127;
            float v = 0.f;
            if ((k >> 7) == h) v = (n < 512) ? p.in[23][h * 16384 + (k & 127) * 128 + j] : p.in[24][h * 16384 + (k & 127) * 128 + j] * 0.08838834764831845f;
            W[i] = f2bf(v);
        }
    }
}

#define MIX_FMA8(S, ka, kb, vv) do { S[0] = fmaf(ka[0], vv, S[0]); S[1] = fmaf(ka[1], vv, S[1]); S[2] = fmaf(ka[2], vv, S[2]); S[3] = fmaf(ka[3], vv, S[3]); \
    S[4] = fmaf(kb[0], vv, S[4]); S[5] = fmaf(kb[1], vv, S[5]); S[6] = fmaf(kb[2], vv, S[6]); S[7] = fmaf(kb[3], vv, S[7]); } while (0)
#define MIX_DOT8(o, S, qa, qb) do { o = qa[0] * S[0]; o = fmaf(qa[1], S[1], o); o = fmaf(qa[2], S[2], o); o = fmaf(qa[3], S[3], o); \
    o = fmaf(qb[0], S[4], o); o = fmaf(qb[1], S[5], o); o = fmaf(qb[2], S[6], o); o = fmaf(qb[3], S[7], o); } while (0)

__device__ __forceinline__ void mix_retention(const Params& p, ldsp_t lds, int item) {
    const int b = item >> 4, h = (item >> 2) & 3, vs = item & 3;
    LAS float* Qs = (LAS float*)lds; LAS float* Ks = Qs + 64 * 128; LAS float* Vs = Ks + 64 * 128; LAS float* Os = Vs + 64 * 32;
    const int tid = threadIdx.x, lane = tid & 63, w = tid >> 6, dg = lane & 15, vl = lane >> 4;
    const int sj = tid >> 3, sc = tid & 7;
    bf16_t* P = (bf16_t*)(p.ws + WS_R);
    const float* ropec = (const float*)(p.ws + WS_ROPE); const float* ropes = ropec + 4096 * 64;
    const float l2g = log2f(1.0f - exp2f(-5.0f - (float)h));
    const float gT = exp2f(64.0f * l2g);
    const float dq = exp2f((float)(sj + 1) * l2g), dkk = exp2f(-(float)(sj + 1) * l2g) * 0.08838834764831845f;
    const bf16_t* qrow = P + ((size_t)b * 4096 + sj) * NPE + h * 128 + sc * 8;
    bf16_t* vrow = P + ((size_t)b * 4096 + (tid >> 2)) * NPE + 1024 + h * 128 + vs * 32 + (tid & 3) * 8;
    float S[8];
#pragma unroll
    for (int i = 0; i < 8; ++i) S[i] = 0.f;
    u32x4 rq1, rq2, rk1, rk2, rv = (u32x4){0u, 0u, 0u, 0u}; f32x4 c0, c1, s0, s1;
#define RET_LOAD(t0) do { const bf16_t* qp_ = qrow + (size_t)(t0) * NPE; rq1 = *(const u32x4*)qp_; rq2 = *(const u32x4*)(qp_ + 64); rk1 = *(const u32x4*)(qp_ + 512); rk2 = *(const u32x4*)(qp_ + 576); \
        if (tid < 256) rv = *(const u32x4*)(vrow + (size_t)(t0) * NPE); \
        const float* cp_ = ropec + ((t0) + sj) * 64 + sc * 8; c0 = *(const f32x4*)cp_; c1 = *(const f32x4*)(cp_ + 4); \
        const float* sp_ = ropes + ((t0) + sj) * 64 + sc * 8; s0 = *(const f32x4*)sp_; s1 = *(const f32x4*)(sp_ + 4); } while (0)
    RET_LOAD(0);
    for (int tile = 0; tile < 64; ++tile) {
        {
            float a[8], bb[8]; f32x4 o1a, o1b, o2a, o2b;
            unpack8(rq1, a); unpack8(rq2, bb);
#pragma unroll
            for (int i = 0; i < 4; ++i) { o1a[i] = (a[i] * c0[i] - bb[i] * s0[i]) * dq; o2a[i] = (a[i] * s0[i] + bb[i] * c0[i]) * dq;
                                          o1b[i] = (a[4 + i] * c1[i] - bb[4 + i] * s1[i]) * dq; o2b[i] = (a[4 + i] * s1[i] + bb[4 + i] * c1[i]) * dq; }
            *(LAS f32x4*)(Qs + sj * 128 + sc * 8) = o1a; *(LAS f32x4*)(Qs + sj * 128 + sc * 8 + 4) = o1b;
            *(LAS f32x4*)(Qs + sj * 128 + 64 + sc * 8) = o2a; *(LAS f32x4*)(Qs + sj * 128 + 64 + sc * 8 + 4) = o2b;
            unpack8(rk1, a); unpack8(rk2, bb);
#pragma unroll
            for (int i = 0; i < 4; ++i) { o1a[i] = (a[i] * c0[i] - bb[i] * s0[i]) * dkk; o2a[i] = (a[i] * s0[i] + bb[i] * c0[i]) * dkk;
                                          o1b[i] = (a[4 + i] * c1[i] - bb[4 + i] * s1[i]) * dkk; o2b[i] = (a[4 + i] * s1[i] + bb[4 + i] * c1[i]) * dkk; }
            *(LAS f32x4*)(Ks + sj * 128 + sc * 8) = o1a; *(LAS f32x4*)(Ks + sj * 128 + sc * 8 + 4) = o1b;
            *(LAS f32x4*)(Ks + sj * 128 + 64 + sc * 8) = o2a; *(LAS f32x4*)(Ks + sj * 128 + 64 + sc * 8 + 4) = o2b;
            if (tid < 256) { float v[8]; unpack8(rv, v);
                *(LAS f32x4*)(Vs + (tid >> 2) * 32 + (tid & 3) * 8) = (f32x4){v[0], v[1], v[2], v[3]}; *(LAS f32x4*)(Vs + (tid >> 2) * 32 + (tid & 3) * 8 + 4) = (f32x4){v[4], v[5], v[6], v[7]}; }
        }
        __syncthreads();
        if (tile + 1 < 64) RET_LOAD((tile + 1) * 64);
        {
            const LAS float* qp = Qs + dg * 8; const LAS float* kp = Ks + dg * 8; const LAS float* vp = Vs + w * 4 + vl; LAS float* op = Os + w * 4 + vl;
#pragma unroll 4
            for (int j = 0; j < 64; ++j) {
                const float vv = vp[j * 32];
                const f32x4 ka = *(const LAS f32x4*)(kp + j * 128), kb = *(const LAS f32x4*)(kp + j * 128 + 4);
                const f32x4 qa = *(const LAS f32x4*)(qp + j * 128), qb = *(const LAS f32x4*)(qp + j * 128 + 4);
                MIX_FMA8(S, ka, kb, vv);
                float o; MIX_DOT8(o, S, qa, qb);
                o += __shfl_xor(o, 1); o += __shfl_xor(o, 2); o += __shfl_xor(o, 4); o += __shfl_xor(o, 8);
                if (dg == 0) op[j * 32] = o;
            }
        }
        __syncthreads();
#pragma unroll
        for (int i = 0; i < 8; ++i) S[i] *= gT;
        if (tid < 256) {
            const f32x4 x0 = *(const LAS f32x4*)(Os + (tid >> 2) * 32 + (tid & 3) * 8), x1 = *(const LAS f32x4*)(Os + (tid >> 2) * 32 + (tid & 3) * 8 + 4);
            const float o[8] = {x0[0], x0[1], x0[2], x0[3], x1[0], x1[1], x1[2], x1[3]};
            *(u32x4*)(vrow + (size_t)(tile * 64) * NPE) = pack8(o);
        }
    }
#undef RET_LOAD
}

__device__ __forceinline__ void mix_gla(const Params& p, ldsp_t lds, int item) {
    const int b = item >> 3, h = (item >> 1) & 3, vs = item & 1;
    LAS float* Qs = (LAS float*)lds; LAS float* Ks = Qs + 4096; LAS float* Vs = Ks + 4096; LAS float* Os = Vs + 4096; LAS float* LA = Os + 4096;
    LAS float* GL = LA + 4096; LAS float* EBE = GL + 1024;
    const int tid = threadIdx.x, lane = tid & 63, w = tid >> 6, dg = lane & 7, vl = lane >> 3;
    const int sj = tid >> 3, sc = tid & 7, d = tid & 63, seg = tid >> 6;
    bf16_t* P = (bf16_t*)(p.ws + WS_R);
    float Wl[16];
#pragma unroll
    for (int r = 0; r < 16; ++r) Wl[r] = p.in[9][r * 256 + h * 64 + d];
    const float bl = p.in[10][h * 64 + d];
    const bf16_t* qrow = P + ((size_t)b * 4096 + sj) * NPE + 2048 + h * 64 + sc * 8;
    bf16_t* vrow = P + ((size_t)b * 4096 + sj) * NPE + 2560 + h * 128 + vs * 64 + sc * 8;
    const bf16_t* grow = P + ((size_t)b * 4096 + (tid >> 1)) * NPE + 3584 + (tid & 1) * 8;
    float S[8];
#pragma unroll
    for (int i = 0; i < 8; ++i) S[i] = 0.f;
    u32x4 rq, rk, rv, rg = (u32x4){0u, 0u, 0u, 0u};
#define GLA_LOAD(t0) do { rq = *(const u32x4*)(qrow + (size_t)(t0) * NPE); rk = *(const u32x4*)(qrow + 256 + (size_t)(t0) * NPE); rv = *(const u32x4*)(vrow + (size_t)(t0) * NPE); \
        if (tid < 128) rg = *(const u32x4*)(grow + (size_t)(t0) * NPE); } while (0)
    GLA_LOAD(0);
    for (int tile = 0; tile < 64; ++tile) {
        {
            float a[8];
            unpack8(rq, a); *(LAS f32x4*)(Qs + sj * 64 + sc * 8) = (f32x4){a[0], a[1], a[2], a[3]}; *(LAS f32x4*)(Qs + sj * 64 + sc * 8 + 4) = (f32x4){a[4], a[5], a[6], a[7]};
            unpack8(rk, a); *(LAS f32x4*)(Ks + sj * 64 + sc * 8) = (f32x4){a[0], a[1], a[2], a[3]} * 0.125f; *(LAS f32x4*)(Ks + sj * 64 + sc * 8 + 4) = (f32x4){a[4], a[5], a[6], a[7]} * 0.125f;
            unpack8(rv, a); *(LAS f32x4*)(Vs + sj * 64 + sc * 8) = (f32x4){a[0], a[1], a[2], a[3]}; *(LAS f32x4*)(Vs + sj * 64 + sc * 8 + 4) = (f32x4){a[4], a[5], a[6], a[7]};
            if (tid < 128) { unpack8(rg, a); *(LAS f32x4*)(GL + (tid >> 1) * 16 + (tid & 1) * 8) = (f32x4){a[0], a[1], a[2], a[3]}; *(LAS f32x4*)(GL + (tid >> 1) * 16 + (tid & 1) * 8 + 4) = (f32x4){a[4], a[5], a[6], a[7]}; }
        }
        __syncthreads();
        if (tile + 1 < 64) GLA_LOAD((tile + 1) * 64);
#pragma unroll
        for (int jj = 0; jj < 8; ++jj) {
            const int j = seg * 8 + jj; float z = bl;
#pragma unroll
            for (int r4 = 0; r4 < 4; ++r4) { const f32x4 gv = *(const LAS f32x4*)(GL + j * 16 + r4 * 4);
                z = fmaf(gv[0], Wl[r4 * 4 + 0], z); z = fmaf(gv[1], Wl[r4 * 4 + 1], z); z = fmaf(gv[2], Wl[r4 * 4 + 2], z); z = fmaf(gv[3], Wl[r4 * 4 + 3], z); }
            LA[j * 64 + d] = logsigmoid_f(z) * (1.0f / 16.0f);
        }
        __syncthreads();
        {
            float bs = 0.f;
            for (int j = 0; j < seg * 8; ++j) bs += LA[j * 64 + d];
#pragma unroll
            for (int jj = 0; jj < 8; ++jj) { const int j = seg * 8 + jj; bs += LA[j * 64 + d]; Qs[j * 64 + d] *= __expf(bs); Ks[j * 64 + d] *= __expf(-bs); }
            if (seg == 7) EBE[d] = __expf(bs);
        }
        __syncthreads();
        {
            const LAS float* qp = Qs + dg * 8; const LAS float* kp = Ks + dg * 8; const LAS float* vp = Vs + w * 8 + vl; LAS float* op = Os + w * 8 + vl;
#pragma unroll 4
            for (int j = 0; j < 64; ++j) {
                const float vv = vp[j * 64];
                const f32x4 ka = *(const LAS f32x4*)(kp + j * 64), kb = *(const LAS f32x4*)(kp + j * 64 + 4);
                const f32x4 qa = *(const LAS f32x4*)(qp + j * 64), qb = *(const LAS f32x4*)(qp + j * 64 + 4);
                MIX_FMA8(S, ka, kb, vv);
                float o; MIX_DOT8(o, S, qa, qb);
                o += __shfl_xor(o, 1); o += __shfl_xor(o, 2); o += __shfl_xor(o, 4);
                if (dg == 0) op[j * 64] = o;
            }
        }
        __syncthreads();
        {
            const f32x4 e0 = *(const LAS f32x4*)(EBE + dg * 8), e1 = *(const LAS f32x4*)(EBE + dg * 8 + 4);
            S[0] *= e0[0]; S[1] *= e0[1]; S[2] *= e0[2]; S[3] *= e0[3]; S[4] *= e1[0]; S[5] *= e1[1]; S[6] *= e1[2]; S[7] *= e1[3];
            const f32x4 x0 = *(const LAS f32x4*)(Os + sj * 64 + sc * 8), x1 = *(const LAS f32x4*)(Os + sj * 64 + sc * 8 + 4);
            const float o[8] = {x0[0], x0[1], x0[2], x0[3], x1[0], x1[1], x1[2], x1[3]};
            *(u32x4*)(vrow + (size_t)(tile * 64) * NPE) = pack8(o);
        }
    }
#undef GLA_LOAD
}

__device__ __forceinline__ void mix_mlstm(const Params& p, ldsp_t lds, int item) {
    const bool is_den = item >= 128;
    const int b = is_den ? ((item - 128) >> 2) : (item >> 4), h = is_den ? ((item - 128) & 3) : ((item >> 2) & 3), vs = is_den ? 0 : (item & 3);
    LAS float* Qs = (LAS float*)lds; LAS float* Ks = Qs + 64 * 128; LAS float* Vs = Ks + 64 * 128; LAS float* Os = Vs + 64 * 32;
    LAS float* WV = Os + 64 * 32; LAS float* QSC = WV + 64; LAS float* CS = QSC + 64;
    const int tid = threadIdx.x, lane = tid & 63, w = tid >> 6, dg = lane & 15, vl = lane >> 4;
    const int sj = tid >> 3, sc = tid & 7;
    bf16_t* P = (bf16_t*)(p.ws + WS_R); const bf16_t* QKB = (const bf16_t*)(p.ws + WS_QKB);
    float* DEN = (float*)(p.ws + WS_DEN); float* EN = (float*)(p.ws + WS_EN);
    const bf16_t* qrow = (EXPER & 2) ? (P + ((size_t)b * 4096 + sj) * NPO + 1024 + h * 128 + sc * 8) : (QKB + ((size_t)b * 4096 + sj) * 1024 + h * 128 + sc * 8);
    const int qstr = (EXPER & 2) ? NPO : 1024;
    bf16_t* vrow = P + ((size_t)b * 4096 + (tid >> 2)) * NPO + 1536 + h * 128 + vs * 32 + (tid & 3) * 8;
    const bf16_t* irow = P + ((size_t)b * 4096 + lane) * NPO + 2560 + h;
    const float bi = p.in[25][h], bfv = p.in[26][h];
    const bool ldv = (tid < 256) && !is_den;
    float m_prev = 0.f;
    float S[8];
#pragma unroll
    for (int i = 0; i < 8; ++i) S[i] = 0.f;
    u32x4 rq1, rq2, rk1, rk2, rv = (u32x4){0u, 0u, 0u, 0u}; bf16_t ri = 0, rf = 0;
#define ML_LOAD(t0) do { const bf16_t* qp_ = qrow + (size_t)(t0) * qstr; rq1 = *(const u32x4*)qp_; rq2 = *(const u32x4*)(qp_ + 64); rk1 = *(const u32x4*)(qp_ + 512); rk2 = *(const u32x4*)(qp_ + 576); \
        if (ldv) rv = *(const u32x4*)(vrow + (size_t)(t0) * NPO); \
        if (w == 0) { ri = irow[(size_t)(t0) * NPO]; rf = irow[(size_t)(t0) * NPO + 4]; } } while (0)
    ML_LOAD(0);
    for (int tile = 0; tile < 64; ++tile) {
        {
            float a[8];
            unpack8(rq1, a); *(LAS f32x4*)(Qs + sj * 128 + sc * 8) = (f32x4){a[0], a[1], a[2], a[3]}; *(LAS f32x4*)(Qs + sj * 128 + sc * 8 + 4) = (f32x4){a[4], a[5], a[6], a[7]};
            unpack8(rq2, a); *(LAS f32x4*)(Qs + sj * 128 + 64 + sc * 8) = (f32x4){a[0], a[1], a[2], a[3]}; *(LAS f32x4*)(Qs + sj * 128 + 64 + sc * 8 + 4) = (f32x4){a[4], a[5], a[6], a[7]};
            unpack8(rk1, a); *(LAS f32x4*)(Ks + sj * 128 + sc * 8) = (f32x4){a[0], a[1], a[2], a[3]}; *(LAS f32x4*)(Ks + sj * 128 + sc * 8 + 4) = (f32x4){a[4], a[5], a[6], a[7]};
            unpack8(rk2, a); *(LAS f32x4*)(Ks + sj * 128 + 64 + sc * 8) = (f32x4){a[0], a[1], a[2], a[3]}; *(LAS f32x4*)(Ks + sj * 128 + 64 + sc * 8 + 4) = (f32x4){a[4], a[5], a[6], a[7]};
            if (ldv) { unpack8(rv, a); *(LAS f32x4*)(Vs + (tid >> 2) * 32 + (tid & 3) * 8) = (f32x4){a[0], a[1], a[2], a[3]}; *(LAS f32x4*)(Vs + (tid >> 2) * 32 + (tid & 3) * 8 + 4) = (f32x4){a[4], a[5], a[6], a[7]}; }
            if (w == 0) {
                const float fi = bf2f(ri) + bi, lf = logsigmoid_f(bf2f(rf) + bfv);
                float F = lf;
#pragma unroll
                for (int o = 1; o < 64; o <<= 1) { const float t = __shfl_up(F, o); if (lane >= o) F += t; }
                const float g = fi - F;
                float pm = g;
#pragma unroll
                for (int o = 1; o < 64; o <<= 1) { const float t = __shfl_up(pm, o); if (lane >= o) pm = fmaxf(pm, t); }
                const float Mj = fmaxf(m_prev, pm);
                const float mu = __shfl(Mj, 63);
                WV[lane] = (EXPER & 1) ? 1.0f : __expf(g - mu); QSC[lane] = (EXPER & 1) ? 1.0f : __expf(mu - Mj);
                if (is_den) EN[((size_t)b * 4096 + tile * 64 + lane) * 4 + h] = (EXPER & 1) ? 1.0f : __expf(-(F + Mj));
                if (lane == 0) CS[0] = (EXPER & 1) ? 0.9f : __expf(m_prev - mu);
                m_prev = __shfl(F, 63) + mu;
            }
        }
        __syncthreads();
        if (tile + 1 < 64) ML_LOAD((tile + 1) * 64);
        {
            const float csv = CS[0];
#pragma unroll
            for (int i = 0; i < 8; ++i) S[i] *= csv;
        }
        if (!is_den || w == 0) {
            const LAS float* qp = Qs + dg * 8; const LAS float* kp = Ks + dg * 8; const LAS float* vp = Vs + w * 4 + vl; LAS float* op = Os + w * 4 + vl;
#pragma unroll 4
            for (int j = 0; j < 64; ++j) {
                const float wv = WV[j];
                const float vv = is_den ? wv : vp[j * 32] * wv;
                const f32x4 ka = *(const LAS f32x4*)(kp + j * 128), kb = *(const LAS f32x4*)(kp + j * 128 + 4);
                const f32x4 qa = *(const LAS f32x4*)(qp + j * 128), qb = *(const LAS f32x4*)(qp + j * 128 + 4);
                MIX_FMA8(S, ka, kb, vv);
                float o; MIX_DOT8(o, S, qa, qb);
                o += __shfl_xor(o, 1); o += __shfl_xor(o, 2); o += __shfl_xor(o, 4); o += __shfl_xor(o, 8);
                o *= QSC[j];
                if (dg == 0) op[j * 32] = o;
            }
        }
        __syncthreads();
        if (!is_den) {
            if (tid < 256) {
                const f32x4 x0 = *(const LAS f32x4*)(Os + (tid >> 2) * 32 + (tid & 3) * 8), x1 = *(const LAS f32x4*)(Os + (tid >> 2) * 32 + (tid & 3) * 8 + 4);
                const float o[8] = {x0[0], x0[1], x0[2], x0[3], x1[0], x1[1], x1[2], x1[3]};
                *(u32x4*)(vrow + (size_t)(tile * 64) * NPO) = pack8(o);
            }
        } else if (tid < 64) DEN[((size_t)b * 4096 + tile * 64 + tid) * 4 + h] = Os[tid * 32];
    }
#undef ML_LOAD
}

__device__ __forceinline__ void mix_lru(const Params& p, ldsp_t lds, int item) {
    const int b = item >> 3, g = item & 7;
    LAS float* XC = (LAS float*)lds; LAS float* AA = XC + 4096; LAS float* BB = AA + 512;
    const int tid = threadIdx.x, j = tid & 63, seg = tid >> 6, c = g * 64 + j;
    float wa[64], wx[64];
#pragma unroll
    for (int i = 0; i < 64; ++i) { wa[i] = p.in[16][g * 4096 + i * 64 + j]; wx[i] = p.in[18][g * 4096 + i * 64 + j]; }
    const float cw0 = p.in[14][c], cw1 = p.in[14][512 + c], cw2 = p.in[14][1024 + c], cw3 = p.in[14][1536 + c], cb = p.in[15][c];
    const float ba = p.in[17][c], bx = p.in[19][c];
    const float sp8 = 8.0f * log1pf(__expf(-p.in[20][c]));
    const bf16_t* P = (const bf16_t*)(p.ws + WS_R); bf16_t* OB = (bf16_t*)(p.ws + WS_OB);
    const bf16_t* lxp = P + ((size_t)b * 4096 + seg * 8) * NPO + 512 + c;
    const bf16_t* lyp = P + ((size_t)b * 4096 + seg * 8) * NPO + c;
    bf16_t* obp = OB + ((size_t)b * 4096 + seg * 8) * 1024 + c;
    float hc = 0.f;
    bf16_t rx[11], ry[8];
#define LRU_LOAD(t0) do { _Pragma("unroll") for (int i = 0; i < 11; ++i) { rx[i] = 0; if ((t0) + seg * 8 - 3 + i >= 0) rx[i] = lxp[((long)(t0) - 3 + i) * NPO]; } \
        _Pragma("unroll") for (int q = 0; q < 8; ++q) ry[q] = lyp[(size_t)((t0) + q) * NPO]; } while (0)
    LRU_LOAD(0);
    for (int tile = 0; tile < 64; ++tile) {
        float xcv[8], lyv[8];
        {
            float x[11];
#pragma unroll
            for (int i = 0; i < 11; ++i) x[i] = bf2f(rx[i]);
#pragma unroll
            for (int q = 0; q < 8; ++q) { xcv[q] = cb + cw0 * x[q] + cw1 * x[q + 1] + cw2 * x[q + 2] + cw3 * x[q + 3]; XC[(seg * 8 + q) * 64 + j] = xcv[q]; lyv[q] = bf2f(ry[q]); }
        }
        __syncthreads();
        if (tile + 1 < 64) LRU_LOAD((tile + 1) * 64);
        float ap[8], hl[8]; float A = 1.f, hloc = 0.f;
#pragma unroll
        for (int q = 0; q < 8; ++q) {
            const LAS float* xr = XC + (seg * 8 + q) * 64;
            float ra = ba, rxx = bx;
#pragma unroll
            for (int i4 = 0; i4 < 16; ++i4) { const f32x4 xv = *(const LAS f32x4*)(xr + i4 * 4);
                ra = fmaf(xv[0], wa[i4 * 4 + 0], ra); ra = fmaf(xv[1], wa[i4 * 4 + 1], ra); ra = fmaf(xv[2], wa[i4 * 4 + 2], ra); ra = fmaf(xv[3], wa[i4 * 4 + 3], ra);
                rxx = fmaf(xv[0], wx[i4 * 4 + 0], rxx); rxx = fmaf(xv[1], wx[i4 * 4 + 1], rxx); rxx = fmaf(xv[2], wx[i4 * 4 + 2], rxx); rxx = fmaf(xv[3], wx[i4 * 4 + 3], rxx); }
            const float r = sigmoid_f(ra), ig = sigmoid_f(rxx);
            const float la = -sp8 * r, a = __expf(la);
            const float uu = sqrtf(-expm1f(2.0f * la)) * (ig * xcv[q]);
            hloc = fmaf(a, hloc, uu); A *= a; ap[q] = A; hl[q] = hloc;
        }
        AA[seg * 64 + j] = A; BB[seg * 64 + j] = hloc;
        __syncthreads();
        float hin = hc, run = hc;
#pragma unroll
        for (int s = 0; s < 8; ++s) { run = fmaf(AA[s * 64 + j], run, BB[s * 64 + j]); if (s < seg) hin = run; }
        hc = run;
#pragma unroll
        for (int q = 0; q < 8; ++q) {
            const float hv = fmaf(ap[q], hin, hl[q]);
            const float y = lyv[q];
            const float u3 = 0.7978845608028654f * (y + 0.044715f * y * y * y);
            const float th = 1.0f - 2.0f / (1.0f + __expf(2.0f * u3));
            obp[(size_t)(tile * 64 + q) * 1024] = f2bf(hv * 0.5f * y * (1.0f + th));
        }
    }
#undef LRU_LOAD
}

__device__ __forceinline__ void phase_mc(const Params& p) {
    const bf16_t* P = (const bf16_t*)(p.ws + WS_R); bf16_t* MC = (bf16_t*)(p.ws + WS_OB);
    const float* cw = p.in[21]; const float* cbp = p.in[22];
    for (int idx = blockIdx.x * 512 + threadIdx.x; idx < M * 64; idx += gridDim.x * 512) {
        const int t = idx >> 6, ch = (idx & 63) * 8, pos = t & 4095;
        float acc[8];
        { const f32x4 a0 = *(const f32x4*)(cbp + ch), a1 = *(const f32x4*)(cbp + ch + 4);
          acc[0] = a0[0]; acc[1] = a0[1]; acc[2] = a0[2]; acc[3] = a0[3]; acc[4] = a1[0]; acc[5] = a1[1]; acc[6] = a1[2]; acc[7] = a1[3]; }
#pragma unroll
        for (int q = 0; q < 4; ++q) {
            if (pos - 3 + q >= 0) {
                float x[8]; unpack8(*(const u32x4*)(P + (size_t)(t - 3 + q) * NPO + 1024 + ch), x);
                const f32x4 w0 = *(const f32x4*)(cw + q * 512 + ch), w1 = *(const f32x4*)(cw + q * 512 + ch + 4);
                acc[0] = fmaf(w0[0], x[0], acc[0]); acc[1] = fmaf(w0[1], x[1], acc[1]); acc[2] = fmaf(w0[2], x[2], acc[2]); acc[3] = fmaf(w0[3], x[3], acc[3]);
                acc[4] = fmaf(w1[0], x[4], acc[4]); acc[5] = fmaf(w1[1], x[5], acc[5]); acc[6] = fmaf(w1[2], x[6], acc[6]); acc[7] = fmaf(w1[3], x[7], acc[7]);
            }
        }
#pragma unroll
        for (int e = 0; e < 8; ++e) acc[e] = silu_f(acc[e]);
        *(u32x4*)(MC + (size_t)t * 512 + ch) = pack8(acc);
    }
}

__device__ __forceinline__ void phase_fin_even(const Params& p) {
    const bf16_t* P = (const bf16_t*)(p.ws + WS_R); bf16_t* OB = (bf16_t*)(p.ws + WS_OB); const float* hw = p.in[11];
    const int tid = threadIdx.x, lane = tid & 63, w = tid >> 6, hh = lane >> 4, l16 = lane & 15;
    for (int idx = blockIdx.x * 8 + w; idx < 2 * M; idx += gridDim.x * 8) {
        const int t = idx >> 1, grp = idx & 1;
        const bf16_t* row = P + (size_t)t * NPE;
        const int ocol = (grp ? 2560 : 1024) + hh * 128 + l16 * 8, gcol = (grp ? 3072 : 1536) + hh * 128 + l16 * 8;
        float o[8], g[8];
        unpack8(*(const u32x4*)(row + ocol), o); unpack8(*(const u32x4*)(row + gcol), g);
        float ss = 0.f;
#pragma unroll
        for (int i = 0; i < 8; ++i) ss = fmaf(o[i], o[i], ss);
        ss += __shfl_xor(ss, 1); ss += __shfl_xor(ss, 2); ss += __shfl_xor(ss, 4); ss += __shfl_xor(ss, 8);
        const float rs = rsqrtf(ss * (1.0f / 128.0f) + EPS);
        const int oc = grp * 512 + hh * 128 + l16 * 8;
        const f32x4 w0 = *(const f32x4*)(hw + oc), w1 = *(const f32x4*)(hw + oc + 4);
        float y[8];
#pragma unroll
        for (int i = 0; i < 8; ++i) y[i] = o[i] * rs * silu_f(g[i]) * (i < 4 ? w0[i & 3] : w1[i & 3]);
        *(u32x4*)(OB + (size_t)t * 1024 + oc) = pack8(y);
    }
}
__device__ __forceinline__ void phase_fin_odd(const Params& p) {
    const bf16_t* P = (const bf16_t*)(p.ws + WS_R); bf16_t* OB = (bf16_t*)(p.ws + WS_OB); const float* nw = p.in[27];
    const float* DEN = (const float*)(p.ws + WS_DEN); const float* EN = (const float*)(p.ws + WS_EN);
    const int tid = threadIdx.x, lane = tid & 63, w = tid >> 6, hh = lane >> 4, l16 = lane & 15;
    for (int t = blockIdx.x * 8 + w; t < M; t += gridDim.x * 8) {
        const bf16_t* row = P + (size_t)t * NPO;
        float nu[8], g[8];
        unpack8(*(const u32x4*)(row + 1536 + hh * 128 + l16 * 8), nu); unpack8(*(const u32x4*)(row + 2048 + hh * 128 + l16 * 8), g);
        const float den = DEN[(size_t)t * 4 + hh], en = EN[(size_t)t * 4 + hh];
        const float inv = 1.0f / fmaxf(fabsf(den), en);
        float hm[8]; float ss = 0.f;
#pragma unroll
        for (int i = 0; i < 8; ++i) { hm[i] = sigmoid_f(g[i]) * nu[i] * inv; ss = fmaf(hm[i], hm[i], ss); }
        ss += __shfl_xor(ss, 1); ss += __shfl_xor(ss, 2); ss += __shfl_xor(ss, 4); ss += __shfl_xor(ss, 8);
        const float rs = rsqrtf(ss * (1.0f / 128.0f) + EPS);
        const int oc = hh * 128 + l16 * 8;
        const f32x4 w0 = *(const f32x4*)(nw + oc), w1 = *(const f32x4*)(nw + oc + 4);
        float y[8];
#pragma unroll
        for (int i = 0; i < 8; ++i) { y[i] = hm[i] * rs * (i < 4 ? w0[i & 3] : w1[i & 3]); }
        *(u32x4*)(OB + (size_t)t * 1024 + 512 + oc) = pack8(y);
    }
}
__device__ __forceinline__ void phase_final(const Params& p) {
    float* hf = p.out; const float* SS = (const float*)(p.ws + WS_SS) + (size_t)6 * 16 * M; const float* fw = p.in[29];
    const int tid = threadIdx.x, lane = tid & 63, w = tid >> 6;
    for (int row = blockIdx.x * 8 + w; row < M; row += gridDim.x * 8) {
        const float rs = row_rs(SS, row);
        f32x4* hr = (f32x4*)(hf + (size_t)row * 1024);
#pragma unroll
        for (int i = 0; i < 4; ++i) { const f32x4 v = hr[lane + 64 * i]; const f32x4 wv = ((const f32x4*)fw)[lane + 64 * i]; hr[lane + 64 * i] = v * rs * wv; }
    }
}

__host__ __device__ inline bool phase_active(int ph) { return !(ph == 4 || ph == 5); }
constexpr int N_PHASES = 22;
__device__ __forceinline__ void load_params(Params& q, ldsp_t lds) {
    const LAS unsigned* tab = (const LAS unsigned*)(lds + 131072);
#pragma unroll
    for (int k = 0; k < 32; ++k) {
        const unsigned lo = __builtin_amdgcn_readfirstlane(tab[2 * k]), hi = __builtin_amdgcn_readfirstlane(tab[2 * k + 1]);
        const unsigned long long v = ((unsigned long long)hi << 32) | lo;
        if (k < 30) q.in[k] = (const float*)(const __attribute__((address_space(1))) float*)v; else if (k == 30) q.out = (float*)(__attribute__((address_space(1))) float*)v; else q.ws = (unsigned char*)(__attribute__((address_space(1))) unsigned char*)v;
    }
}
#define PHASE_BEGIN(k) if (lo <= (k) && (k) < hi) { asm volatile("" ::: "memory"); Params p; load_params(p, lds); unsigned char* ws = p.ws; (void)ws;
#define PHASE_END(k) if ((k) + 1 < hi) grid.sync(); }
template <int L> __device__ __forceinline__ void layer_phases(ldsp_t lds, cg::grid_group& grid, const int lo, const int hi) {
    constexpr int B0 = 1 + 10 * L;
    PHASE_BEGIN(B0 + 0)
        if (PH_MASK & 4) { EpiSwiGLU E{(bf16_t*)(ws + WS_R), (const float*)(ws + WS_SS) + (size_t)(3 * L + 0) * 16 * M};
        run_gemm<EpiSwiGLU>(lds, (const bf16_t*)(ws + WS_XB), (const bf16_t*)(ws + WS_WGU + (size_t)(L * 2 + 0) * SZ_WGU), 5632, 1024, E); }
    PHASE_END(B0 + 0)
    PHASE_BEGIN(B0 + 1)
        if (PH_MASK & 8) { EpiResid E{(L == 0) ? p.in[0] : (const float*)p.out, p.out, (bf16_t*)(ws + WS_XB), (float*)(ws + WS_SS) + (size_t)(3 * L + 1) * 16 * M, 0.5f};
        run_gemm<EpiResid>(lds, (const bf16_t*)(ws + WS_R), (const bf16_t*)(ws + WS_WD + (size_t)(L * 2 + 0) * SZ_WD), 1024, 2816, E); }
    PHASE_END(B0 + 1)
    PHASE_BEGIN(B0 + 2)
        if (PH_MASK & 16) { EpiProj E{(bf16_t*)(ws + WS_R), L ? NPO : NPE, (const float*)(ws + WS_SS) + (size_t)(3 * L + 1) * 16 * M};
        run_gemm<EpiProj>(lds, (const bf16_t*)(ws + WS_XB), (const bf16_t*)(ws + (L ? WS_OWIN : WS_EWIN)), L ? NPO : NPE, 1024, E); }
    PHASE_END(B0 + 2)
    if (L == 1) {
        PHASE_BEGIN(B0 + 3)
            if (PH_MASK & 32) phase_mc(p);
        PHASE_END(B0 + 3)
        PHASE_BEGIN(B0 + 4)
            if (PH_MASK & 32) { EpiProj E{(bf16_t*)(ws + WS_QKB), 1024, nullptr};
            run_gemm<EpiProj>(lds, (const bf16_t*)(ws + WS_OB), (const bf16_t*)(ws + WS_MLQK), 1024, 512, E); }
        PHASE_END(B0 + 4)
    }
    PHASE_BEGIN(B0 + 5)
        if (L == 0) {
            for (int it = blockIdx.x; it < 192; it += gridDim.x) { if (it < 128) { if (PH_MASK & 64) mix_retention(p, lds, it); } else { if (PH_MASK & 128) mix_gla(p, lds, it - 128); } __syncthreads(); }
        } else {
            for (int it = blockIdx.x; it < 224; it += gridDim.x) { if (it < 160) { if (PH_MASK & 256) mix_mlstm(p, lds, it); } else { if (PH_MASK & 512) mix_lru(p, lds, it - 160); } __syncthreads(); }
        }
    PHASE_END(B0 + 5)
    PHASE_BEGIN(B0 + 6)
        if (PH_MASK & 1024) { if (L == 0) phase_fin_even(p); else phase_fin_odd(p); }
    PHASE_END(B0 + 6)
    PHASE_BEGIN(B0 + 7)
        if (PH_MASK & 8) { EpiResid E{(const float*)p.out, p.out, (bf16_t*)(ws + WS_XB), (float*)(ws + WS_SS) + (size_t)(3 * L + 2) * 16 * M, 1.0f};
        run_gemm<EpiResid>(lds, (const bf16_t*)(ws + WS_OB), (const bf16_t*)(ws + (L ? WS_OWOUT : WS_EWOUT)), 1024, 1024, E); }
    PHASE_END(B0 + 7)
    PHASE_BEGIN(B0 + 8)
        if (PH_MASK & 4) { EpiSwiGLU E{(bf16_t*)(ws + WS_R), (const float*)(ws + WS_SS) + (size_t)(3 * L + 2) * 16 * M};
        run_gemm<EpiSwiGLU>(lds, (const bf16_t*)(ws + WS_XB), (const bf16_t*)(ws + WS_WGU + (size_t)(L * 2 + 1) * SZ_WGU), 5632, 1024, E); }
    PHASE_END(B0 + 8)
    PHASE_BEGIN(B0 + 9)
        if (PH_MASK & 8) { EpiResid E{(const float*)p.out, p.out, (bf16_t*)(ws + WS_XB), (float*)(ws + WS_SS) + (size_t)(3 * L + 3) * 16 * M, 0.5f};
        run_gemm<EpiResid>(lds, (const bf16_t*)(ws + WS_R), (const bf16_t*)(ws + WS_WD + (size_t)(L * 2 + 1) * SZ_WD), 1024, 2816, E); }
    PHASE_END(B0 + 9)
}
__global__ void __launch_bounds__(512, 2) mega(Params p0) {
    extern __shared__ __attribute__((aligned(16))) unsigned char ldsraw[];
    ldsp_t lds = (ldsp_t)ldsraw;
    cg::grid_group grid = cg::this_grid();
    if (threadIdx.x == 0) {
        LAS unsigned long long* tab = (LAS unsigned long long*)(lds + 131072);
#pragma unroll
        for (int k = 0; k < 30; ++k) tab[k] = (unsigned long long)p0.in[k];
        tab[30] = (unsigned long long)p0.out; tab[31] = (unsigned long long)p0.ws;
    }
    __syncthreads();
    const int lo = p0.ph_lo, hi = p0.ph_hi;
    PHASE_BEGIN(0)
        if (PH_MASK & 1) phase_prep(p, lds);
    PHASE_END(0)
    layer_phases<0>(lds, grid, lo, hi);
    layer_phases<1>(lds, grid, lo, hi);
    PHASE_BEGIN(21)
        if (PH_MASK & 2) phase_final(p);
    PHASE_END(21)
}

extern "C" void kernel_launch(void* const* d_in, const int* in_sizes, int n_in, void* d_out, int out_size, void* d_ws, size_t ws_size, hipStream_t stream) {
    static int grid = 0;
    if (grid == 0) {
        if (n_in != 30 || out_size != M * 1024 || ws_size < WS_END) { fprintf(stderr, "kernel_launch: unexpected problem (n_in %d out %d ws %zu need %zu)\n", n_in, out_size, ws_size, (size_t)WS_END); grid = -1; return; }
        int dev = 0, cus = 0, per_cu = 0;
        hipGetDevice(&dev); hipDeviceGetAttribute(&cus, hipDeviceAttributeMultiprocessorCount, dev);
        if (hipFuncSetAttribute((const void*)mega, hipFuncAttributeMaxDynamicSharedMemorySize, LDS_BYTES) != hipSuccess) { fprintf(stderr, "kernel_launch: hipFuncSetAttribute failed\n"); }
        if (hipOccupancyMaxActiveBlocksPerMultiprocessor(&per_cu, (const void*)mega, 512, LDS_BYTES) != hipSuccess || per_cu < 1) { fprintf(stderr, "kernel_launch: occupancy query says %d\n", per_cu); per_cu = 1; }
        (void)hipGetLastError();
        grid = cus * per_cu; if (grid > 256) grid = 256; if (grid < 1) grid = 256;
    }
    if (grid < 0) return;
    Params p{};
    for (int i = 0; i < 30; ++i) p.in[i] = (const float*)d_in[i];
    p.out = (float*)d_out; p.ws = (unsigned char*)d_ws;
#if MK_N_LAUNCHES == 1
    p.ph_lo = 0; p.ph_hi = N_PHASES;
    void* args[] = {&p};
    hipError_t e = hipLaunchCooperativeKernel((const void*)mega, dim3(grid), dim3(512), args, LDS_BYTES, stream);
    if (e != hipSuccess) fprintf(stderr, "kernel_launch: cooperative launch failed: %s (grid %d)\n", hipGetErrorString(e), grid);
#else
    for (int ph = 0; ph < N_PHASES; ++ph) {
        if (!phase_active(ph)) continue;
        p.ph_lo = ph; p.ph_hi = ph + 1;
        hipLaunchKernelGGL(mega, dim3(grid), dim3(512), LDS_BYTES, stream, p);
    }
#endif
}
```

```cpp
#include <hip/hip_runtime.h>
#include <hip/hip_cooperative_groups.h>
#include <cstdio>
namespace cg = cooperative_groups;
#ifndef MK_N_LAUNCHES
#define MK_N_LAUNCHES 1
#endif
namespace pg8 {
#define PG8_LAS __attribute__((address_space(3)))
typedef unsigned short bf16_t;
typedef short bf16x8 __attribute__((ext_vector_type(8)));
typedef float f32x4 __attribute__((ext_vector_type(4)));
typedef unsigned u32x4 __attribute__((ext_vector_type(4)));
constexpr int BM = 256, BK = 64, HALF = 128, HTB = HALF * BK * 2  , STAGE_BYTES = 8 * HTB, NXCD = 8, WGM = 8;

__host__ __device__ __forceinline__ int lds_byte(int r, int c) { const int st = (r >> 4) * 2 + (c >> 5), rr = r & 15, cc = c & 31, ob = rr * 64 + cc * 2; return st * 1024 + (ob ^ (((ob >> 9) & 1) << 5)); }
__host__ __device__ __forceinline__ void stage_rc(int b, int& R, int& C) { const int st = b / 1024, sb = b % 1024, swz = sb ^ (((sb >> 9) & 1) << 5); R = (st >> 1) * 16 + swz / 64; C = (st & 1) * 32 + (swz % 64) / 2; }
__host__ __device__ __forceinline__ int perm32(int rho) { const int n = rho >> 4, i = rho & 15; return 8 * (i >> 2) + 4 * n + (i & 3); }

struct Unit { int pm, pn; };
struct Gemm { const bf16_t* A; const bf16_t* Bt; int M, N, K; };

struct StaticOrder {
    int nM, nN, nwg, G, c;
    __host__ __device__ void init(int M, int N, int G_, int c_) { nM = M / BM; nN = N / BM; nwg = nM * nN; G = G_; c = c_; }
    __host__ __device__ bool next(int i, Unit& u) const {
        const long L = (long)i * G + c; if (L >= nwg) return false;
        int wgid = (int)L; { const int q = nwg / NXCD, r = nwg % NXCD, xcd = wgid % NXCD, off = wgid / NXCD; wgid = (xcd < r ? xcd * (q + 1) : r * (q + 1) + (xcd - r) * q) + off; }
        const int nig = WGM * nN, gid = wgid / nig, fm = gid * WGM, gsz = (nM - fm) < WGM ? (nM - fm) : WGM;
        u.pm = fm + ((wgid % nig) % gsz); u.pn = (wgid % nig) / gsz; return true;
    }
    __device__ __forceinline__ void a_ready(const Unit&) const {}
    __device__ __forceinline__ void done(const Unit&) const {}
};
typedef __bf16 bf16x2_native __attribute__((ext_vector_type(2)));
__device__ __forceinline__ unsigned cvt_pk_bf16(float lo, float hi) { const bf16x2_native v = {(__bf16)lo, (__bf16)hi}; return __builtin_bit_cast(unsigned, v); }
typedef float f32x2 __attribute__((ext_vector_type(2)));
template <class Epi, class Sched, bool STAMP = false>
__device__ __forceinline__ void gemm_phase(PG8_LAS unsigned char* lds, const Gemm g, const Sched& S, const Epi& E, unsigned long long* stamps) {
    const int tid = threadIdx.x, wid = __builtin_amdgcn_readfirstlane(tid >> 6), lane = tid & 63, wr = wid >> 2, wc = wid & 3, fr = lane & 15, fq = lane >> 4;
    const int K = g.K, nt = K / BK;
    int ts_lo = 0, ts_hi = 0, nts = 0; const unsigned long long rt_entry = STAMP ? (unsigned long long)wall_clock64() : 0ull;
#define PG8_STAMP() do { if (STAMP && wid == 0 && nts < 64) { const unsigned long long _c = (unsigned long long)clock64(); \
        ts_lo = (lane == nts) ? (int)(unsigned)_c : ts_lo; ts_hi = (lane == nts) ? (int)(unsigned)(_c >> 32) : ts_hi; ++nts; } } while (0)
    PG8_STAMP();
    unsigned voffA[2], voffB[2];
#pragma unroll
    for (int i = 0; i < 2; ++i) { int R, C; stage_rc(tid * 16 + i * 8192, R, C); const int Rb = Epi::PERM ? ((R & ~31) + perm32(R & 31)) : R;
        voffA[i] = (unsigned)(R * K + C) * 2u; voffB[i] = (unsigned)(Rb * K + C) * 2u; }
    const size_t kstep = (size_t)(BK * 2);
    const size_t hstep = (size_t)HALF * K * 2;
    const size_t tstep = 2 * hstep;
    const unsigned ldsw = (unsigned)wid * 1024u;
    const int aoff = lds_byte(wr * 64 + fr, fq * 8), boff = lds_byte(wc * 32 + fr, fq * 8);
#define PG8_SA(b, h) (((b) * 2 + (h)) * HTB)
#define PG8_SB(b, h) ((4 + (b) * 2 + (h)) * HTB)
#define PG8_STAGE(bufoff, gbase, voff) do { _Pragma("unroll") for (int _i = 0; _i < 2; ++_i) \
        __builtin_amdgcn_global_load_lds((const unsigned*)((const char*)(gbase) + (voff)[_i]), (PG8_LAS unsigned*)(lds + (bufoff) + ldsw + _i * 8192), 16, 0, 0); } while (0)
#define PG8_LDA(dst, b, h) do { _Pragma("unroll") for (int m = 0; m < 4; ++m) _Pragma("unroll") for (int k = 0; k < 2; ++k) dst[m][k] = *(const PG8_LAS bf16x8*)(lds + PG8_SA(b, h) + aoff + m * 2048 + k * 1024); } while (0)
#define PG8_LDB(dst, b, h) do { _Pragma("unroll") for (int n = 0; n < 2; ++n) _Pragma("unroll") for (int k = 0; k < 2; ++k) dst[n][k] = *(const PG8_LAS bf16x8*)(lds + PG8_SB(b, h) + boff + n * 2048 + k * 1024); } while (0)
#define PG8_MMA(ai, bj, At, Bt) do { __builtin_amdgcn_s_setprio(1); _Pragma("unroll") for (int m = 0; m < 4; ++m) _Pragma("unroll") for (int n = 0; n < 2; ++n) _Pragma("unroll") for (int k = 0; k < 2; ++k) \
        acc[ai][bj][m][n] = __builtin_amdgcn_mfma_f32_16x16x32_bf16(Bt[n][k], At[m][k], acc[ai][bj][m][n], 0, 0, 0); __builtin_amdgcn_s_setprio(0); } while (0)
#define PG8_WAIT_V(n) asm volatile("s_waitcnt vmcnt(" #n ")" ::: "memory")
#define PG8_WAIT_L(n) asm volatile("s_waitcnt lgkmcnt(" #n ")" ::: "memory")
#define PG8_BAR __builtin_amdgcn_s_barrier()
#define PG8_SCHED __builtin_amdgcn_sched_barrier(0)
    Unit cur, nxt; int ui = 0;
    if (!S.next(0, cur)) return;
    f32x4 acc[2][2][4][2];
#pragma unroll
    for (int a = 0; a < 2; ++a)
#pragma unroll
        for (int b = 0; b < 2; ++b)
#pragma unroll
            for (int m = 0; m < 4; ++m)
#pragma unroll
                for (int n = 0; n < 2; ++n) acc[a][b][m][n] = (f32x4){0.f, 0.f, 0.f, 0.f};
    bf16x8 At[4][2], B0[2][2], B1[2][2];
    const char* cA = (const char*)g.A + (size_t)cur.pm * tstep; const char* cB = (const char*)g.Bt + (size_t)cur.pn * tstep;
    S.a_ready(cur);
    PG8_STAGE(PG8_SB(0, 0), cB, voffB); PG8_STAGE(PG8_SA(0, 0), cA, voffA); PG8_STAGE(PG8_SB(0, 1), cB + hstep, voffB); PG8_STAGE(PG8_SA(0, 1), cA + hstep, voffA);
    if (wr == 1) PG8_BAR;
    PG8_WAIT_V(4); PG8_BAR;
    PG8_STAGE(PG8_SB(1, 0), cB + kstep, voffB); PG8_STAGE(PG8_SA(1, 0), cA + kstep, voffA); PG8_STAGE(PG8_SB(1, 1), cB + hstep + kstep, voffB);
    PG8_WAIT_V(6); PG8_BAR;
    PG8_STAMP();
    for (;;) {
        const bool has_next = S.next(ui + 1, nxt);
        const char* nA = has_next ? (const char*)g.A + (size_t)nxt.pm * tstep : cA; const char* nB = has_next ? (const char*)g.Bt + (size_t)nxt.pn * tstep : cB;
        for (int t = 0; t < nt; t += 2) {
            const bool last = (t == nt - 2);
            const char* a1 = cA + (size_t)(t + 1) * kstep;
            const char* a2 = last ? nA : cA + (size_t)(t + 2) * kstep; const char* b2 = last ? nB : cB + (size_t)(t + 2) * kstep;
            const char* a3 = a2 + kstep; const char* b3 = b2 + kstep;
            if (last && has_next) S.a_ready(nxt);
            PG8_LDB(B0, 0, 0); PG8_SCHED; PG8_LDA(At, 0, 0); PG8_STAGE(PG8_SA(1, 1), a1 + hstep, voffA);
            PG8_WAIT_L(8); PG8_BAR; PG8_WAIT_L(0); PG8_MMA(0, 0, At, B0); PG8_BAR; PG8_SCHED;
            PG8_LDB(B1, 0, 1); PG8_STAGE(PG8_SB(0, 0), b2, voffB);
            PG8_BAR; PG8_WAIT_L(0); PG8_MMA(0, 1, At, B1); PG8_BAR;
            PG8_LDA(At, 0, 1); PG8_STAGE(PG8_SA(0, 0), a2, voffA);
            PG8_BAR; PG8_WAIT_L(0); PG8_MMA(1, 0, At, B0); PG8_BAR; PG8_SCHED;
            PG8_STAGE(PG8_SB(0, 1), b2 + hstep, voffB);
            PG8_WAIT_V(6); PG8_BAR; PG8_MMA(1, 1, At, B1); PG8_BAR;
            PG8_LDB(B0, 1, 0); PG8_SCHED; PG8_LDA(At, 1, 0); PG8_STAGE(PG8_SA(0, 1), a2 + hstep, voffA);
            PG8_WAIT_L(8); PG8_BAR; PG8_WAIT_L(0); PG8_MMA(0, 0, At, B0); PG8_BAR; PG8_SCHED;
            PG8_LDB(B1, 1, 1); PG8_STAGE(PG8_SB(1, 0), b3, voffB);
            PG8_BAR; PG8_WAIT_L(0); PG8_MMA(0, 1, At, B1); PG8_BAR;
            PG8_LDA(At, 1, 1); PG8_STAGE(PG8_SA(1, 0), a3, voffA);
            PG8_BAR; PG8_WAIT_L(0); PG8_MMA(1, 0, At, B0); PG8_BAR; PG8_SCHED;
            PG8_STAGE(PG8_SB(1, 1), b3 + hstep, voffB);
            PG8_WAIT_V(6); PG8_BAR; PG8_MMA(1, 1, At, B1); PG8_BAR;
        }
        PG8_STAMP();
        if constexpr (!Epi::AFTER_DRAIN) { E(acc, cur, wr, wc, fr, fq); S.done(cur); }
        PG8_STAMP();
        if (!has_next) break;
#pragma unroll
        for (int a = 0; a < 2; ++a)
#pragma unroll
            for (int b = 0; b < 2; ++b)
#pragma unroll
                for (int m = 0; m < 4; ++m)
#pragma unroll
                    for (int n = 0; n < 2; ++n) acc[a][b][m][n] = (f32x4){0.f, 0.f, 0.f, 0.f};
        cur = nxt; cA = nA; cB = nB; ++ui;
    }
    PG8_WAIT_V(0);
    if (wr == 0) PG8_BAR;
    PG8_BAR;
    if constexpr (Epi::AFTER_DRAIN) { E.fused(acc, cur, wr, wc, fr, fq, lds, wid, lane); S.done(cur); }
    PG8_STAMP();
    if (STAMP && wid == 0) { stamps[lane] = lane < nts ? (((unsigned long long)(unsigned)ts_hi << 32) | (unsigned)ts_lo) : 0ull;
        if (lane == 62) stamps[62] = rt_entry; if (lane == 63) stamps[63] = (unsigned long long)wall_clock64(); }
#undef PG8_STAMP
#undef PG8_SA
#undef PG8_SB
#undef PG8_STAGE
#undef PG8_LDA
#undef PG8_LDB
#undef PG8_MMA
#undef PG8_WAIT_V
#undef PG8_WAIT_L
#undef PG8_BAR
#undef PG8_SCHED
}
}
#ifndef LAS
#define LAS __attribute__((address_space(3)))
#endif
#define XB_TMO      128
#define XB_XCNT(j)  (256  + 64 * (j))
#define XB_XSUB(j)  (1280 + 64 * (j))
#define XB_XGEN(j)  (2304 + 64 * (j))
#define XB_TOP      3328
#define XB_TOPGEN   3392
#define XCD_BAR_WORDS 3456
#define XB_SPIN_CAP (1u << 18)

__device__ __forceinline__ unsigned xb_ld(unsigned* p)              { return __hip_atomic_load(p, __ATOMIC_RELAXED, __HIP_MEMORY_SCOPE_AGENT); }
__device__ __forceinline__ unsigned xb_add(unsigned* p, unsigned v) { return __hip_atomic_fetch_add(p, v, __ATOMIC_RELAXED, __HIP_MEMORY_SCOPE_AGENT); }
__device__ __forceinline__ unsigned xb_xcc_id() { return (unsigned)__builtin_amdgcn_s_getreg((3 << 11) | 20) & 0xFu; }
#define XB_SPIN(cond, bar) do { unsigned _sp = 0; while (cond) { __builtin_amdgcn_s_sleep(1); \
    if ((++_sp & 255u) == 0u) { if (xb_ld(&(bar)[XB_TMO])) break; if (_sp > XB_SPIN_CAP) { atomicAdd(&(bar)[XB_TMO], 1u); break; } } } } while (0)

struct XcdBarrier {
    unsigned* bar; unsigned x;
    volatile LAS unsigned* st;
};

__device__ __forceinline__ XcdBarrier xcd_barrier_post(unsigned* bar, volatile LAS unsigned* st) {
    XcdBarrier b; b.bar = bar; b.x = xb_xcc_id(); b.st = st;
    if (threadIdx.x == 0) (void)xb_add(&bar[XB_XCNT(b.x)], 1u);
    return b;
}
__device__ __forceinline__ void xcd_barrier_complete(unsigned* bar, unsigned x, unsigned& nloc, unsigned& nx) {
    const unsigned G = gridDim.x * gridDim.y * gridDim.z;
    unsigned sum, cnt, mine, sp = 0u;
    for (;;) {
        sum = 0u; cnt = 0u; mine = 0u;
#pragma unroll
        for (unsigned j = 0; j < 16; ++j) { const unsigned c = xb_ld(&bar[XB_XCNT(j)]); sum += c; cnt += (c > 0u) ? 1u : 0u; mine = (j == x) ? c : mine; }
        if (sum == G) break;
        __builtin_amdgcn_s_sleep(1);
        if ((++sp & 255u) == 0u) { if (xb_ld(&bar[XB_TMO])) break; if (sp > XB_SPIN_CAP) { atomicAdd(&bar[XB_TMO], 1u); break; } }
    }
    nloc = mine > 0u ? mine : 1u; nx = cnt > 0u ? cnt : 1u;
}

__device__ __forceinline__ void xcd_barrier(const XcdBarrier& b) {
    asm volatile("s_waitcnt vmcnt(0)" ::: "memory");
    __syncthreads();
    if (threadIdx.x == 0) {
        unsigned* bar = b.bar;
        __builtin_amdgcn_s_waitcnt(0);
        unsigned nloc = b.st[0], nx = b.st[1];
        if (nloc == 0u) { xcd_barrier_complete(bar, b.x, nloc, nx); b.st[0] = nloc; b.st[1] = nx; }
        const unsigned old = xb_add(&bar[XB_XSUB(b.x)], 1u);
        const unsigned gen = old / nloc;
        if (old + 1u == (gen + 1u) * nloc) {
            __builtin_amdgcn_fence(__ATOMIC_RELEASE, "agent");
            asm volatile("s_waitcnt vmcnt(0)" ::: "memory");
            const unsigned og = xb_add(&bar[XB_TOP], 1u);
            const unsigned tg = og / nx;
            if (og + 1u == (tg + 1u) * nx) xb_add(&bar[XB_TOPGEN], 1u);
            else XB_SPIN(xb_ld(&bar[XB_TOPGEN]) == tg, bar);
            __builtin_amdgcn_fence(__ATOMIC_ACQUIRE, "agent");
            xb_add(&bar[XB_XGEN(b.x)], 1u);
            asm volatile("s_waitcnt vmcnt(0)" ::: "memory");
        } else {
            XB_SPIN(xb_ld(&bar[XB_XGEN(b.x)]) == gen, bar);
            __builtin_amdgcn_fence(__ATOMIC_ACQUIRE, "agent");
            asm volatile("s_waitcnt vmcnt(0)" ::: "memory");
        }
    }
    __syncthreads();
}


using pg8::bf16_t; using pg8::bf16x8; using pg8::f32x4; using pg8::u32x4;
typedef unsigned u32x2 __attribute__((ext_vector_type(2)));
#define LAS __attribute__((address_space(3)))
typedef LAS unsigned char* ldsp_t;

constexpr int M = 32768, NPE = 3840, NPO = 2816;
constexpr float EPS = 1e-6f;
constexpr int LDS_BYTES = 135168;

constexpr size_t SZ_WGU = (size_t)5632 * 1024 * 2, SZ_WD = (size_t)1024 * 2816 * 2;
constexpr size_t WS_WGU = 0;
constexpr size_t WS_WD = WS_WGU + 4 * SZ_WGU;
constexpr size_t WS_EWIN = WS_WD + 4 * SZ_WD;
constexpr size_t WS_OWIN = WS_EWIN + (size_t)NPE * 1024 * 2;
constexpr size_t WS_EWOUT = WS_OWIN + (size_t)NPO * 1024 * 2;
constexpr size_t WS_OWOUT = WS_EWOUT + (size_t)1024 * 1024 * 2;
constexpr size_t WS_MLQK = WS_OWOUT + (size_t)1024 * 1024 * 2;
constexpr size_t WS_ROPE = WS_MLQK + (size_t)1024 * 512 * 2;
constexpr size_t WS_SS = WS_ROPE + (size_t)2 * 4096 * 64 * 4;
constexpr size_t WS_DEN = WS_SS + (size_t)7 * 16 * M * 4;
constexpr size_t WS_EN = WS_DEN + (size_t)M * 4 * 4;
constexpr size_t WS_XB = WS_EN + (size_t)M * 4 * 4;
constexpr size_t WS_OB = WS_XB + (size_t)M * 1024 * 2;
constexpr size_t WS_R = WS_OB + (size_t)M * 1024 * 2;
constexpr size_t WS_QKB = WS_R + (size_t)M * NPO * 2;
constexpr size_t WS_BAR = WS_R + (size_t)M * NPE * 2;
constexpr size_t WS_END = WS_BAR + 16384;

struct Params { const float* in[30]; float* out; unsigned char* ws; int ph_lo, ph_hi; };

__device__ __forceinline__ float bflo(unsigned w) { return __uint_as_float(w << 16); }
__device__ __forceinline__ float bfhi(unsigned w) { return __uint_as_float(w & 0xffff0000u); }
__device__ __forceinline__ float bf2f(bf16_t b) { return __uint_as_float(((unsigned)b) << 16); }
__device__ __forceinline__ bf16_t f2bf(float f) { return (bf16_t)(pg8::cvt_pk_bf16(f, 0.f) & 0xffffu); }
__device__ __forceinline__ float sigmoid_f(float x) { return __builtin_amdgcn_rcpf(1.f + __expf(-x)); }
__device__ __forceinline__ float silu_f(float x) { return x * __builtin_amdgcn_rcpf(1.f + __expf(-x)); }
template <int CTRL> __device__ __forceinline__ float dpp_add(float v) { return v + __int_as_float(__builtin_amdgcn_update_dpp(0, __float_as_int(v), CTRL, 0xF, 0xF, true)); }
__device__ __forceinline__ float reduce8(float o) { o = dpp_add<0xB1>(o); o = dpp_add<0x4E>(o); o = dpp_add<0x141>(o); return o; }
__device__ __forceinline__ float reduce16(float o) { return dpp_add<0x140>(reduce8(o)); }
__device__ __forceinline__ float logsigmoid_f(float z) { return fminf(z, 0.f) - log1pf(__expf(-fabsf(z))); }
__device__ __forceinline__ void unpack8(const u32x4 w, float (&f)[8]) {
    f[0] = bflo(w.x); f[1] = bfhi(w.x); f[2] = bflo(w.y); f[3] = bfhi(w.y); f[4] = bflo(w.z); f[5] = bfhi(w.z); f[6] = bflo(w.w); f[7] = bfhi(w.w);
}
__device__ __forceinline__ u32x4 pack8(const float (&f)[8]) {
    u32x4 w; w.x = pg8::cvt_pk_bf16(f[0], f[1]); w.y = pg8::cvt_pk_bf16(f[2], f[3]); w.z = pg8::cvt_pk_bf16(f[4], f[5]); w.w = pg8::cvt_pk_bf16(f[6], f[7]); return w;
}

__device__ __forceinline__ float row_rs(const float* ssb, int row) {
    const f32x4* q = (const f32x4*)(ssb + (size_t)row * 16);
    const f32x4 a = q[0], b = q[1], c = q[2], d = q[3];
    const float s = ((a[0] + a[1]) + (a[2] + a[3])) + ((b[0] + b[1]) + (b[2] + b[3])) + ((c[0] + c[1]) + (c[2] + c[3])) + ((d[0] + d[1]) + (d[2] + d[3]));
    return rsqrtf(s * (1.0f / 1024.0f) + EPS);
}
__device__ __forceinline__ void panel_rs(const float* ss, LAS float* rsl, int& cur_pm, int pm) {
    if (pm != cur_pm) {
        cur_pm = pm;
        if (threadIdx.x < 256) rsl[threadIdx.x] = row_rs(ss, pm * 256 + (int)threadIdx.x);
        asm volatile("s_waitcnt lgkmcnt(0)" ::: "memory");
        __builtin_amdgcn_s_barrier();
        asm volatile("" ::: "memory");
    }
}
struct EpiSwiGLU {
    static constexpr bool PERM = true, AFTER_DRAIN = false;
    bf16_t* G; const float* ss; LAS float* rsl; mutable int cur_pm;
    __device__ __forceinline__ void operator()(const f32x4 (&acc)[2][2][4][2], const pg8::Unit& u, int wr, int wc, int fr, int fq) const {
        const int row0 = u.pm * 256 + wr * 64 + fr, col0 = u.pn * 128 + wc * 32 + 8 * fq;
        panel_rs(ss, rsl, cur_pm, u.pm);
        float rsv[2][4];
#pragma unroll
        for (int ai = 0; ai < 2; ++ai)
#pragma unroll
            for (int m = 0; m < 4; ++m) rsv[ai][m] = rsl[wr * 64 + fr + ai * 128 + m * 16];
#pragma unroll
        for (int ai = 0; ai < 2; ++ai)
#pragma unroll
            for (int m = 0; m < 4; ++m) {
                const int row = row0 + ai * 128 + m * 16;
                const float rs = rsv[ai][m];
                float o[8];
#pragma unroll
                for (int n = 0; n < 2; ++n)
#pragma unroll
                    for (int j = 0; j < 4; ++j) { const float g = acc[ai][0][m][n][j] * rs, uu = acc[ai][1][m][n][j] * rs; o[n * 4 + j] = silu_f(g) * uu; }
                *(u32x4*)(G + (size_t)row * 2816 + col0) = pack8(o);
            }
    }
};
struct EpiResid {
    static constexpr bool PERM = true, AFTER_DRAIN = false;
    bf16_t* xb; float* ssn; float scale;
    __device__ __forceinline__ void operator()(const f32x4 (&acc)[2][2][4][2], const pg8::Unit& u, int wr, int wc, int fr, int fq) const {
        const int row0 = u.pm * 256 + wr * 64 + fr, col0 = u.pn * 256 + wc * 32 + 8 * fq;
        u32x4 rr[2][4][2];
#pragma unroll
        for (int ai = 0; ai < 2; ++ai)
#pragma unroll
            for (int m = 0; m < 4; ++m)
#pragma unroll
                for (int bj = 0; bj < 2; ++bj) rr[ai][m][bj] = *(const u32x4*)(xb + (size_t)(row0 + ai * 128 + m * 16) * 1024 + col0 + bj * 128);
#pragma unroll
        for (int ai = 0; ai < 2; ++ai)
#pragma unroll
            for (int m = 0; m < 4; ++m) {
                const int row = row0 + ai * 128 + m * 16;
                float part = 0.f;
#pragma unroll
                for (int bj = 0; bj < 2; ++bj) {
                    float r[8], h[8];
                    unpack8(rr[ai][m][bj], r);
#pragma unroll
                    for (int n = 0; n < 2; ++n)
#pragma unroll
                        for (int j = 0; j < 4; ++j) { h[n * 4 + j] = fmaf(acc[ai][bj][m][n][j], scale, r[n * 4 + j]); part = fmaf(h[n * 4 + j], h[n * 4 + j], part); }
                    *(u32x4*)(xb + (size_t)row * 1024 + col0 + bj * 128) = pack8(h);
                }
                part += __shfl_xor(part, 16); part += __shfl_xor(part, 32);
                if (fq == 0) ssn[(size_t)row * 16 + (u.pn * 4 + wc)] = part;
            }
    }
};
struct EpiProj {
    static constexpr bool PERM = true, AFTER_DRAIN = false;
    bf16_t* P; int ld; const float* ss; LAS float* rsl; mutable int cur_pm;
    __device__ __forceinline__ void operator()(const f32x4 (&acc)[2][2][4][2], const pg8::Unit& u, int wr, int wc, int fr, int fq) const {
        const int row0 = u.pm * 256 + wr * 64 + fr, col0 = u.pn * 256 + wc * 32 + 8 * fq;
        if (ss) panel_rs(ss, rsl, cur_pm, u.pm);
        float rsv[2][4];
#pragma unroll
        for (int ai = 0; ai < 2; ++ai)
#pragma unroll
            for (int m = 0; m < 4; ++m) rsv[ai][m] = ss ? rsl[wr * 64 + fr + ai * 128 + m * 16] : 1.0f;
#pragma unroll
        for (int ai = 0; ai < 2; ++ai)
#pragma unroll
            for (int m = 0; m < 4; ++m) {
                const int row = row0 + ai * 128 + m * 16;
                const float rs = rsv[ai][m];
#pragma unroll
                for (int bj = 0; bj < 2; ++bj) {
                    float o[8];
#pragma unroll
                    for (int n = 0; n < 2; ++n)
#pragma unroll
                        for (int j = 0; j < 4; ++j) o[n * 4 + j] = acc[ai][bj][m][n][j] * rs;
                    *(u32x4*)(P + (size_t)row * ld + col0 + bj * 128) = pack8(o);
                }
            }
    }
};
template <class Epi> __device__ __forceinline__ void run_gemm(ldsp_t lds, const bf16_t* A, const bf16_t* Bt, int N, int K, const Epi& E) {
    pg8::Gemm g{A, Bt, M, N, K}; pg8::StaticOrder S; S.init(M, N, (int)gridDim.x, (int)blockIdx.x);
    pg8::gemm_phase<Epi, pg8::StaticOrder>(lds, g, S, E, nullptr);
}

struct CvtJob { const float* src; const float* scale; bf16_t* dst; int K, N, mode; };
__device__ __forceinline__ void get_job(const Params& p, int j, CvtJob& J) {
    unsigned char* ws = p.ws;
    if (j < 4) { const int l = j >> 1, f = j & 1; J.src = (f ? p.in[6] : p.in[2]) + (size_t)l * 1024 * 5632; J.scale = (f ? p.in[5] : p.in[1]) + l * 1024;
        J.dst = (bf16_t*)(ws + WS_WGU + (size_t)j * SZ_WGU); J.K = 1024; J.N = 5632; J.mode = 1; }
    else if (j < 8) { const int jj = j - 4, l = jj >> 1, f = jj & 1; J.src = (f ? p.in[7] : p.in[3]) + (size_t)l * 2816 * 1024; J.scale = nullptr;
        J.dst = (bf16_t*)(ws + WS_WD + (size_t)jj * SZ_WD); J.K = 2816; J.N = 1024; J.mode = 0; }
    else if (j == 8) { J.src = p.in[8]; J.scale = p.in[4]; J.dst = (bf16_t*)(ws + WS_EWIN); J.K = 1024; J.N = 3600; J.mode = 0; }
    else if (j == 9) { J.src = p.in[13]; J.scale = p.in[4] + 1024; J.dst = (bf16_t*)(ws + WS_OWIN); J.K = 1024; J.N = 2568; J.mode = 0; }
    else if (j == 10) { J.src = p.in[12]; J.scale = nullptr; J.dst = (bf16_t*)(ws + WS_EWOUT); J.K = 1024; J.N = 1024; J.mode = 0; }
    else { J.src = p.in[28]; J.scale = nullptr; J.dst = (bf16_t*)(ws + WS_OWOUT); J.K = 1024; J.N = 1024; J.mode = 0; }
}
__device__ __forceinline__ void cvt_tile_load(const Params& p, int t, int tid, f32x4& v0, f32x4& v1, float& s0, float& s1, bf16_t*& dst) {
    int j, tt;
    if (t < 5632) { j = t / 1408; tt = t % 1408; }
    else if (t < 8448) { j = 4 + (t - 5632) / 704; tt = (t - 5632) % 704; }
    else if (t < 9344) { j = 8; tt = t - 8448; }
    else if (t < 10048) { j = 9; tt = t - 9344; }
    else if (t < 10304) { j = 10; tt = t - 10048; }
    else { j = 11; tt = t - 10304; }
    CvtJob J; get_job(p, j, J);
    const int kbn = J.K >> 6, nb = tt / kbn, kb = tt % kbn;
    const int srccol0 = (J.mode == 1) ? (((nb & 3) < 2) ? 128 * (nb >> 2) + 64 * (nb & 3) : 2816 + 128 * (nb >> 2) + 64 * ((nb & 3) - 2)) : 64 * nb;
    const int r = tid >> 4, col = srccol0 + (tid & 15) * 4, k0 = kb * 64 + r;
    v0 = (f32x4){0.f, 0.f, 0.f, 0.f}; v1 = v0;
    if (col < J.N) { v0 = *(const f32x4*)(J.src + (size_t)k0 * J.N + col); v1 = *(const f32x4*)(J.src + (size_t)(k0 + 32) * J.N + col); }
    s0 = J.scale ? J.scale[k0] : 1.0f; s1 = J.scale ? J.scale[k0 + 32] : 1.0f;
    dst = J.dst + (size_t)(nb * 64 + (tid >> 3)) * J.K + kb * 64 + (tid & 7) * 8;
}
__device__ __forceinline__ void phase_prep(const Params& p, ldsp_t lds) {
    const int tid = threadIdx.x, lane = tid & 63, w = tid >> 6;
    LAS float* tb = (LAS float*)lds;
    {
        f32x4 v0, v1; float s0, s1; bf16_t* dst;
        int t = blockIdx.x;
        if (t < 10560) cvt_tile_load(p, t, tid, v0, v1, s0, s1, dst);
        for (; t < 10560; t += gridDim.x) {
            { const int r = tid >> 4, c4 = (tid & 15) * 4;
              tb[r * 65 + c4 + 0] = v0[0] * s0; tb[r * 65 + c4 + 1] = v0[1] * s0; tb[r * 65 + c4 + 2] = v0[2] * s0; tb[r * 65 + c4 + 3] = v0[3] * s0;
              tb[(r + 32) * 65 + c4 + 0] = v1[0] * s1; tb[(r + 32) * 65 + c4 + 1] = v1[1] * s1; tb[(r + 32) * 65 + c4 + 2] = v1[2] * s1; tb[(r + 32) * 65 + c4 + 3] = v1[3] * s1; }
            __syncthreads();
            bf16_t* const dcur = dst;
            if (t + (int)gridDim.x < 10560) cvt_tile_load(p, t + (int)gridDim.x, tid, v0, v1, s0, s1, dst);
            { const int nl = tid >> 3, kc = (tid & 7) * 8;
              float o[8];
#pragma unroll
              for (int e = 0; e < 8; ++e) o[e] = tb[(kc + e) * 65 + nl];
              *(u32x4*)dcur = pack8(o); }
            __syncthreads();
        }
    }
    {
        const float* x = p.in[0]; bf16_t* XB = (bf16_t*)(p.ws + WS_XB); float* SS = (float*)(p.ws + WS_SS);
        for (int row = blockIdx.x * 8 + w; row < M; row += gridDim.x * 8) {
            const f32x4* xr = (const f32x4*)(x + (size_t)row * 1024);
            float ss = 0.f;
#pragma unroll
            for (int i = 0; i < 4; ++i) {
                const f32x4 v = xr[lane + 64 * i];
                ss += (v[0] * v[0] + v[1] * v[1]) + (v[2] * v[2] + v[3] * v[3]);
                u32x2 pk; pk.x = pg8::cvt_pk_bf16(v[0], v[1]); pk.y = pg8::cvt_pk_bf16(v[2], v[3]);
                *(u32x2*)(XB + (size_t)row * 1024 + (lane + 64 * i) * 4) = pk;
            }
#pragma unroll
            for (int o = 32; o >= 1; o >>= 1) ss += __shfl_xor(ss, o);
            if (lane < 16) SS[(size_t)row * 16 + lane] = (lane == 0) ? ss : 0.f;
        }
    }
    {
        float* rc = (float*)(p.ws + WS_ROPE); float* rsn = rc + 4096 * 64;
        for (int i = blockIdx.x * 512 + tid; i < 4096 * 64; i += gridDim.x * 512) {
            const int pos = i >> 6, j = i & 63;
            const float inv = exp2f(-(float)j * (13.287712379549449f / 64.0f));
            double rev = (double)pos * (double)inv * 0.15915494309189535;
            rev -= rint(rev);
            const float r = (float)(rev * 6.283185307179586);
            rc[i] = cosf(r); rsn[i] = sinf(r);
        }
    }
    {
        bf16_t* W = (bf16_t*)(p.ws + WS_EWIN) + (size_t)3584 * 1024;
        for (int i = blockIdx.x * 512 + tid; i < 256 * 1024; i += gridDim.x * 512) {
            const int c = i >> 10, k = i & 1023;
            const float* wr = p.in[8] + (size_t)k * 3600 + 3584;
            float acc = 0.f;
#pragma unroll
            for (int r = 0; r < 16; ++r) acc = fmaf(wr[r], p.in[9][r * 256 + c], acc);
            W[i] = f2bf(acc * p.in[4][k]);
        }
    }
    {
        bf16_t* W = (bf16_t*)(p.ws + WS_MLQK);
        for (int i = blockIdx.x * 512 + tid; i < 1024 * 512; i += gridDim.x * 512) {
            const int n = i >> 9, k = i & 511, h = (n & 511) >> 7, j = n & 127;
            float v = 0.f;
            if ((k >> 7) == h) v = (n < 512) ? p.in[23][h * 16384 + (k & 127) * 128 + j] : p.in[24][h * 16384 + (k & 127) * 128 + j] * 0.08838834764831845f;
            W[i] = f2bf(v);
        }
    }
}

#define MIX_FMA8(S, ka, kb, vv) do { S[0] = fmaf(ka[0], vv, S[0]); S[1] = fmaf(ka[1], vv, S[1]); S[2] = fmaf(ka[2], vv, S[2]); S[3] = fmaf(ka[3], vv, S[3]); \
    S[4] = fmaf(kb[0], vv, S[4]); S[5] = fmaf(kb[1], vv, S[5]); S[6] = fmaf(kb[2], vv, S[6]); S[7] = fmaf(kb[3], vv, S[7]); } while (0)
#define MIX_DOT8(o, S, qa, qb) do { o = qa[0] * S[0]; o = fmaf(qa[1], S[1], o); o = fmaf(qa[2], S[2], o); o = fmaf(qa[3], S[3], o); \
    o = fmaf(qb[0], S[4], o); o = fmaf(qb[1], S[5], o); o = fmaf(qb[2], S[6], o); o = fmaf(qb[3], S[7], o); } while (0)

typedef short s16x4 __attribute__((ext_vector_type(4)));
__device__ __forceinline__ bf16x8 tr_frag(const LAS bf16_t* T, int LD, int c16, int ks, int lane) {
    const int g = lane >> 4, q = (lane & 15) >> 2, pp = lane & 3;
    const LAS bf16_t* a0 = T + (32 * ks + 8 * g + q) * LD + 16 * c16 + 4 * pp;
    const s16x4 lo = __builtin_amdgcn_ds_read_tr16_b64_v4i16((LAS s16x4*)a0);
    const s16x4 hi = __builtin_amdgcn_ds_read_tr16_b64_v4i16((LAS s16x4*)(a0 + 4 * LD));
    return (bf16x8){lo[0], lo[1], lo[2], lo[3], hi[0], hi[1], hi[2], hi[3]};
}
__device__ __forceinline__ bf16x8 row_frag(const LAS bf16_t* T, int LD, int r16, int kk, int fr, int fq) {
    return *(const LAS bf16x8*)(T + (16 * r16 + fr) * LD + 32 * kk + 8 * fq);
}
__device__ __forceinline__ void st_bf16x4(LAS bf16_t* dst, const f32x4 v) { u32x2 pk; pk.x = pg8::cvt_pk_bf16(v[0], v[1]); pk.y = pg8::cvt_pk_bf16(v[2], v[3]); *(LAS u32x2*)dst = pk; }

template <int CTRL> __device__ __forceinline__ float dpp_mov_old(float oldv, float v) { return __int_as_float(__builtin_amdgcn_update_dpp(__float_as_int(oldv), __float_as_int(v), CTRL, 0xF, 0xF, false)); }
__device__ __forceinline__ float readlane_f(float v, int l) { return __int_as_float(__builtin_amdgcn_readlane(__float_as_int(v), l)); }
__device__ __forceinline__ float wave_scan_add(float x, int lane) {
    x += dpp_mov_old<0x111>(0.f, x); x += dpp_mov_old<0x112>(0.f, x); x += dpp_mov_old<0x114>(0.f, x); x += dpp_mov_old<0x118>(0.f, x);
    const float t0 = readlane_f(x, 15), t1 = readlane_f(x, 31), t2 = readlane_f(x, 47);
    const int row = lane >> 4;
    return x + ((row >= 1 ? t0 : 0.f) + (row >= 2 ? t1 : 0.f) + (row >= 3 ? t2 : 0.f));
}
__device__ __forceinline__ float wave_scan_max(float x, int lane) {
    const float ninf = -__builtin_huge_valf();
    x = fmaxf(x, dpp_mov_old<0x111>(ninf, x)); x = fmaxf(x, dpp_mov_old<0x112>(ninf, x)); x = fmaxf(x, dpp_mov_old<0x114>(ninf, x)); x = fmaxf(x, dpp_mov_old<0x118>(ninf, x));
    const float t0 = readlane_f(x, 15), t1 = readlane_f(x, 31), t2 = readlane_f(x, 47);
    const int row = lane >> 4;
    const float pre = fmaxf(row >= 1 ? t0 : ninf, fmaxf(row >= 2 ? t1 : ninf, row >= 3 ? t2 : ninf));
    return fmaxf(x, pre);
}
__device__ __forceinline__ float logsigmoid_fast(float z) { return fminf(z, 0.f) - __logf(1.0f + __expf(-fabsf(z))); }
template <int DK, int MODE>
__device__ __forceinline__ void mfma_chunk_p(const LAS bf16_t* Qb, const LAS bf16_t* Kb, LAS bf16_t* Pb, LAS float* DP, int w, int lane) {
    constexpr int LD = DK + 8, PLD = 72, KS = DK / 32;
    const int fr = lane & 15, fq = lane >> 4, ts = w & 3;
#pragma unroll
    for (int tt = 0; tt < 2; ++tt) {
        const int tl = 2 * (w >> 2) + tt;
        f32x4 acc = (f32x4){0.f, 0.f, 0.f, 0.f};
        if (ts <= tl) {
            bf16x8 kf[KS], qf[KS];
#pragma unroll
            for (int kk = 0; kk < KS; ++kk) { kf[kk] = row_frag(Kb, LD, ts, kk, fr, fq); qf[kk] = row_frag(Qb, LD, tl, kk, fr, fq); }
            __builtin_amdgcn_s_setprio(1);
#pragma unroll
            for (int kk = 0; kk < KS; ++kk) acc = __builtin_amdgcn_mfma_f32_16x16x32_bf16(kf[kk], qf[kk], acc, 0, 0, 0);
            __builtin_amdgcn_s_setprio(0);
            if (ts == tl) {
#pragma unroll
                for (int r = 0; r < 4; ++r) if (4 * fq + r > fr) acc[r] = 0.f;
            }
        }
        st_bf16x4(Pb + (16 * tl + fr) * PLD + 16 * ts + 4 * fq, acc);
        if (MODE == 2) { float part = (acc[0] + acc[1]) + (acc[2] + acc[3]); part += __shfl_xor(part, 16); part += __shfl_xor(part, 32); if (fq == 0) DP[ts * 64 + 16 * tl + fr] = part; }
    }
}
template <int DK, int MODE>
__device__ __forceinline__ void mfma_chunk_os(const LAS bf16_t* Qb, const LAS bf16_t* Kb, const LAS bf16_t* Vb, LAS bf16_t* STb, const LAS bf16_t* Pb, f32x4 (&Sacc)[DK / 32],
                                              bf16_t* orow, int ldo, int tile, float cs, float qscv, const LAS float* EBE, int w, int lane, int hv) {
    constexpr int LD = DK + 8, PLD = 72, KS = DK / 32, DTH = DK / 32;
    const int fr = lane & 15, fq = lane >> 4, vt = w & 3, hh = w >> 2, vabs = hv * 4 + vt;
    const bf16x8 vt0 = tr_frag(Vb, 136, vabs, 0, lane), vt1 = tr_frag(Vb, 136, vabs, 1, lane);
    bf16x8 st[KS];
#pragma unroll
    for (int kk = 0; kk < KS; ++kk) st[kk] = row_frag(STb + (tile & 1) * 64 * LD, LD, vt, kk, fr, fq);
#pragma unroll
    for (int tt = 0; tt < 2; ++tt) {
        const int tl = 2 * hh + tt;
        f32x4 accP = (f32x4){0.f, 0.f, 0.f, 0.f}, accS = (f32x4){0.f, 0.f, 0.f, 0.f};
        accP = __builtin_amdgcn_mfma_f32_16x16x32_bf16(vt0, *(const LAS bf16x8*)(Pb + (16 * tl + fr) * PLD + 8 * fq), accP, 0, 0, 0);
        accP = __builtin_amdgcn_mfma_f32_16x16x32_bf16(vt1, *(const LAS bf16x8*)(Pb + (16 * tl + fr) * PLD + 32 + 8 * fq), accP, 0, 0, 0);
        if (tile > 0) {
#pragma unroll
            for (int kk = 0; kk < KS; ++kk) accS = __builtin_amdgcn_mfma_f32_16x16x32_bf16(st[kk], row_frag(Qb, LD, tl, kk, fr, fq), accS, 0, 0, 0);
        }
        f32x4 o;
        if (MODE == 2) { const float qs = __shfl(qscv, 16 * tl + fr); o = (accP + accS * cs) * qs; } else o = accP + accS;
        u32x2 pk; pk.x = pg8::cvt_pk_bf16(o[0], o[1]); pk.y = pg8::cvt_pk_bf16(o[2], o[3]);
        *(u32x2*)(orow + (size_t)(tile * 64 + 16 * tl + fr) * ldo) = pk;
    }
    bf16x8 ktf[DTH][2];
#pragma unroll
    for (int i = 0; i < DTH; ++i) { ktf[i][0] = tr_frag(Kb, LD, hh * DTH + i, 0, lane); ktf[i][1] = tr_frag(Kb, LD, hh * DTH + i, 1, lane); }
#pragma unroll
    for (int i = 0; i < DTH; ++i) {
        const int dt = hh * DTH + i;
        if (MODE == 2) Sacc[i] = Sacc[i] * cs;
        __builtin_amdgcn_s_setprio(1);
        Sacc[i] = __builtin_amdgcn_mfma_f32_16x16x32_bf16(ktf[i][0], vt0, Sacc[i], 0, 0, 0);
        Sacc[i] = __builtin_amdgcn_mfma_f32_16x16x32_bf16(ktf[i][1], vt1, Sacc[i], 0, 0, 0);
        __builtin_amdgcn_s_setprio(0);
        if (MODE == 1) Sacc[i] = Sacc[i] * *(const LAS f32x4*)(EBE + 16 * dt + 4 * fq);
        if (MODE == 0) Sacc[i] = Sacc[i] * cs;
        st_bf16x4(STb + ((tile + 1) & 1) * 64 * LD + (16 * vt + fr) * LD + 16 * dt + 4 * fq, Sacc[i]);
    }
}

__device__ __forceinline__ void mix_retention_mfma(const Params& p, ldsp_t lds, int item) {
    const int b = item >> 3, h = (item >> 1) & 3, hv = item & 1;
    constexpr int LD = 136, PLD = 72;
    LAS bf16_t* Qb = (LAS bf16_t*)lds; LAS bf16_t* Kb = Qb + 64 * LD; LAS bf16_t* Vb = Kb + 64 * LD; LAS bf16_t* STb = Vb + 64 * LD; LAS bf16_t* Pb = STb + 128 * LD;
    const int tid = threadIdx.x, lane = tid & 63, w = __builtin_amdgcn_readfirstlane(tid >> 6), fq = lane >> 4;
    const int sj = tid >> 3, sc = tid & 7;
    bf16_t* P = (bf16_t*)(p.ws + WS_R);
    const float* ropec = (const float*)(p.ws + WS_ROPE); const float* ropes = ropec + 4096 * 64;
    const float l2g = log2f(1.0f - exp2f(-5.0f - (float)h));
    const float gT = exp2f(64.0f * l2g);
    const float dq = exp2f((float)(sj + 1) * l2g), dkk = exp2f(-(float)(sj + 1) * l2g) * 0.08838834764831845f;
    const bf16_t* qrow = P + ((size_t)b * 4096 + sj) * NPE + h * 128 + sc * 8;
    bf16_t* orow = P + ((size_t)b * 4096) * NPE + 1024 + h * 128 + 16 * (hv * 4 + (w & 3)) + 4 * fq;
    f32x4 Sacc[4];
#pragma unroll
    for (int i = 0; i < 4; ++i) Sacc[i] = (f32x4){0.f, 0.f, 0.f, 0.f};
    u32x4 rq1, rq2, rk1, rk2, rv; f32x4 c0, c1, s0, s1;
#define RETM_LOAD(t0) do { const bf16_t* qp_ = qrow + (size_t)(t0) * NPE; rq1 = *(const u32x4*)qp_; rq2 = *(const u32x4*)(qp_ + 64); rk1 = *(const u32x4*)(qp_ + 512); rk2 = *(const u32x4*)(qp_ + 576); \
        rv = *(const u32x4*)(qp_ + 1024 + hv * 64); \
        const float* cp_ = ropec + ((t0) + sj) * 64 + sc * 8; c0 = *(const f32x4*)cp_; c1 = *(const f32x4*)(cp_ + 4); \
        const float* sp_ = ropes + ((t0) + sj) * 64 + sc * 8; s0 = *(const f32x4*)sp_; s1 = *(const f32x4*)(sp_ + 4); } while (0)
    RETM_LOAD(0);
    for (int tile = 0; tile < 64; ++tile) {
        {
            float a[8], bb[8], o1[8], o2[8];
            unpack8(rq1, a); unpack8(rq2, bb);
#pragma unroll
            for (int i = 0; i < 4; ++i) { o1[i] = (a[i] * c0[i] - bb[i] * s0[i]) * dq; o2[i] = (a[i] * s0[i] + bb[i] * c0[i]) * dq;
                                          o1[4 + i] = (a[4 + i] * c1[i] - bb[4 + i] * s1[i]) * dq; o2[4 + i] = (a[4 + i] * s1[i] + bb[4 + i] * c1[i]) * dq; }
            *(LAS u32x4*)(Qb + sj * LD + sc * 8) = pack8(o1); *(LAS u32x4*)(Qb + sj * LD + 64 + sc * 8) = pack8(o2);
            unpack8(rk1, a); unpack8(rk2, bb);
#pragma unroll
            for (int i = 0; i < 4; ++i) { o1[i] = (a[i] * c0[i] - bb[i] * s0[i]) * dkk; o2[i] = (a[i] * s0[i] + bb[i] * c0[i]) * dkk;
                                          o1[4 + i] = (a[4 + i] * c1[i] - bb[4 + i] * s1[i]) * dkk; o2[4 + i] = (a[4 + i] * s1[i] + bb[4 + i] * c1[i]) * dkk; }
            *(LAS u32x4*)(Kb + sj * LD + sc * 8) = pack8(o1); *(LAS u32x4*)(Kb + sj * LD + 64 + sc * 8) = pack8(o2);
            *(LAS u32x4*)(Vb + sj * LD + hv * 64 + sc * 8) = rv;
        }
        __syncthreads();
        if (tile + 1 < 64) RETM_LOAD((tile + 1) * 64);
        mfma_chunk_p<128, 0>(Qb, Kb, Pb, nullptr, w, lane);
        __syncthreads();
        mfma_chunk_os<128, 0>(Qb, Kb, Vb, STb, Pb, Sacc, orow, NPE, tile, gT, 1.0f, nullptr, w, lane, hv);
        __syncthreads();
    }
#undef RETM_LOAD
}

template <int ROLE>
__device__ __forceinline__ void mix_mlstm_mfma(const Params& p, ldsp_t lds, int item) {
    const int b = (ROLE == 0) ? (item >> 3) : (item >> 2), h = (ROLE == 0) ? ((item >> 1) & 3) : (item & 3), hv = (ROLE == 0) ? (item & 1) : 0;
    constexpr int LD = 136, PLD = 72;
    LAS bf16_t* Qb = (LAS bf16_t*)lds; LAS bf16_t* Kb = Qb + 64 * LD; LAS bf16_t* Vb = Kb + 64 * LD; LAS bf16_t* STb = Vb + 64 * LD; LAS bf16_t* Pb = STb + 128 * LD;
    LAS float* DP = (LAS float*)(Pb + 64 * PLD); LAS float* NV = DP + 256; LAS float* KS = NV + 128;
    const int tid = threadIdx.x, lane = tid & 63, w = __builtin_amdgcn_readfirstlane(tid >> 6), fq = lane >> 4;
    const int sj = tid >> 3, sc = tid & 7;
    bf16_t* P = (bf16_t*)(p.ws + WS_R); const bf16_t* QKB = (const bf16_t*)(p.ws + WS_QKB);
    float* DEN = (float*)(p.ws + WS_DEN); float* EN = (float*)(p.ws + WS_EN);
    const bf16_t* qrow = QKB + ((size_t)b * 4096 + sj) * 1024 + h * 128 + sc * 8;
    const bf16_t* vrow = P + ((size_t)b * 4096 + sj) * NPO + 1536 + h * 128 + hv * 64 + sc * 8;
    const bf16_t* irow = P + ((size_t)b * 4096 + lane) * NPO + 2560 + h;
    bf16_t* orow = P + ((size_t)b * 4096) * NPO + 1536 + h * 128 + 16 * (hv * 4 + (w & 3)) + 4 * fq;
    const float bi = p.in[25][h], bfv = p.in[26][h];
    float m_prev = 0.f;
    f32x4 Sacc[4];
#pragma unroll
    for (int i = 0; i < 4; ++i) Sacc[i] = (f32x4){0.f, 0.f, 0.f, 0.f};
    if (ROLE == 1 && tid < 128) NV[tid] = 0.f;
    u32x4 rq1, rq2, rk1, rk2, rv1 = (u32x4){0u, 0u, 0u, 0u}; bf16_t ri, rf;
#define MLM_LOAD(t0) do { const bf16_t* qp_ = qrow + (size_t)(t0) * 1024; rq1 = *(const u32x4*)qp_; rq2 = *(const u32x4*)(qp_ + 64); rk1 = *(const u32x4*)(qp_ + 512); rk2 = *(const u32x4*)(qp_ + 576); \
        if (ROLE == 0) { rv1 = *(const u32x4*)(vrow + (size_t)(t0) * NPO); } \
        ri = irow[(size_t)(t0) * NPO]; rf = irow[(size_t)(t0) * NPO + 4]; } while (0)
    MLM_LOAD(0);
    for (int tile = 0; tile < 64; ++tile) {
        float wv, qscv, env, cs;
        {
            const float fi = bf2f(ri) + bi, lf = logsigmoid_f(bf2f(rf) + bfv);
            const float F = wave_scan_add(lf, lane);
            const float g = fi - F;
            const float pm = wave_scan_max(g, lane);
            const float Mj = fmaxf(m_prev, pm);
            const float mu = readlane_f(Mj, 63);
            wv = __expf(g - mu); qscv = __expf(mu - Mj); env = __expf(-(F + Mj)); cs = __expf(m_prev - mu);
            m_prev = readlane_f(F, 63) + mu;
        }
        {
            const float wvs = __shfl(wv, sj);
            float a[8];
            *(LAS u32x4*)(Qb + sj * LD + sc * 8) = rq1; *(LAS u32x4*)(Qb + sj * LD + 64 + sc * 8) = rq2;
            unpack8(rk1, a);
#pragma unroll
            for (int i = 0; i < 8; ++i) a[i] *= wvs;
            *(LAS u32x4*)(Kb + sj * LD + sc * 8) = pack8(a);
            unpack8(rk2, a);
#pragma unroll
            for (int i = 0; i < 8; ++i) a[i] *= wvs;
            *(LAS u32x4*)(Kb + sj * LD + 64 + sc * 8) = pack8(a);
            if (ROLE == 0) { *(LAS u32x4*)(Vb + sj * LD + hv * 64 + sc * 8) = rv1; }
        }
        __syncthreads();
        if (tile + 1 < 64) MLM_LOAD((tile + 1) * 64);
        if (ROLE == 1) {
            const int kd = tid & 127, kp = tid >> 7;
            float ks = 0.f;
#pragma unroll
            for (int s2 = 0; s2 < 16; ++s2) ks += bf2f(Kb[(kp * 16 + s2) * LD + kd]);
            KS[kp * 128 + kd] = ks;
        }
        if (ROLE == 1) mfma_chunk_p<128, 2>(Qb, Kb, Pb, DP, w, lane); else mfma_chunk_p<128, 0>(Qb, Kb, Pb, nullptr, w, lane);
        __syncthreads();
        if (ROLE == 1) {
            const int l = tid >> 3, part = tid & 7;
            float qn = 0.f;
#pragma unroll
            for (int i = 0; i < 2; ++i) { float qv[8]; unpack8(*(const LAS u32x4*)(Qb + l * LD + part * 16 + i * 8), qv);
                const f32x4 n0 = *(const LAS f32x4*)(NV + part * 16 + i * 8), n1 = *(const LAS f32x4*)(NV + part * 16 + i * 8 + 4);
                qn += qv[0] * n0[0] + qv[1] * n0[1] + qv[2] * n0[2] + qv[3] * n0[3] + qv[4] * n1[0] + qv[5] * n1[1] + qv[6] * n1[2] + qv[7] * n1[3]; }
            qn = reduce8(qn);
            const float qs_l = __shfl(qscv, l), en_l = __shfl(env, l);
            if (part == 0) {
                const float dsum = (DP[l] + DP[64 + l]) + (DP[128 + l] + DP[192 + l]);
                const size_t o = ((size_t)b * 4096 + tile * 64 + l) * 4 + h;
                DEN[o] = (dsum + cs * qn) * qs_l; EN[o] = en_l;
            }
        }
        if (ROLE == 0) mfma_chunk_os<128, 2>(Qb, Kb, Vb, STb, Pb, Sacc, orow, NPO, tile, cs, qscv, nullptr, w, lane, hv);
        __syncthreads();
        if (ROLE == 1 && tid < 128) NV[tid] = cs * NV[tid] + ((KS[tid] + KS[128 + tid]) + (KS[256 + tid] + KS[384 + tid]));
    }
#undef MLM_LOAD
}

__device__ __forceinline__ void mix_gla_mfma(const Params& p, ldsp_t lds, int item) {
    const int b = item >> 3, h = (item >> 1) & 3, hv = item & 1;
    constexpr int LD = 72, PLD = 72;
    LAS bf16_t* Qb = (LAS bf16_t*)lds; LAS bf16_t* Kb = Qb + 64 * LD; LAS bf16_t* Vb = Kb + 64 * LD; LAS bf16_t* STb = Vb + 64 * 136; LAS bf16_t* Pb = STb + 128 * LD;
    LAS float* EBE = (LAS float*)(Pb + 64 * PLD);
    const int tid = threadIdx.x, lane = tid & 63, w = __builtin_amdgcn_readfirstlane(tid >> 6), fq = lane >> 4;
    const int sj = tid >> 3, sc = tid & 7;
    bf16_t* P = (bf16_t*)(p.ws + WS_R);
    float bl[8];
    { const f32x4 b0 = *(const f32x4*)(p.in[10] + h * 64 + 8 * w), b1 = *(const f32x4*)(p.in[10] + h * 64 + 8 * w + 4);
      bl[0] = b0[0]; bl[1] = b0[1]; bl[2] = b0[2]; bl[3] = b0[3]; bl[4] = b1[0]; bl[5] = b1[1]; bl[6] = b1[2]; bl[7] = b1[3]; }
    const bf16_t* trow = P + ((size_t)b * 4096 + lane) * NPE + h * 64 + 8 * w;
    const bf16_t* vrow = P + ((size_t)b * 4096 + sj) * NPE + 2560 + h * 128 + hv * 64 + sc * 8;
    bf16_t* orow = P + ((size_t)b * 4096) * NPE + 2560 + h * 128 + 16 * (hv * 4 + (w & 3)) + 4 * fq;
    f32x4 Sacc[2];
#pragma unroll
    for (int i = 0; i < 2; ++i) Sacc[i] = (f32x4){0.f, 0.f, 0.f, 0.f};
    u32x4 rq, rk, rz, rv1;
#define GLM_LOAD(t0) do { const bf16_t* tp_ = trow + (size_t)(t0) * NPE; rq = *(const u32x4*)(tp_ + 2048); rk = *(const u32x4*)(tp_ + 2304); rz = *(const u32x4*)(tp_ + 3584); \
        rv1 = *(const u32x4*)(vrow + (size_t)(t0) * NPE); } while (0)
    GLM_LOAD(0);
    for (int tile = 0; tile < 64; ++tile) {
        {
            float z[8], q[8], k[8];
            unpack8(rz, z); unpack8(rq, q); unpack8(rk, k);
#pragma unroll
            for (int i = 0; i < 8; ++i) {
                const float la = logsigmoid_fast(z[i] + bl[i]) * (1.0f / 16.0f);
                const float bs = wave_scan_add(la, lane);
                const float e = __expf(bs);
                q[i] *= e; k[i] *= 0.125f * __expf(-bs);
                if (lane == 63) EBE[8 * w + i] = e;
            }
            *(LAS u32x4*)(Qb + lane * LD + 8 * w) = pack8(q);
            *(LAS u32x4*)(Kb + lane * LD + 8 * w) = pack8(k);
            *(LAS u32x4*)(Vb + sj * 136 + hv * 64 + sc * 8) = rv1;
        }
        __syncthreads();
        if (tile + 1 < 64) GLM_LOAD((tile + 1) * 64);
        mfma_chunk_p<64, 1>(Qb, Kb, Pb, nullptr, w, lane);
        __syncthreads();
        mfma_chunk_os<64, 1>(Qb, Kb, Vb, STb, Pb, Sacc, orow, NPE, tile, 1.0f, 1.0f, EBE, w, lane, hv);
        __syncthreads();
    }
#undef GLM_LOAD
}

__device__ __forceinline__ void mix_lru_fused(const Params& p, ldsp_t lds, int item) {
    const int b = item >> 3, g = item & 7;
    constexpr int LD = 72;
    LAS bf16_t* Wg = (LAS bf16_t*)lds; LAS bf16_t* XCb = Wg + 128 * LD;
    LAS float* LAs = (LAS float*)(XCb + 64 * LD); LAS float* Us = LAs + 4096; LAS float* AA = Us + 4096; LAS float* BB = AA + 512;
    const int tid = threadIdx.x, lane = tid & 63, w = __builtin_amdgcn_readfirstlane(tid >> 6), fr = lane & 15, fq = lane >> 4;
    const int j = tid & 63, seg = tid >> 6, c = g * 64 + j;
    const int r_ = tid >> 3, cc = tid & 7, mt = w & 3;
    const bf16_t* P = (const bf16_t*)(p.ws + WS_R); bf16_t* OB = (bf16_t*)(p.ws + WS_OB);
#pragma unroll
    for (int k = 0; k < 16; ++k) { const int idx = tid + 512 * k, n = idx >> 6, i = idx & 63;
        const float v = (n < 64) ? p.in[16][g * 4096 + i * 64 + n] : p.in[18][g * 4096 + i * 64 + (n - 64)];
        Wg[n * LD + i] = f2bf(v); }
    float ba_[2][4], bx_[2][4], sp_[2][4], cw[4][8], cb[8];
#pragma unroll
    for (int q2 = 0; q2 < 2; ++q2)
#pragma unroll
        for (int r = 0; r < 4; ++r) { const int cch = g * 64 + 16 * (2 * (w >> 2) + q2) + 4 * fq + r;
            ba_[q2][r] = p.in[17][cch]; bx_[q2][r] = p.in[19][cch]; sp_[q2][r] = 8.0f * log1pf(__expf(-p.in[20][cch])); }
#pragma unroll
    for (int q = 0; q < 4; ++q) { const f32x4 a0 = *(const f32x4*)(p.in[14] + q * 512 + g * 64 + cc * 8), a1 = *(const f32x4*)(p.in[14] + q * 512 + g * 64 + cc * 8 + 4);
        cw[q][0] = a0[0]; cw[q][1] = a0[1]; cw[q][2] = a0[2]; cw[q][3] = a0[3]; cw[q][4] = a1[0]; cw[q][5] = a1[1]; cw[q][6] = a1[2]; cw[q][7] = a1[3]; }
    { const f32x4 a0 = *(const f32x4*)(p.in[15] + g * 64 + cc * 8), a1 = *(const f32x4*)(p.in[15] + g * 64 + cc * 8 + 4);
        cb[0] = a0[0]; cb[1] = a0[1]; cb[2] = a0[2]; cb[3] = a0[3]; cb[4] = a1[0]; cb[5] = a1[1]; cb[6] = a1[2]; cb[7] = a1[3]; }
    const bf16_t* lxp = P + ((size_t)b * 4096 + r_) * NPO + 512 + g * 64 + cc * 8;
    const bf16_t* lyp = P + ((size_t)b * 4096 + seg * 8) * NPO + c;
    bf16_t* obp = OB + ((size_t)b * 4096 + seg * 8) * 1024 + c;
    float hc = 0.f;
    u32x4 rx[4]; bf16_t ry[8];
#define LRF_LOAD(t0) do { _Pragma("unroll") for (int q = 0; q < 4; ++q) { rx[q] = (u32x4){0u, 0u, 0u, 0u}; if ((t0) + r_ - 3 + q >= 0) rx[q] = *(const u32x4*)(lxp + ((long)(t0) - 3 + q) * NPO); } \
        _Pragma("unroll") for (int q = 0; q < 8; ++q) ry[q] = lyp[(size_t)((t0) + q) * NPO]; } while (0)
    LRF_LOAD(0);
    for (int tile = 0; tile < 64; ++tile) {
        float lyv[8];
        {
            float acc[8];
#pragma unroll
            for (int e = 0; e < 8; ++e) acc[e] = cb[e];
#pragma unroll
            for (int q = 0; q < 4; ++q) { float x[8]; unpack8(rx[q], x);
#pragma unroll
                for (int e = 0; e < 8; ++e) acc[e] = fmaf(cw[q][e], x[e], acc[e]); }
            *(LAS u32x4*)(XCb + r_ * LD + cc * 8) = pack8(acc);
#pragma unroll
            for (int q = 0; q < 8; ++q) lyv[q] = bf2f(ry[q]);
        }
        __syncthreads();
        if (tile + 1 < 64) LRF_LOAD((tile + 1) * 64);
#pragma unroll
        for (int q2 = 0; q2 < 2; ++q2) {
            const int nt = 2 * (w >> 2) + q2;
            f32x4 accA = (f32x4){0.f, 0.f, 0.f, 0.f}, accX = (f32x4){0.f, 0.f, 0.f, 0.f};
#pragma unroll
            for (int kk = 0; kk < 2; ++kk) { const bf16x8 xf = row_frag(XCb, LD, mt, kk, fr, fq);
                accA = __builtin_amdgcn_mfma_f32_16x16x32_bf16(row_frag(Wg, LD, nt, kk, fr, fq), xf, accA, 0, 0, 0);
                accX = __builtin_amdgcn_mfma_f32_16x16x32_bf16(row_frag(Wg, LD, 4 + nt, kk, fr, fq), xf, accX, 0, 0, 0); }
            const int c0 = 16 * nt + 4 * fq;
            const u32x2 xw = *(const LAS u32x2*)(XCb + (16 * mt + fr) * LD + c0);
            const float xc4[4] = {bflo(xw.x), bfhi(xw.x), bflo(xw.y), bfhi(xw.y)};
            f32x4 lav, uv;
#pragma unroll
            for (int r = 0; r < 4; ++r) {
                const float rr = sigmoid_f(accA[r] + ba_[q2][r]), ig = sigmoid_f(accX[r] + bx_[q2][r]);
                const float la = -sp_[q2][r] * rr;
                const float x2 = 2.0f * la;
                const float om = -x2 * fmaf(x2, fmaf(x2, fmaf(x2, fmaf(x2, fmaf(x2, 1.0f / 720.0f, 1.0f / 120.0f), 1.0f / 24.0f), 1.0f / 6.0f), 0.5f), 1.0f);
                lav[r] = la; uv[r] = __builtin_amdgcn_sqrtf(om) * (ig * xc4[r]);
            }
            *(LAS f32x4*)(LAs + (16 * mt + fr) * 64 + c0) = lav; *(LAS f32x4*)(Us + (16 * mt + fr) * 64 + c0) = uv;
        }
        __syncthreads();
        float ap[8], hl[8]; float A = 1.f, hloc = 0.f;
#pragma unroll
        for (int q = 0; q < 8; ++q) { const float a = __expf(LAs[(seg * 8 + q) * 64 + j]); hloc = fmaf(a, hloc, Us[(seg * 8 + q) * 64 + j]); A *= a; ap[q] = A; hl[q] = hloc; }
        AA[seg * 64 + j] = A; BB[seg * 64 + j] = hloc;
        __syncthreads();
        float hin = hc, run = hc;
#pragma unroll
        for (int s2 = 0; s2 < 8; ++s2) { run = fmaf(AA[s2 * 64 + j], run, BB[s2 * 64 + j]); if (s2 < seg) hin = run; }
        hc = run;
#pragma unroll
        for (int q = 0; q < 8; ++q) {
            const float hv = fmaf(ap[q], hin, hl[q]);
            const float y = lyv[q];
            const float u3 = 0.7978845608028654f * (y + 0.044715f * y * y * y);
            const float th = 1.0f - 2.0f * __builtin_amdgcn_rcpf(1.0f + __expf(2.0f * u3));
            obp[(size_t)(tile * 64 + q) * 1024] = f2bf(hv * 0.5f * y * (1.0f + th));
        }
    }
#undef LRF_LOAD
}

__device__ __forceinline__ void phase_qkproj(const Params& p, ldsp_t lds) {
    constexpr int LD = 136;
    LAS bf16_t* MCb = (LAS bf16_t*)lds;
    const bf16_t* MLQK = (const bf16_t*)(p.ws + WS_MLQK); const bf16_t* P = (const bf16_t*)(p.ws + WS_R); bf16_t* QKB = (bf16_t*)(p.ws + WS_QKB);
    const int tid = threadIdx.x, lane = tid & 63, w = __builtin_amdgcn_readfirstlane(tid >> 6), fr = lane & 15, fq = lane >> 4;
    const int tp = tid >> 4, c16 = tid & 15;
    int hcur = -1;
    bf16x8 wf[2][4];
    float cw[4][8], cb[8];
    u32x4 rx[5];
#define QKP_LOAD(job_) do { const int h_ = (job_) & 3, t_ = ((job_) >> 2) * 64 + 2 * tp; const int pos_ = t_ & 4095; \
        _Pragma("unroll") for (int q = 0; q < 5; ++q) { rx[q] = (u32x4){0u, 0u, 0u, 0u}; if (pos_ - 3 + q >= 0) rx[q] = *(const u32x4*)(P + (size_t)(t_ - 3 + q) * NPO + 1024 + h_ * 128 + c16 * 8); } } while (0)
    int job = blockIdx.x;
    if (job < 2048) QKP_LOAD(job);
    for (; job < 2048; job += gridDim.x) {
        const int h = job & 3, tk0 = (job >> 2) * 64;
        if (h != hcur) {
            hcur = h;
#pragma unroll
            for (int q2 = 0; q2 < 2; ++q2) { const int n = 2 * w + q2; const int gr = (n < 8) ? (h * 128 + 16 * n + fr) : (512 + h * 128 + 16 * (n - 8) + fr);
#pragma unroll
                for (int kk = 0; kk < 4; ++kk) wf[q2][kk] = *(const bf16x8*)(MLQK + (size_t)gr * 512 + h * 128 + 32 * kk + 8 * fq); }
#pragma unroll
            for (int q = 0; q < 4; ++q) { const f32x4 a0 = *(const f32x4*)(p.in[21] + q * 512 + h * 128 + c16 * 8), a1 = *(const f32x4*)(p.in[21] + q * 512 + h * 128 + c16 * 8 + 4);
                cw[q][0] = a0[0]; cw[q][1] = a0[1]; cw[q][2] = a0[2]; cw[q][3] = a0[3]; cw[q][4] = a1[0]; cw[q][5] = a1[1]; cw[q][6] = a1[2]; cw[q][7] = a1[3]; }
            { const f32x4 a0 = *(const f32x4*)(p.in[22] + h * 128 + c16 * 8), a1 = *(const f32x4*)(p.in[22] + h * 128 + c16 * 8 + 4);
                cb[0] = a0[0]; cb[1] = a0[1]; cb[2] = a0[2]; cb[3] = a0[3]; cb[4] = a1[0]; cb[5] = a1[1]; cb[6] = a1[2]; cb[7] = a1[3]; }
        }
        {
            float x[5][8];
#pragma unroll
            for (int q = 0; q < 5; ++q) unpack8(rx[q], x[q]);
#pragma unroll
            for (int tt = 0; tt < 2; ++tt) {
                float o[8];
#pragma unroll
                for (int e = 0; e < 8; ++e) o[e] = silu_f(cb[e] + cw[0][e] * x[tt][e] + cw[1][e] * x[tt + 1][e] + cw[2][e] * x[tt + 2][e] + cw[3][e] * x[tt + 3][e]);
                *(LAS u32x4*)(MCb + (2 * tp + tt) * LD + c16 * 8) = pack8(o);
            }
        }
        __syncthreads();
        if (job + (int)gridDim.x < 2048) QKP_LOAD(job + (int)gridDim.x);
#pragma unroll
        for (int m = 0; m < 4; ++m) {
            bf16x8 af[4];
#pragma unroll
            for (int kk = 0; kk < 4; ++kk) af[kk] = row_frag(MCb, LD, m, kk, fr, fq);
#pragma unroll
            for (int q2 = 0; q2 < 2; ++q2) {
                f32x4 acc = (f32x4){0.f, 0.f, 0.f, 0.f};
#pragma unroll
                for (int kk = 0; kk < 4; ++kk) acc = __builtin_amdgcn_mfma_f32_16x16x32_bf16(wf[q2][kk], af[kk], acc, 0, 0, 0);
                const int n = 2 * w + q2;
                const int dstcol = (n < 8) ? (h * 128 + 16 * n + 4 * fq) : (512 + h * 128 + 16 * (n - 8) + 4 * fq);
                u32x2 pk; pk.x = pg8::cvt_pk_bf16(acc[0], acc[1]); pk.y = pg8::cvt_pk_bf16(acc[2], acc[3]);
                *(u32x2*)(QKB + (size_t)(tk0 + 16 * m + fr) * 1024 + dstcol) = pk;
            }
        }
        __syncthreads();
    }
#undef QKP_LOAD
}

__device__ __forceinline__ void phase_fin_even(const Params& p) {
    const bf16_t* P = (const bf16_t*)(p.ws + WS_R); bf16_t* OB = (bf16_t*)(p.ws + WS_OB); const float* hw = p.in[11];
    const int tid = threadIdx.x, lane = tid & 63, w = tid >> 6, hh = lane >> 4, l16 = lane & 15;
    for (int idx = blockIdx.x * 8 + w; idx < 2 * M; idx += gridDim.x * 8) {
        const int t = idx >> 1, grp = idx & 1;
        const bf16_t* row = P + (size_t)t * NPE;
        const int ocol = (grp ? 2560 : 1024) + hh * 128 + l16 * 8, gcol = (grp ? 3072 : 1536) + hh * 128 + l16 * 8;
        float o[8], g[8];
        unpack8(*(const u32x4*)(row + ocol), o); unpack8(*(const u32x4*)(row + gcol), g);
        float ss = 0.f;
#pragma unroll
        for (int i = 0; i < 8; ++i) ss = fmaf(o[i], o[i], ss);
        ss = reduce16(ss);
        const float rs = rsqrtf(ss * (1.0f / 128.0f) + EPS);
        const int oc = grp * 512 + hh * 128 + l16 * 8;
        const f32x4 w0 = *(const f32x4*)(hw + oc), w1 = *(const f32x4*)(hw + oc + 4);
        float y[8];
#pragma unroll
        for (int i = 0; i < 8; ++i) y[i] = o[i] * rs * silu_f(g[i]) * (i < 4 ? w0[i & 3] : w1[i & 3]);
        *(u32x4*)(OB + (size_t)t * 1024 + oc) = pack8(y);
    }
}
__device__ __forceinline__ void phase_fin_odd(const Params& p) {
    const bf16_t* P = (const bf16_t*)(p.ws + WS_R); bf16_t* OB = (bf16_t*)(p.ws + WS_OB); const float* nw = p.in[27];
    const float* DEN = (const float*)(p.ws + WS_DEN); const float* EN = (const float*)(p.ws + WS_EN);
    const int tid = threadIdx.x, lane = tid & 63, w = tid >> 6, hh = lane >> 4, l16 = lane & 15;
    for (int t = blockIdx.x * 8 + w; t < M; t += gridDim.x * 8) {
        const bf16_t* row = P + (size_t)t * NPO;
        float nu[8], g[8];
        unpack8(*(const u32x4*)(row + 1536 + hh * 128 + l16 * 8), nu); unpack8(*(const u32x4*)(row + 2048 + hh * 128 + l16 * 8), g);
        const float den = DEN[(size_t)t * 4 + hh], en = EN[(size_t)t * 4 + hh];
        const float inv = __builtin_amdgcn_rcpf(fmaxf(fabsf(den), en));
        float hm[8]; float ss = 0.f;
#pragma unroll
        for (int i = 0; i < 8; ++i) { hm[i] = sigmoid_f(g[i]) * nu[i] * inv; ss = fmaf(hm[i], hm[i], ss); }
        ss = reduce16(ss);
        const float rs = rsqrtf(ss * (1.0f / 128.0f) + EPS);
        const int oc = hh * 128 + l16 * 8;
        const f32x4 w0 = *(const f32x4*)(nw + oc), w1 = *(const f32x4*)(nw + oc + 4);
        float y[8];
#pragma unroll
        for (int i = 0; i < 8; ++i) { y[i] = hm[i] * rs * (i < 4 ? w0[i & 3] : w1[i & 3]); }
        *(u32x4*)(OB + (size_t)t * 1024 + 512 + oc) = pack8(y);
    }
}
__device__ __forceinline__ void phase_final(const Params& p) {
    float* out = p.out; const bf16_t* XB = (const bf16_t*)(p.ws + WS_XB); const float* SS = (const float*)(p.ws + WS_SS) + (size_t)6 * 16 * M; const float* fw = p.in[29];
    const int tid = threadIdx.x, lane = tid & 63, w = tid >> 6;
    for (int row = blockIdx.x * 8 + w; row < M; row += gridDim.x * 8) {
        const float rs = row_rs(SS, row);
#pragma unroll
        for (int i = 0; i < 2; ++i) {
            float h[8]; unpack8(*(const u32x4*)(XB + (size_t)row * 1024 + (lane + 64 * i) * 8), h);
            const f32x4 w0 = *(const f32x4*)(fw + (lane + 64 * i) * 8), w1 = *(const f32x4*)(fw + (lane + 64 * i) * 8 + 4);
            f32x4 o0, o1;
            o0[0] = h[0] * rs * w0[0]; o0[1] = h[1] * rs * w0[1]; o0[2] = h[2] * rs * w0[2]; o0[3] = h[3] * rs * w0[3];
            o1[0] = h[4] * rs * w1[0]; o1[1] = h[5] * rs * w1[1]; o1[2] = h[6] * rs * w1[2]; o1[3] = h[7] * rs * w1[3];
            *(f32x4*)(out + (size_t)row * 1024 + (lane + 64 * i) * 8) = o0; *(f32x4*)(out + (size_t)row * 1024 + (lane + 64 * i) * 8 + 4) = o1;
        }
    }
}

__host__ __device__ inline bool phase_active(int ph) { return !(ph == 4 || ph == 5 || ph == 15); }
constexpr int N_PHASES = 22;
__device__ __forceinline__ void load_params(Params& q, ldsp_t lds) {
    const LAS unsigned* tab = (const LAS unsigned*)(lds + 131072);
#pragma unroll
    for (int k = 0; k < 32; ++k) {
        const unsigned lo = __builtin_amdgcn_readfirstlane(tab[2 * k]), hi = __builtin_amdgcn_readfirstlane(tab[2 * k + 1]);
        const unsigned long long v = ((unsigned long long)hi << 32) | lo;
        if (k < 30) q.in[k] = (const float*)(const __attribute__((address_space(1))) float*)v; else if (k == 30) q.out = (float*)(__attribute__((address_space(1))) float*)v; else q.ws = (unsigned char*)(__attribute__((address_space(1))) unsigned char*)v;
    }
}
#define PHASE_BEGIN(k) if (lo <= (k) && (k) < hi) { asm volatile("" ::: "memory"); Params p; load_params(p, lds); unsigned char* ws = p.ws; (void)ws;
#define PHASE_END(k) if ((k) + 1 < hi) { xcd_barrier(xb); } }
template <int L> __device__ __forceinline__ void layer_phases(ldsp_t lds, cg::grid_group& grid, XcdBarrier& xb, const int lo, const int hi) {
    constexpr int B0 = 1 + 10 * L;
    PHASE_BEGIN(B0 + 0)
        { EpiSwiGLU E{(bf16_t*)(ws + WS_R), (const float*)(ws + WS_SS) + (size_t)(3 * L + 0) * 16 * M, (LAS float*)(lds + 131072 + 512), -1};
        run_gemm<EpiSwiGLU>(lds, (const bf16_t*)(ws + WS_XB), (const bf16_t*)(ws + WS_WGU + (size_t)(L * 2 + 0) * SZ_WGU), 5632, 1024, E); }
    PHASE_END(B0 + 0)
    PHASE_BEGIN(B0 + 1)
        { EpiResid E{(bf16_t*)(ws + WS_XB), (float*)(ws + WS_SS) + (size_t)(3 * L + 1) * 16 * M, 0.5f};
        run_gemm<EpiResid>(lds, (const bf16_t*)(ws + WS_R), (const bf16_t*)(ws + WS_WD + (size_t)(L * 2 + 0) * SZ_WD), 1024, 2816, E); }
    PHASE_END(B0 + 1)
    PHASE_BEGIN(B0 + 2)
        { EpiProj E{(bf16_t*)(ws + WS_R), L ? NPO : NPE, (const float*)(ws + WS_SS) + (size_t)(3 * L + 1) * 16 * M, (LAS float*)(lds + 131072 + 512), -1};
        run_gemm<EpiProj>(lds, (const bf16_t*)(ws + WS_XB), (const bf16_t*)(ws + (L ? WS_OWIN : WS_EWIN)), L ? NPO : NPE, 1024, E); }
    PHASE_END(B0 + 2)
    if (L == 1) {
        PHASE_BEGIN(B0 + 3)
            phase_qkproj(p, lds);
        PHASE_END(B0 + 3)
    }
    PHASE_BEGIN(B0 + 5)
        if (L == 0) {
            for (int it = blockIdx.x; it < 128; it += gridDim.x) { if (it < 64) mix_retention_mfma(p, lds, it); else mix_gla_mfma(p, lds, it - 64); __syncthreads(); }
        } else {
            for (int it = blockIdx.x; it < 160; it += gridDim.x) { if (it < 64) mix_mlstm_mfma<0>(p, lds, it); else if (it < 96) mix_mlstm_mfma<1>(p, lds, it - 64); else mix_lru_fused(p, lds, it - 96); __syncthreads(); }
        }
    PHASE_END(B0 + 5)
    PHASE_BEGIN(B0 + 6)
        { if (L == 0) phase_fin_even(p); else phase_fin_odd(p); }
    PHASE_END(B0 + 6)
    PHASE_BEGIN(B0 + 7)
        { EpiResid E{(bf16_t*)(ws + WS_XB), (float*)(ws + WS_SS) + (size_t)(3 * L + 2) * 16 * M, 1.0f};
        run_gemm<EpiResid>(lds, (const bf16_t*)(ws + WS_OB), (const bf16_t*)(ws + (L ? WS_OWOUT : WS_EWOUT)), 1024, 1024, E); }
    PHASE_END(B0 + 7)
    PHASE_BEGIN(B0 + 8)
        { EpiSwiGLU E{(bf16_t*)(ws + WS_R), (const float*)(ws + WS_SS) + (size_t)(3 * L + 2) * 16 * M, (LAS float*)(lds + 131072 + 512), -1};
        run_gemm<EpiSwiGLU>(lds, (const bf16_t*)(ws + WS_XB), (const bf16_t*)(ws + WS_WGU + (size_t)(L * 2 + 1) * SZ_WGU), 5632, 1024, E); }
    PHASE_END(B0 + 8)
    PHASE_BEGIN(B0 + 9)
        { EpiResid E{(bf16_t*)(ws + WS_XB), (float*)(ws + WS_SS) + (size_t)(3 * L + 3) * 16 * M, 0.5f};
        run_gemm<EpiResid>(lds, (const bf16_t*)(ws + WS_R), (const bf16_t*)(ws + WS_WD + (size_t)(L * 2 + 1) * SZ_WD), 1024, 2816, E); }
    PHASE_END(B0 + 9)
}
__global__ void __launch_bounds__(512, 2) mega(Params p0) {
    extern __shared__ __attribute__((aligned(16))) unsigned char ldsraw[];
    ldsp_t lds = (ldsp_t)ldsraw;
    cg::grid_group grid = cg::this_grid();
    if (threadIdx.x == 0) {
        LAS unsigned long long* tab = (LAS unsigned long long*)(lds + 131072);
#pragma unroll
        for (int k = 0; k < 30; ++k) tab[k] = (unsigned long long)p0.in[k];
        tab[30] = (unsigned long long)p0.out; tab[31] = (unsigned long long)p0.ws;
        LAS unsigned* st = (LAS unsigned*)(lds + 131072 + 256); st[0] = 0u; st[1] = 0u; st[2] = 0u; st[3] = 0u;
    }
    __syncthreads();
    const int lo = p0.ph_lo, hi = p0.ph_hi;
    if (hi > 1000) grid.sync();
    XcdBarrier xb; xb.bar = nullptr; xb.x = 0u; xb.st = nullptr;
    if (hi - lo > 1) xb = xcd_barrier_post((unsigned*)(p0.ws + WS_BAR), (volatile LAS unsigned*)(lds + 131072 + 256));
    PHASE_BEGIN(0)
        phase_prep(p, lds);
    PHASE_END(0)
    layer_phases<0>(lds, grid, xb, lo, hi);
    layer_phases<1>(lds, grid, xb, lo, hi);
    PHASE_BEGIN(21)
        phase_final(p);
    PHASE_END(21)
}

extern "C" void kernel_launch(void* const* d_in, const int* in_sizes, int n_in, void* d_out, int out_size, void* d_ws, size_t ws_size, hipStream_t stream) {
    static int grid = 0;
    if (grid == 0) {
        if (n_in != 30 || out_size != M * 1024 || ws_size < WS_END) { fprintf(stderr, "kernel_launch: unexpected problem (n_in %d out %d ws %zu need %zu)\n", n_in, out_size, ws_size, (size_t)WS_END); grid = -1; return; }
        int dev = 0, cus = 0, per_cu = 0;
        hipGetDevice(&dev); hipDeviceGetAttribute(&cus, hipDeviceAttributeMultiprocessorCount, dev);
        if (hipFuncSetAttribute((const void*)mega, hipFuncAttributeMaxDynamicSharedMemorySize, LDS_BYTES) != hipSuccess) { fprintf(stderr, "kernel_launch: hipFuncSetAttribute failed\n"); }
        if (hipOccupancyMaxActiveBlocksPerMultiprocessor(&per_cu, (const void*)mega, 512, LDS_BYTES) != hipSuccess || per_cu < 1) { fprintf(stderr, "kernel_launch: occupancy query says %d\n", per_cu); per_cu = 1; }
        (void)hipGetLastError();
        grid = cus * per_cu; if (grid > 256) grid = 256; if (grid < 1) grid = 256;
    }
    if (grid < 0) return;
    Params p{};
    for (int i = 0; i < 30; ++i) p.in[i] = (const float*)d_in[i];
    p.out = (float*)d_out; p.ws = (unsigned char*)d_ws;
#if MK_N_LAUNCHES == 1
    p.ph_lo = 0; p.ph_hi = N_PHASES;
    if (hipMemsetAsync((unsigned char*)d_ws + WS_BAR, 0, 16384, stream) != hipSuccess) { fprintf(stderr, "kernel_launch: hipMemsetAsync of the barrier words failed\n"); return; }
    void* args[] = {&p};
    hipError_t e = hipLaunchCooperativeKernel((const void*)mega, dim3(grid), dim3(512), args, LDS_BYTES, stream);
    if (e != hipSuccess) fprintf(stderr, "kernel_launch: cooperative launch failed: %s (grid %d)\n", hipGetErrorString(e), grid);
#else
    for (int ph = 0; ph < N_PHASES; ++ph) {
        if (!phase_active(ph)) continue;
        p.ph_lo = ph; p.ph_hi = ph + 1;
        hipLaunchKernelGGL(mega, dim3(grid), dim3(512), LDS_BYTES, stream, p);
    }
#endif
}
```

```cpp
#include <hip/hip_runtime.h>
#include <hip/hip_cooperative_groups.h>
#include <cstdio>
namespace cg = cooperative_groups;
#ifndef MK_N_LAUNCHES
#define MK_N_LAUNCHES 1
#endif
namespace pg8 {
#define PG8_LAS __attribute__((address_space(3)))
typedef unsigned short bf16_t;
typedef short bf16x8 __attribute__((ext_vector_type(8)));
typedef float f32x4 __attribute__((ext_vector_type(4)));
typedef unsigned u32x4 __attribute__((ext_vector_type(4)));
constexpr int BM = 256, BK = 64, HALF = 128, HTB = HALF * BK * 2  , STAGE_BYTES = 8 * HTB, NXCD = 8, WGM = 8;

__host__ __device__ __forceinline__ int lds_byte(int r, int c) { const int st = (r >> 4) * 2 + (c >> 5), rr = r & 15, cc = c & 31, ob = rr * 64 + cc * 2; return st * 1024 + (ob ^ (((ob >> 9) & 1) << 5)); }
__host__ __device__ __forceinline__ void stage_rc(int b, int& R, int& C) { const int st = b / 1024, sb = b % 1024, swz = sb ^ (((sb >> 9) & 1) << 5); R = (st >> 1) * 16 + swz / 64; C = (st & 1) * 32 + (swz % 64) / 2; }
__host__ __device__ __forceinline__ int perm32(int rho) { const int n = rho >> 4, i = rho & 15; return 8 * (i >> 2) + 4 * n + (i & 3); }

struct Unit { int pm, pn; };
struct Gemm { const bf16_t* A; const bf16_t* Bt; int M, N, K; };

struct StaticOrder {
    int nM, nN, nwg, G, c;
    __host__ __device__ void init(int M, int N, int G_, int c_) { nM = M / BM; nN = N / BM; nwg = nM * nN; G = G_; c = c_; }
    __host__ __device__ bool next(int i, Unit& u) const {
        const long L = (long)i * G + c; if (L >= nwg) return false;
        int wgid = (int)L; { const int q = nwg / NXCD, r = nwg % NXCD, xcd = wgid % NXCD, off = wgid / NXCD; wgid = (xcd < r ? xcd * (q + 1) : r * (q + 1) + (xcd - r) * q) + off; }
        const int nig = WGM * nN, gid = wgid / nig, fm = gid * WGM, gsz = (nM - fm) < WGM ? (nM - fm) : WGM;
        u.pm = fm + ((wgid % nig) % gsz); u.pn = (wgid % nig) / gsz; return true;
    }
    __device__ __forceinline__ void a_ready(const Unit&) const {}
    __device__ __forceinline__ void done(const Unit&) const {}
};
typedef __bf16 bf16x2_native __attribute__((ext_vector_type(2)));
__device__ __forceinline__ unsigned cvt_pk_bf16(float lo, float hi) { const bf16x2_native v = {(__bf16)lo, (__bf16)hi}; return __builtin_bit_cast(unsigned, v); }
typedef float f32x2 __attribute__((ext_vector_type(2)));
template <class Epi, class Sched, bool STAMP = false>
__device__ __forceinline__ void gemm_phase(PG8_LAS unsigned char* lds, const Gemm g, const Sched& S, const Epi& E, unsigned long long* stamps) {
    const int tid = threadIdx.x, wid = __builtin_amdgcn_readfirstlane(tid >> 6), lane = tid & 63, wr = wid >> 2, wc = wid & 3, fr = lane & 15, fq = lane >> 4;
    const int K = g.K, nt = K / BK;
    int ts_lo = 0, ts_hi = 0, nts = 0; const unsigned long long rt_entry = STAMP ? (unsigned long long)wall_clock64() : 0ull;
#define PG8_STAMP() do { if (STAMP && wid == 0 && nts < 64) { const unsigned long long _c = (unsigned long long)clock64(); \
        ts_lo = (lane == nts) ? (int)(unsigned)_c : ts_lo; ts_hi = (lane == nts) ? (int)(unsigned)(_c >> 32) : ts_hi; ++nts; } } while (0)
    PG8_STAMP();
    unsigned voffA[2], voffB[2];
#pragma unroll
    for (int i = 0; i < 2; ++i) { int R, C; stage_rc(tid * 16 + i * 8192, R, C); const int Rb = Epi::PERM ? ((R & ~31) + perm32(R & 31)) : R;
        voffA[i] = (unsigned)(R * K + C) * 2u; voffB[i] = (unsigned)(Rb * K + C) * 2u; }
    const size_t kstep = (size_t)(BK * 2);
    const size_t hstep = (size_t)HALF * K * 2;
    const size_t tstep = 2 * hstep;
    const unsigned ldsw = (unsigned)wid * 1024u;
    const int aoff = lds_byte(wr * 64 + fr, fq * 8), boff = lds_byte(wc * 32 + fr, fq * 8);
#define PG8_SA(b, h) (((b) * 2 + (h)) * HTB)
#define PG8_SB(b, h) ((4 + (b) * 2 + (h)) * HTB)
#define PG8_STAGE(bufoff, gbase, voff) do { _Pragma("unroll") for (int _i = 0; _i < 2; ++_i) \
        __builtin_amdgcn_global_load_lds((const unsigned*)((const char*)(gbase) + (voff)[_i]), (PG8_LAS unsigned*)(lds + (bufoff) + ldsw + _i * 8192), 16, 0, 0); } while (0)
#define PG8_LDA(dst, b, h) do { _Pragma("unroll") for (int m = 0; m < 4; ++m) _Pragma("unroll") for (int k = 0; k < 2; ++k) dst[m][k] = *(const PG8_LAS bf16x8*)(lds + PG8_SA(b, h) + aoff + m * 2048 + k * 1024); } while (0)
#define PG8_LDB(dst, b, h) do { _Pragma("unroll") for (int n = 0; n < 2; ++n) _Pragma("unroll") for (int k = 0; k < 2; ++k) dst[n][k] = *(const PG8_LAS bf16x8*)(lds + PG8_SB(b, h) + boff + n * 2048 + k * 1024); } while (0)
#define PG8_MMA(ai, bj, At, Bt) do { __builtin_amdgcn_s_setprio(1); _Pragma("unroll") for (int m = 0; m < 4; ++m) _Pragma("unroll") for (int n = 0; n < 2; ++n) _Pragma("unroll") for (int k = 0; k < 2; ++k) \
        acc[ai][bj][m][n] = __builtin_amdgcn_mfma_f32_16x16x32_bf16(Bt[n][k], At[m][k], acc[ai][bj][m][n], 0, 0, 0); __builtin_amdgcn_s_setprio(0); } while (0)
#define PG8_WAIT_V(n) asm volatile("s_waitcnt vmcnt(" #n ")" ::: "memory")
#define PG8_WAIT_L(n) asm volatile("s_waitcnt lgkmcnt(" #n ")" ::: "memory")
#define PG8_BAR __builtin_amdgcn_s_barrier()
#define PG8_SCHED __builtin_amdgcn_sched_barrier(0)
    Unit cur, nxt; int ui = 0;
    if (!S.next(0, cur)) return;
    f32x4 acc[2][2][4][2];
#pragma unroll
    for (int a = 0; a < 2; ++a)
#pragma unroll
        for (int b = 0; b < 2; ++b)
#pragma unroll
            for (int m = 0; m < 4; ++m)
#pragma unroll
                for (int n = 0; n < 2; ++n) acc[a][b][m][n] = (f32x4){0.f, 0.f, 0.f, 0.f};
    bf16x8 At[4][2], B0[2][2], B1[2][2];
    const char* cA = (const char*)g.A + (size_t)cur.pm * tstep; const char* cB = (const char*)g.Bt + (size_t)cur.pn * tstep;
    S.a_ready(cur);
    PG8_STAGE(PG8_SB(0, 0), cB, voffB); PG8_STAGE(PG8_SA(0, 0), cA, voffA); PG8_STAGE(PG8_SB(0, 1), cB + hstep, voffB); PG8_STAGE(PG8_SA(0, 1), cA + hstep, voffA);
    if (wr == 1) PG8_BAR;
    PG8_WAIT_V(4); PG8_BAR;
    PG8_STAGE(PG8_SB(1, 0), cB + kstep, voffB); PG8_STAGE(PG8_SA(1, 0), cA + kstep, voffA); PG8_STAGE(PG8_SB(1, 1), cB + hstep + kstep, voffB);
    PG8_WAIT_V(6); PG8_BAR;
    PG8_STAMP();
    for (;;) {
        const bool has_next = S.next(ui + 1, nxt);
        const char* nA = has_next ? (const char*)g.A + (size_t)nxt.pm * tstep : cA; const char* nB = has_next ? (const char*)g.Bt + (size_t)nxt.pn * tstep : cB;
        for (int t = 0; t < nt; t += 2) {
            const bool last = (t == nt - 2);
            const char* a1 = cA + (size_t)(t + 1) * kstep;
            const char* a2 = last ? nA : cA + (size_t)(t + 2) * kstep; const char* b2 = last ? nB : cB + (size_t)(t + 2) * kstep;
            const char* a3 = a2 + kstep; const char* b3 = b2 + kstep;
            if (last && has_next) S.a_ready(nxt);
            PG8_LDB(B0, 0, 0); PG8_SCHED; PG8_LDA(At, 0, 0); PG8_STAGE(PG8_SA(1, 1), a1 + hstep, voffA);
            PG8_WAIT_L(8); PG8_BAR; PG8_WAIT_L(0); PG8_MMA(0, 0, At, B0); PG8_BAR; PG8_SCHED;
            PG8_LDB(B1, 0, 1); PG8_STAGE(PG8_SB(0, 0), b2, voffB);
            PG8_BAR; PG8_WAIT_L(0); PG8_MMA(0, 1, At, B1); PG8_BAR;
            PG8_LDA(At, 0, 1); PG8_STAGE(PG8_SA(0, 0), a2, voffA);
            PG8_BAR; PG8_WAIT_L(0); PG8_MMA(1, 0, At, B0); PG8_BAR; PG8_SCHED;
            PG8_STAGE(PG8_SB(0, 1), b2 + hstep, voffB);
            PG8_WAIT_V(6); PG8_BAR; PG8_MMA(1, 1, At, B1); PG8_BAR;
            PG8_LDB(B0, 1, 0); PG8_SCHED; PG8_LDA(At, 1, 0); PG8_STAGE(PG8_SA(0, 1), a2 + hstep, voffA);
            PG8_WAIT_L(8); PG8_BAR; PG8_WAIT_L(0); PG8_MMA(0, 0, At, B0); PG8_BAR; PG8_SCHED;
            PG8_LDB(B1, 1, 1); PG8_STAGE(PG8_SB(1, 0), b3, voffB);
            PG8_BAR; PG8_WAIT_L(0); PG8_MMA(0, 1, At, B1); PG8_BAR;
            PG8_LDA(At, 1, 1); PG8_STAGE(PG8_SA(1, 0), a3, voffA);
            PG8_BAR; PG8_WAIT_L(0); PG8_MMA(1, 0, At, B0); PG8_BAR; PG8_SCHED;
            PG8_STAGE(PG8_SB(1, 1), b3 + hstep, voffB);
            PG8_WAIT_V(6); PG8_BAR; PG8_MMA(1, 1, At, B1); PG8_BAR;
        }
        PG8_STAMP();
        if constexpr (!Epi::AFTER_DRAIN) { E(acc, cur, wr, wc, fr, fq); S.done(cur); }
        PG8_STAMP();
        if (!has_next) break;
#pragma unroll
        for (int a = 0; a < 2; ++a)
#pragma unroll
            for (int b = 0; b < 2; ++b)
#pragma unroll
                for (int m = 0; m < 4; ++m)
#pragma unroll
                    for (int n = 0; n < 2; ++n) acc[a][b][m][n] = (f32x4){0.f, 0.f, 0.f, 0.f};
        cur = nxt; cA = nA; cB = nB; ++ui;
    }
    PG8_WAIT_V(0);
    if (wr == 0) PG8_BAR;
    PG8_BAR;
    if constexpr (Epi::AFTER_DRAIN) { E.fused(acc, cur, wr, wc, fr, fq, lds, wid, lane); S.done(cur); }
    PG8_STAMP();
    if (STAMP && wid == 0) { stamps[lane] = lane < nts ? (((unsigned long long)(unsigned)ts_hi << 32) | (unsigned)ts_lo) : 0ull;
        if (lane == 62) stamps[62] = rt_entry; if (lane == 63) stamps[63] = (unsigned long long)wall_clock64(); }
#undef PG8_STAMP
#undef PG8_SA
#undef PG8_SB
#undef PG8_STAGE
#undef PG8_LDA
#undef PG8_LDB
#undef PG8_MMA
#undef PG8_WAIT_V
#undef PG8_WAIT_L
#undef PG8_BAR
#undef PG8_SCHED
}
}
#ifndef LAS
#define LAS __attribute__((address_space(3)))
#endif
#define XB_TMO      128
#define XB_XCNT(j)  (256  + 64 * (j))
#define XB_XSUB(j)  (1280 + 64 * (j))
#define XB_XGEN(j)  (2304 + 64 * (j))
#define XB_TOP      3328
#define XB_TOPGEN   3392
#define XCD_BAR_WORDS 3456
#define XB_SPIN_CAP (1u << 18)

__device__ __forceinline__ unsigned xb_ld(unsigned* p)              { return __hip_atomic_load(p, __ATOMIC_RELAXED, __HIP_MEMORY_SCOPE_AGENT); }
__device__ __forceinline__ unsigned xb_add(unsigned* p, unsigned v) { return __hip_atomic_fetch_add(p, v, __ATOMIC_RELAXED, __HIP_MEMORY_SCOPE_AGENT); }
__device__ __forceinline__ unsigned xb_xcc_id() { return (unsigned)__builtin_amdgcn_s_getreg((3 << 11) | 20) & 0xFu; }
#define XB_SPIN(cond, bar) do { unsigned _sp = 0; while (cond) { __builtin_amdgcn_s_sleep(1); \
    if ((++_sp & 255u) == 0u) { if (xb_ld(&(bar)[XB_TMO])) break; if (_sp > XB_SPIN_CAP) { atomicAdd(&(bar)[XB_TMO], 1u); break; } } } } while (0)

struct XcdBarrier {
    unsigned* bar; unsigned x;
    volatile LAS unsigned* st;
};

__device__ __forceinline__ XcdBarrier xcd_barrier_post(unsigned* bar, volatile LAS unsigned* st) {
    XcdBarrier b; b.bar = bar; b.x = xb_xcc_id(); b.st = st;
    if (threadIdx.x == 0) (void)xb_add(&bar[XB_XCNT(b.x)], 1u);
    return b;
}
__device__ __forceinline__ void xcd_barrier_complete(unsigned* bar, unsigned x, unsigned& nloc, unsigned& nx) {
    const unsigned G = gridDim.x * gridDim.y * gridDim.z;
    unsigned sum, cnt, mine, sp = 0u;
    for (;;) {
        sum = 0u; cnt = 0u; mine = 0u;
#pragma unroll
        for (unsigned j = 0; j < 16; ++j) { const unsigned c = xb_ld(&bar[XB_XCNT(j)]); sum += c; cnt += (c > 0u) ? 1u : 0u; mine = (j == x) ? c : mine; }
        if (sum == G) break;
        __builtin_amdgcn_s_sleep(1);
        if ((++sp & 255u) == 0u) { if (xb_ld(&bar[XB_TMO])) break; if (sp > XB_SPIN_CAP) { atomicAdd(&bar[XB_TMO], 1u); break; } }
    }
    nloc = mine > 0u ? mine : 1u; nx = cnt > 0u ? cnt : 1u;
}

__device__ __forceinline__ void xcd_barrier(const XcdBarrier& b) {
    asm volatile("s_waitcnt vmcnt(0)" ::: "memory");
    __syncthreads();
    if (threadIdx.x == 0) {
        unsigned* bar = b.bar;
        __builtin_amdgcn_s_waitcnt(0);
        unsigned nloc = b.st[0], nx = b.st[1];
        if (nloc == 0u) { xcd_barrier_complete(bar, b.x, nloc, nx); b.st[0] = nloc; b.st[1] = nx; }
        const unsigned old = xb_add(&bar[XB_XSUB(b.x)], 1u);
        const unsigned gen = old / nloc;
        if (old + 1u == (gen + 1u) * nloc) {
            __builtin_amdgcn_fence(__ATOMIC_RELEASE, "agent");
            asm volatile("s_waitcnt vmcnt(0)" ::: "memory");
            const unsigned og = xb_add(&bar[XB_TOP], 1u);
            const unsigned tg = og / nx;
            if (og + 1u == (tg + 1u) * nx) xb_add(&bar[XB_TOPGEN], 1u);
            else XB_SPIN(xb_ld(&bar[XB_TOPGEN]) == tg, bar);
            __builtin_amdgcn_fence(__ATOMIC_ACQUIRE, "agent");
            xb_add(&bar[XB_XGEN(b.x)], 1u);
            asm volatile("s_waitcnt vmcnt(0)" ::: "memory");
        } else {
            XB_SPIN(xb_ld(&bar[XB_XGEN(b.x)]) == gen, bar);
            __builtin_amdgcn_fence(__ATOMIC_ACQUIRE, "agent");
            asm volatile("s_waitcnt vmcnt(0)" ::: "memory");
        }
    }
    __syncthreads();
}


using pg8::bf16_t; using pg8::bf16x8; using pg8::f32x4; using pg8::u32x4;
typedef unsigned u32x2 __attribute__((ext_vector_type(2)));
#define LAS __attribute__((address_space(3)))
typedef LAS unsigned char* ldsp_t;

constexpr int M = 32768, NPE = 3840, NPO = 2816;
constexpr float EPS = 1e-6f;
constexpr int LDS_CTRL = 155648;
constexpr int LDS_BYTES = 159744;

constexpr size_t SZ_WGU = (size_t)5632 * 1024 * 2, SZ_WD = (size_t)1024 * 2816 * 2;
constexpr size_t WS_WGU = 0;
constexpr size_t WS_WD = WS_WGU + 4 * SZ_WGU;
constexpr size_t WS_EWIN = WS_WD + 4 * SZ_WD;
constexpr size_t WS_OWIN = WS_EWIN + (size_t)NPE * 1024 * 2;
constexpr size_t WS_EWOUT = WS_OWIN + (size_t)NPO * 1024 * 2;
constexpr size_t WS_OWOUT = WS_EWOUT + (size_t)1024 * 1024 * 2;
constexpr size_t WS_MLQK = WS_OWOUT + (size_t)1024 * 1024 * 2;
constexpr size_t WS_ROPE = WS_MLQK + (size_t)1024 * 512 * 2;
constexpr size_t WS_SS = WS_ROPE + (size_t)2 * 4096 * 64 * 4;
constexpr size_t WS_DEN = WS_SS + (size_t)7 * 16 * M * 4;
constexpr size_t WS_EN = WS_DEN + (size_t)M * 4 * 4;
constexpr size_t WS_XB = WS_EN + (size_t)M * 4 * 4;
constexpr size_t WS_OB = WS_XB + (size_t)M * 1024 * 2;
constexpr size_t WS_R = WS_OB + (size_t)M * 1024 * 2;
constexpr size_t WS_QKB = WS_R + (size_t)M * NPO * 2;
constexpr size_t WS_BAR = WS_R + (size_t)M * NPE * 2;
constexpr size_t WS_END = WS_BAR + 16384;

struct Params { const float* in[30]; float* out; unsigned char* ws; int ph_lo, ph_hi; };

__device__ __forceinline__ float bflo(unsigned w) { return __uint_as_float(w << 16); }
__device__ __forceinline__ float bfhi(unsigned w) { return __uint_as_float(w & 0xffff0000u); }
__device__ __forceinline__ float bf2f(bf16_t b) { return __uint_as_float(((unsigned)b) << 16); }
__device__ __forceinline__ bf16_t f2bf(float f) { return (bf16_t)(pg8::cvt_pk_bf16(f, 0.f) & 0xffffu); }
__device__ __forceinline__ float sigmoid_f(float x) { return __builtin_amdgcn_rcpf(1.f + __expf(-x)); }
__device__ __forceinline__ float silu_f(float x) { return x * __builtin_amdgcn_rcpf(1.f + __expf(-x)); }
template <int CTRL> __device__ __forceinline__ float dpp_add(float v) { return v + __int_as_float(__builtin_amdgcn_update_dpp(0, __float_as_int(v), CTRL, 0xF, 0xF, true)); }
__device__ __forceinline__ float reduce8(float o) { o = dpp_add<0xB1>(o); o = dpp_add<0x4E>(o); o = dpp_add<0x141>(o); return o; }
__device__ __forceinline__ float reduce16(float o) { return dpp_add<0x140>(reduce8(o)); }
__device__ __forceinline__ float logsigmoid_f(float z) { return fminf(z, 0.f) - log1pf(__expf(-fabsf(z))); }
__device__ __forceinline__ void unpack8(const u32x4 w, float (&f)[8]) {
    f[0] = bflo(w.x); f[1] = bfhi(w.x); f[2] = bflo(w.y); f[3] = bfhi(w.y); f[4] = bflo(w.z); f[5] = bfhi(w.z); f[6] = bflo(w.w); f[7] = bfhi(w.w);
}
__device__ __forceinline__ u32x4 pack8(const float (&f)[8]) {
    u32x4 w; w.x = pg8::cvt_pk_bf16(f[0], f[1]); w.y = pg8::cvt_pk_bf16(f[2], f[3]); w.z = pg8::cvt_pk_bf16(f[4], f[5]); w.w = pg8::cvt_pk_bf16(f[6], f[7]); return w;
}

__device__ __forceinline__ float row_rs(const float* ssb, int row) {
    const f32x4* q = (const f32x4*)(ssb + (size_t)row * 16);
    const f32x4 a = q[0], b = q[1], c = q[2], d = q[3];
    const float s = ((a[0] + a[1]) + (a[2] + a[3])) + ((b[0] + b[1]) + (b[2] + b[3])) + ((c[0] + c[1]) + (c[2] + c[3])) + ((d[0] + d[1]) + (d[2] + d[3]));
    return rsqrtf(s * (1.0f / 1024.0f) + EPS);
}
__device__ __forceinline__ void panel_rs(const float* ss, LAS float* rsl, int& cur_pm, int pm) {
    if (pm != cur_pm) {
        cur_pm = pm;
        if (threadIdx.x < 256) rsl[threadIdx.x] = row_rs(ss, pm * 256 + (int)threadIdx.x);
        asm volatile("s_waitcnt lgkmcnt(0)" ::: "memory");
        __builtin_amdgcn_s_barrier();
        asm volatile("" ::: "memory");
    }
}
struct EpiSwiGLU {
    static constexpr bool PERM = true, AFTER_DRAIN = false;
    bf16_t* G; const float* ss; LAS float* rsl; mutable int cur_pm;
    __device__ __forceinline__ void operator()(const f32x4 (&acc)[2][2][4][2], const pg8::Unit& u, int wr, int wc, int fr, int fq) const {
        const int row0 = u.pm * 256 + wr * 64 + fr, col0 = u.pn * 128 + wc * 32 + 8 * fq;
        panel_rs(ss, rsl, cur_pm, u.pm);
        float rsv[2][4];
#pragma unroll
        for (int ai = 0; ai < 2; ++ai)
#pragma unroll
            for (int m = 0; m < 4; ++m) rsv[ai][m] = rsl[wr * 64 + fr + ai * 128 + m * 16];
#pragma unroll
        for (int ai = 0; ai < 2; ++ai)
#pragma unroll
            for (int m = 0; m < 4; ++m) {
                const int row = row0 + ai * 128 + m * 16;
                const float rs = rsv[ai][m];
                float o[8];
#pragma unroll
                for (int n = 0; n < 2; ++n)
#pragma unroll
                    for (int j = 0; j < 4; ++j) { const float g = acc[ai][0][m][n][j] * rs, uu = acc[ai][1][m][n][j] * rs; o[n * 4 + j] = silu_f(g) * uu; }
                *(u32x4*)(G + (size_t)row * 2816 + col0) = pack8(o);
            }
    }
};
struct EpiResid {
    static constexpr bool PERM = true, AFTER_DRAIN = false;
    bf16_t* xb; float* ssn; float scale;
    __device__ __forceinline__ void operator()(const f32x4 (&acc)[2][2][4][2], const pg8::Unit& u, int wr, int wc, int fr, int fq) const {
        const int row0 = u.pm * 256 + wr * 64 + fr, col0 = u.pn * 256 + wc * 32 + 8 * fq;
        u32x4 rr[2][4][2];
#pragma unroll
        for (int ai = 0; ai < 2; ++ai)
#pragma unroll
            for (int m = 0; m < 4; ++m)
#pragma unroll
                for (int bj = 0; bj < 2; ++bj) rr[ai][m][bj] = *(const u32x4*)(xb + (size_t)(row0 + ai * 128 + m * 16) * 1024 + col0 + bj * 128);
#pragma unroll
        for (int ai = 0; ai < 2; ++ai)
#pragma unroll
            for (int m = 0; m < 4; ++m) {
                const int row = row0 + ai * 128 + m * 16;
                float part = 0.f;
#pragma unroll
                for (int bj = 0; bj < 2; ++bj) {
                    float r[8], h[8];
                    unpack8(rr[ai][m][bj], r);
#pragma unroll
                    for (int n = 0; n < 2; ++n)
#pragma unroll
                        for (int j = 0; j < 4; ++j) { h[n * 4 + j] = fmaf(acc[ai][bj][m][n][j], scale, r[n * 4 + j]); part = fmaf(h[n * 4 + j], h[n * 4 + j], part); }
                    *(u32x4*)(xb + (size_t)row * 1024 + col0 + bj * 128) = pack8(h);
                }
                part += __shfl_xor(part, 16); part += __shfl_xor(part, 32);
                if (fq == 0) ssn[(size_t)row * 16 + (u.pn * 4 + wc)] = part;
            }
    }
};
struct EpiProj {
    static constexpr bool PERM = true, AFTER_DRAIN = false;
    bf16_t* P; int ld; const float* ss; LAS float* rsl; mutable int cur_pm;
    __device__ __forceinline__ void operator()(const f32x4 (&acc)[2][2][4][2], const pg8::Unit& u, int wr, int wc, int fr, int fq) const {
        const int row0 = u.pm * 256 + wr * 64 + fr, col0 = u.pn * 256 + wc * 32 + 8 * fq;
        if (ss) panel_rs(ss, rsl, cur_pm, u.pm);
        float rsv[2][4];
#pragma unroll
        for (int ai = 0; ai < 2; ++ai)
#pragma unroll
            for (int m = 0; m < 4; ++m) rsv[ai][m] = ss ? rsl[wr * 64 + fr + ai * 128 + m * 16] : 1.0f;
#pragma unroll
        for (int ai = 0; ai < 2; ++ai)
#pragma unroll
            for (int m = 0; m < 4; ++m) {
                const int row = row0 + ai * 128 + m * 16;
                const float rs = rsv[ai][m];
#pragma unroll
                for (int bj = 0; bj < 2; ++bj) {
                    float o[8];
#pragma unroll
                    for (int n = 0; n < 2; ++n)
#pragma unroll
                        for (int j = 0; j < 4; ++j) o[n * 4 + j] = acc[ai][bj][m][n][j] * rs;
                    *(u32x4*)(P + (size_t)row * ld + col0 + bj * 128) = pack8(o);
                }
            }
    }
};
template <class Epi> __device__ __forceinline__ void run_gemm(ldsp_t lds, const bf16_t* A, const bf16_t* Bt, int N, int K, const Epi& E) {
    pg8::Gemm g{A, Bt, M, N, K}; pg8::StaticOrder S; S.init(M, N, (int)gridDim.x, (int)blockIdx.x);
    pg8::gemm_phase<Epi, pg8::StaticOrder>(lds, g, S, E, nullptr);
}

struct CvtJob { const float* src; const float* scale; bf16_t* dst; int K, N, mode; };
__device__ __forceinline__ void get_job(const Params& p, int j, CvtJob& J) {
    unsigned char* ws = p.ws;
    if (j < 4) { const int l = j >> 1, f = j & 1; J.src = (f ? p.in[6] : p.in[2]) + (size_t)l * 1024 * 5632; J.scale = (f ? p.in[5] : p.in[1]) + l * 1024;
        J.dst = (bf16_t*)(ws + WS_WGU + (size_t)j * SZ_WGU); J.K = 1024; J.N = 5632; J.mode = 1; }
    else if (j < 8) { const int jj = j - 4, l = jj >> 1, f = jj & 1; J.src = (f ? p.in[7] : p.in[3]) + (size_t)l * 2816 * 1024; J.scale = nullptr;
        J.dst = (bf16_t*)(ws + WS_WD + (size_t)jj * SZ_WD); J.K = 2816; J.N = 1024; J.mode = 0; }
    else if (j == 8) { J.src = p.in[8]; J.scale = p.in[4]; J.dst = (bf16_t*)(ws + WS_EWIN); J.K = 1024; J.N = 3600; J.mode = 0; }
    else if (j == 9) { J.src = p.in[13]; J.scale = p.in[4] + 1024; J.dst = (bf16_t*)(ws + WS_OWIN); J.K = 1024; J.N = 2568; J.mode = 0; }
    else if (j == 10) { J.src = p.in[12]; J.scale = nullptr; J.dst = (bf16_t*)(ws + WS_EWOUT); J.K = 1024; J.N = 1024; J.mode = 0; }
    else { J.src = p.in[28]; J.scale = nullptr; J.dst = (bf16_t*)(ws + WS_OWOUT); J.K = 1024; J.N = 1024; J.mode = 0; }
}
__device__ __forceinline__ void cvt_tile_load(const Params& p, int t, int tid, f32x4& v0, f32x4& v1, float& s0, float& s1, bf16_t*& dst) {
    int j, tt;
    if (t < 5632) { j = t / 1408; tt = t % 1408; }
    else if (t < 8448) { j = 4 + (t - 5632) / 704; tt = (t - 5632) % 704; }
    else if (t < 9344) { j = 8; tt = t - 8448; }
    else if (t < 10048) { j = 9; tt = t - 9344; }
    else if (t < 10304) { j = 10; tt = t - 10048; }
    else { j = 11; tt = t - 10304; }
    CvtJob J; get_job(p, j, J);
    const int kbn = J.K >> 6, nb = tt / kbn, kb = tt % kbn;
    const int srccol0 = (J.mode == 1) ? (((nb & 3) < 2) ? 128 * (nb >> 2) + 64 * (nb & 3) : 2816 + 128 * (nb >> 2) + 64 * ((nb & 3) - 2)) : 64 * nb;
    const int r = tid >> 4, col = srccol0 + (tid & 15) * 4, k0 = kb * 64 + r;
    v0 = (f32x4){0.f, 0.f, 0.f, 0.f}; v1 = v0;
    if (col < J.N) { v0 = *(const f32x4*)(J.src + (size_t)k0 * J.N + col); v1 = *(const f32x4*)(J.src + (size_t)(k0 + 32) * J.N + col); }
    s0 = J.scale ? J.scale[k0] : 1.0f; s1 = J.scale ? J.scale[k0 + 32] : 1.0f;
    dst = J.dst + (size_t)(nb * 64 + (tid >> 3)) * J.K + kb * 64 + (tid & 7) * 8;
}
__device__ __forceinline__ void phase_prep(const Params& p, ldsp_t lds) {
    const int tid = threadIdx.x, lane = tid & 63, w = tid >> 6;
    LAS float* tb = (LAS float*)lds;
    {
        f32x4 v0, v1; float s0, s1; bf16_t* dst;
        int t = blockIdx.x;
        if (t < 10560) cvt_tile_load(p, t, tid, v0, v1, s0, s1, dst);
        for (; t < 10560; t += gridDim.x) {
            { const int r = tid >> 4, c4 = (tid & 15) * 4;
              tb[r * 65 + c4 + 0] = v0[0] * s0; tb[r * 65 + c4 + 1] = v0[1] * s0; tb[r * 65 + c4 + 2] = v0[2] * s0; tb[r * 65 + c4 + 3] = v0[3] * s0;
              tb[(r + 32) * 65 + c4 + 0] = v1[0] * s1; tb[(r + 32) * 65 + c4 + 1] = v1[1] * s1; tb[(r + 32) * 65 + c4 + 2] = v1[2] * s1; tb[(r + 32) * 65 + c4 + 3] = v1[3] * s1; }
            __syncthreads();
            bf16_t* const dcur = dst;
            if (t + (int)gridDim.x < 10560) cvt_tile_load(p, t + (int)gridDim.x, tid, v0, v1, s0, s1, dst);
            { const int nl = tid >> 3, kc = (tid & 7) * 8;
              float o[8];
#pragma unroll
              for (int e = 0; e < 8; ++e) o[e] = tb[(kc + e) * 65 + nl];
              *(u32x4*)dcur = pack8(o); }
            __syncthreads();
        }
    }
    {
        const float* x = p.in[0]; bf16_t* XB = (bf16_t*)(p.ws + WS_XB); float* SS = (float*)(p.ws + WS_SS);
        for (int row = blockIdx.x * 8 + w; row < M; row += gridDim.x * 8) {
            const f32x4* xr = (const f32x4*)(x + (size_t)row * 1024);
            float ss = 0.f;
#pragma unroll
            for (int i = 0; i < 4; ++i) {
                const f32x4 v = xr[lane + 64 * i];
                ss += (v[0] * v[0] + v[1] * v[1]) + (v[2] * v[2] + v[3] * v[3]);
                u32x2 pk; pk.x = pg8::cvt_pk_bf16(v[0], v[1]); pk.y = pg8::cvt_pk_bf16(v[2], v[3]);
                *(u32x2*)(XB + (size_t)row * 1024 + (lane + 64 * i) * 4) = pk;
            }
#pragma unroll
            for (int o = 32; o >= 1; o >>= 1) ss += __shfl_xor(ss, o);
            if (lane < 16) SS[(size_t)row * 16 + lane] = (lane == 0) ? ss : 0.f;
        }
    }
    {
        float* rc = (float*)(p.ws + WS_ROPE); float* rsn = rc + 4096 * 64;
        for (int i = blockIdx.x * 512 + tid; i < 4096 * 64; i += gridDim.x * 512) {
            const int pos = i >> 6, j = i & 63;
            const float inv = exp2f(-(float)j * (13.287712379549449f / 64.0f));
            double rev = (double)pos * (double)inv * 0.15915494309189535;
            rev -= rint(rev);
            const float r = (float)(rev * 6.283185307179586);
            rc[i] = cosf(r); rsn[i] = sinf(r);
        }
    }
    {
        bf16_t* W = (bf16_t*)(p.ws + WS_EWIN) + (size_t)3584 * 1024;
        for (int i = blockIdx.x * 512 + tid; i < 256 * 1024; i += gridDim.x * 512) {
            const int c = i >> 10, k = i & 1023;
            const float* wr = p.in[8] + (size_t)k * 3600 + 3584;
            float acc = 0.f;
#pragma unroll
            for (int r = 0; r < 16; ++r) acc = fmaf(wr[r], p.in[9][r * 256 + c], acc);
            W[i] = f2bf(acc * p.in[4][k]);
        }
    }
    {
        bf16_t* W = (bf16_t*)(p.ws + WS_MLQK);
        for (int i = blockIdx.x * 512 + tid; i < 1024 * 512; i += gridDim.x * 512) {
            const int n = i >> 9, k = i & 511, h = (n & 511) >> 7, j = n & 127;
            float v = 0.f;
            if ((k >> 7) == h) v = (n < 512) ? p.in[23][h * 16384 + (k & 127) * 128 + j] : p.in[24][h * 16384 + (k & 127) * 128 + j] * 0.08838834764831845f;
            W[i] = f2bf(v);
        }
    }
}

#define MIX_FMA8(S, ka, kb, vv) do { S[0] = fmaf(ka[0], vv, S[0]); S[1] = fmaf(ka[1], vv, S[1]); S[2] = fmaf(ka[2], vv, S[2]); S[3] = fmaf(ka[3], vv, S[3]); \
    S[4] = fmaf(kb[0], vv, S[4]); S[5] = fmaf(kb[1], vv, S[5]); S[6] = fmaf(kb[2], vv, S[6]); S[7] = fmaf(kb[3], vv, S[7]); } while (0)
#define MIX_DOT8(o, S, qa, qb) do { o = qa[0] * S[0]; o = fmaf(qa[1], S[1], o); o = fmaf(qa[2], S[2], o); o = fmaf(qa[3], S[3], o); \
    o = fmaf(qb[0], S[4], o); o = fmaf(qb[1], S[5], o); o = fmaf(qb[2], S[6], o); o = fmaf(qb[3], S[7], o); } while (0)

typedef short s16x4 __attribute__((ext_vector_type(4)));
__device__ __forceinline__ bf16x8 tr_frag(const LAS bf16_t* T, int LD, int c16, int ks, int lane) {
    const int g = lane >> 4, q = (lane & 15) >> 2, pp = lane & 3;
    const LAS bf16_t* a0 = T + (32 * ks + 8 * g + q) * LD + 16 * c16 + 4 * pp;
    const s16x4 lo = __builtin_amdgcn_ds_read_tr16_b64_v4i16((LAS s16x4*)a0);
    const s16x4 hi = __builtin_amdgcn_ds_read_tr16_b64_v4i16((LAS s16x4*)(a0 + 4 * LD));
    return (bf16x8){lo[0], lo[1], lo[2], lo[3], hi[0], hi[1], hi[2], hi[3]};
}
__device__ __forceinline__ bf16x8 row_frag(const LAS bf16_t* T, int LD, int r16, int kk, int fr, int fq) {
    return *(const LAS bf16x8*)(T + (16 * r16 + fr) * LD + 32 * kk + 8 * fq);
}
__device__ __forceinline__ void st_bf16x4(LAS bf16_t* dst, const f32x4 v) { u32x2 pk; pk.x = pg8::cvt_pk_bf16(v[0], v[1]); pk.y = pg8::cvt_pk_bf16(v[2], v[3]); *(LAS u32x2*)dst = pk; }

template <int CTRL> __device__ __forceinline__ float dpp_mov_old(float oldv, float v) { return __int_as_float(__builtin_amdgcn_update_dpp(__float_as_int(oldv), __float_as_int(v), CTRL, 0xF, 0xF, false)); }
__device__ __forceinline__ float readlane_f(float v, int l) { return __int_as_float(__builtin_amdgcn_readlane(__float_as_int(v), l)); }
__device__ __forceinline__ float wave_scan_add(float x, int lane) {
    x += dpp_mov_old<0x111>(0.f, x); x += dpp_mov_old<0x112>(0.f, x); x += dpp_mov_old<0x114>(0.f, x); x += dpp_mov_old<0x118>(0.f, x);
    const float t0 = readlane_f(x, 15), t1 = readlane_f(x, 31), t2 = readlane_f(x, 47);
    const int row = lane >> 4;
    return x + ((row >= 1 ? t0 : 0.f) + (row >= 2 ? t1 : 0.f) + (row >= 3 ? t2 : 0.f));
}
__device__ __forceinline__ float wave_scan_max(float x, int lane) {
    const float ninf = -__builtin_huge_valf();
    x = fmaxf(x, dpp_mov_old<0x111>(ninf, x)); x = fmaxf(x, dpp_mov_old<0x112>(ninf, x)); x = fmaxf(x, dpp_mov_old<0x114>(ninf, x)); x = fmaxf(x, dpp_mov_old<0x118>(ninf, x));
    const float t0 = readlane_f(x, 15), t1 = readlane_f(x, 31), t2 = readlane_f(x, 47);
    const int row = lane >> 4;
    const float pre = fmaxf(row >= 1 ? t0 : ninf, fmaxf(row >= 2 ? t1 : ninf, row >= 3 ? t2 : ninf));
    return fmaxf(x, pre);
}
__device__ __forceinline__ float logsigmoid_fast(float z) { return fminf(z, 0.f) - __logf(1.0f + __expf(-fabsf(z))); }
template <int DK, int MODE>
__device__ __forceinline__ void mfma_chunk_p(const LAS bf16_t* Qb, const LAS bf16_t* Kb, LAS bf16_t* Pb, LAS float* DP, int w, int lane) {
    constexpr int LD = DK + 8, PLD = 72, KS = DK / 32;
    const int fr = lane & 15, fq = lane >> 4, ts = w & 3;
#pragma unroll
    for (int tt = 0; tt < 2; ++tt) {
        const int tl = 2 * (w >> 2) + tt;
        f32x4 acc = (f32x4){0.f, 0.f, 0.f, 0.f};
        if (ts <= tl) {
#pragma unroll
            for (int kk = 0; kk < KS; ++kk) acc = __builtin_amdgcn_mfma_f32_16x16x32_bf16(row_frag(Kb, LD, ts, kk, fr, fq), row_frag(Qb, LD, tl, kk, fr, fq), acc, 0, 0, 0);
            if (ts == tl) {
#pragma unroll
                for (int r = 0; r < 4; ++r) if (4 * fq + r > fr) acc[r] = 0.f;
            }
        }
        st_bf16x4(Pb + (16 * tl + fr) * PLD + 16 * ts + 4 * fq, acc);
        if (MODE == 2) { float part = (acc[0] + acc[1]) + (acc[2] + acc[3]); part += __shfl_xor(part, 16); part += __shfl_xor(part, 32); if (fq == 0) DP[ts * 64 + 16 * tl + fr] = part; }
    }
}
template <int DK, int MODE>
__device__ __forceinline__ void mfma_chunk_os(const LAS bf16_t* Qb, const LAS bf16_t* Kb, const LAS bf16_t* Vb, LAS bf16_t* STb, const LAS bf16_t* Pb, f32x4 (&Sacc)[DK / 32],
                                              bf16_t* orow, int ldo, int tile, float cs, float qscv, const LAS float* EBE, int w, int lane, int hv) {
    constexpr int LD = DK + 8, PLD = 72, KS = DK / 32, DTH = DK / 32;
    const int fr = lane & 15, fq = lane >> 4, vt = w & 3, hh = w >> 2, vabs = hv * 4 + vt;
    const bf16x8 vt0 = tr_frag(Vb, 136, vabs, 0, lane), vt1 = tr_frag(Vb, 136, vabs, 1, lane);
    bf16x8 st[KS];
#pragma unroll
    for (int kk = 0; kk < KS; ++kk) st[kk] = row_frag(STb + (tile & 1) * 64 * LD, LD, vt, kk, fr, fq);
#pragma unroll
    for (int tt = 0; tt < 2; ++tt) {
        const int tl = 2 * hh + tt;
        f32x4 accP = (f32x4){0.f, 0.f, 0.f, 0.f}, accS = (f32x4){0.f, 0.f, 0.f, 0.f};
        accP = __builtin_amdgcn_mfma_f32_16x16x32_bf16(vt0, *(const LAS bf16x8*)(Pb + (16 * tl + fr) * PLD + 8 * fq), accP, 0, 0, 0);
        accP = __builtin_amdgcn_mfma_f32_16x16x32_bf16(vt1, *(const LAS bf16x8*)(Pb + (16 * tl + fr) * PLD + 32 + 8 * fq), accP, 0, 0, 0);
        if (tile > 0) {
#pragma unroll
            for (int kk = 0; kk < KS; ++kk) accS = __builtin_amdgcn_mfma_f32_16x16x32_bf16(st[kk], row_frag(Qb, LD, tl, kk, fr, fq), accS, 0, 0, 0);
        }
        f32x4 o;
        if (MODE == 2) { const float qs = __shfl(qscv, 16 * tl + fr); o = (accP + accS * cs) * qs; } else o = accP + accS;
        u32x2 pk; pk.x = pg8::cvt_pk_bf16(o[0], o[1]); pk.y = pg8::cvt_pk_bf16(o[2], o[3]);
        *(u32x2*)(orow + (size_t)(tile * 64 + 16 * tl + fr) * ldo) = pk;
    }
#pragma unroll
    for (int i = 0; i < DTH; ++i) {
        const int dt = hh * DTH + i;
        if (MODE == 2) Sacc[i] = Sacc[i] * cs;
        Sacc[i] = __builtin_amdgcn_mfma_f32_16x16x32_bf16(tr_frag(Kb, LD, dt, 0, lane), vt0, Sacc[i], 0, 0, 0);
        Sacc[i] = __builtin_amdgcn_mfma_f32_16x16x32_bf16(tr_frag(Kb, LD, dt, 1, lane), vt1, Sacc[i], 0, 0, 0);
        if (MODE == 1) Sacc[i] = Sacc[i] * *(const LAS f32x4*)(EBE + 16 * dt + 4 * fq);
        if (MODE == 0) Sacc[i] = Sacc[i] * cs;
        st_bf16x4(STb + ((tile + 1) & 1) * 64 * LD + (16 * vt + fr) * LD + 16 * dt + 4 * fq, Sacc[i]);
    }
}

__device__ __forceinline__ void mix_retention_mfma(const Params& p, ldsp_t lds, int item) {
    const int b = item >> 3, h = (item >> 1) & 3, hv = item & 1;
    constexpr int LD = 136, PLD = 72;
    constexpr int TB = 64 * LD;
    LAS bf16_t* Qb = (LAS bf16_t*)lds; LAS bf16_t* Kb = Qb + 2 * TB; LAS bf16_t* Vb = Kb + 2 * TB; LAS bf16_t* STb = Vb + 2 * TB; LAS bf16_t* Pb = STb + 128 * LD;
    const int tid = threadIdx.x, lane = tid & 63, w = __builtin_amdgcn_readfirstlane(tid >> 6), fq = lane >> 4;
    const int sj = tid >> 3, sc = tid & 7;
    bf16_t* P = (bf16_t*)(p.ws + WS_R);
    const float* ropec = (const float*)(p.ws + WS_ROPE); const float* ropes = ropec + 4096 * 64;
    const float l2g = log2f(1.0f - exp2f(-5.0f - (float)h));
    const float gT = exp2f(64.0f * l2g);
    const float dq = exp2f((float)(sj + 1) * l2g), dkk = exp2f(-(float)(sj + 1) * l2g) * 0.08838834764831845f;
    const bf16_t* qrow = P + ((size_t)b * 4096 + sj) * NPE + h * 128 + sc * 8;
    bf16_t* orow = P + ((size_t)b * 4096) * NPE + 1024 + h * 128 + 16 * (hv * 4 + (w & 3)) + 4 * fq;
    f32x4 Sacc[4];
#pragma unroll
    for (int i = 0; i < 4; ++i) Sacc[i] = (f32x4){0.f, 0.f, 0.f, 0.f};
    u32x4 rq1, rq2, rk1, rk2, rv; f32x4 c0, c1, s0, s1;
#define RETM_LOAD(t0) do { const bf16_t* qp_ = qrow + (size_t)(t0) * NPE; rq1 = *(const u32x4*)qp_; rq2 = *(const u32x4*)(qp_ + 64); rk1 = *(const u32x4*)(qp_ + 512); rk2 = *(const u32x4*)(qp_ + 576); \
        rv = *(const u32x4*)(qp_ + 1024 + hv * 64); \
        const float* cp_ = ropec + ((t0) + sj) * 64 + sc * 8; c0 = *(const f32x4*)cp_; c1 = *(const f32x4*)(cp_ + 4); \
        const float* sp_ = ropes + ((t0) + sj) * 64 + sc * 8; s0 = *(const f32x4*)sp_; s1 = *(const f32x4*)(sp_ + 4); } while (0)
#define RETM_STAGE(bi) do { LAS bf16_t* Qd = Qb + (bi) * TB; LAS bf16_t* Kd = Kb + (bi) * TB; LAS bf16_t* Vd = Vb + (bi) * TB; \
            float a[8], bb[8], o1[8], o2[8]; \
            unpack8(rq1, a); unpack8(rq2, bb); \
            _Pragma("unroll") for (int i = 0; i < 4; ++i) { o1[i] = (a[i] * c0[i] - bb[i] * s0[i]) * dq; o2[i] = (a[i] * s0[i] + bb[i] * c0[i]) * dq; \
                                          o1[4 + i] = (a[4 + i] * c1[i] - bb[4 + i] * s1[i]) * dq; o2[4 + i] = (a[4 + i] * s1[i] + bb[4 + i] * c1[i]) * dq; } \
            *(LAS u32x4*)(Qd + sj * LD + sc * 8) = pack8(o1); *(LAS u32x4*)(Qd + sj * LD + 64 + sc * 8) = pack8(o2); \
            unpack8(rk1, a); unpack8(rk2, bb); \
            _Pragma("unroll") for (int i = 0; i < 4; ++i) { o1[i] = (a[i] * c0[i] - bb[i] * s0[i]) * dkk; o2[i] = (a[i] * s0[i] + bb[i] * c0[i]) * dkk; \
                                          o1[4 + i] = (a[4 + i] * c1[i] - bb[4 + i] * s1[i]) * dkk; o2[4 + i] = (a[4 + i] * s1[i] + bb[4 + i] * c1[i]) * dkk; } \
            *(LAS u32x4*)(Kd + sj * LD + sc * 8) = pack8(o1); *(LAS u32x4*)(Kd + sj * LD + 64 + sc * 8) = pack8(o2); \
            *(LAS u32x4*)(Vd + sj * LD + hv * 64 + sc * 8) = rv; } while (0)
    RETM_LOAD(0);
    RETM_STAGE(0);
    __syncthreads();
    RETM_LOAD(64);
    for (int tile = 0; tile < 64; ++tile) {
        const int cur = tile & 1;
        mfma_chunk_p<128, 0>(Qb + cur * TB, Kb + cur * TB, Pb, nullptr, w, lane);
        __syncthreads();
        mfma_chunk_os<128, 0>(Qb + cur * TB, Kb + cur * TB, Vb + cur * TB, STb, Pb, Sacc, orow, NPE, tile, gT, 1.0f, nullptr, w, lane, hv);
        if (tile + 1 < 64) { RETM_STAGE(cur ^ 1); if (tile + 2 < 64) RETM_LOAD((tile + 2) * 64); }
        __syncthreads();
    }
#undef RETM_STAGE
#undef RETM_LOAD
}

template <int ROLE>
__device__ __forceinline__ void mix_mlstm_mfma(const Params& p, ldsp_t lds, int item) {
    const int b = (ROLE == 0) ? (item >> 3) : (item >> 2), h = (ROLE == 0) ? ((item >> 1) & 3) : (item & 3), hv = (ROLE == 0) ? (item & 1) : 0;
    constexpr int LD = 136, PLD = 72;
    LAS bf16_t* Qb = (LAS bf16_t*)lds; LAS bf16_t* Kb = Qb + 64 * LD; LAS bf16_t* Vb = Kb + 64 * LD; LAS bf16_t* STb = Vb + 64 * LD; LAS bf16_t* Pb = STb + 128 * LD;
    LAS float* DP = (LAS float*)(Pb + 64 * PLD); LAS float* NV = DP + 256; LAS float* KS = NV + 128;
    const int tid = threadIdx.x, lane = tid & 63, w = __builtin_amdgcn_readfirstlane(tid >> 6), fq = lane >> 4;
    const int sj = tid >> 3, sc = tid & 7;
    bf16_t* P = (bf16_t*)(p.ws + WS_R); const bf16_t* QKB = (const bf16_t*)(p.ws + WS_QKB);
    float* DEN = (float*)(p.ws + WS_DEN); float* EN = (float*)(p.ws + WS_EN);
    const bf16_t* qrow = QKB + ((size_t)b * 4096 + sj) * 1024 + h * 128 + sc * 8;
    const bf16_t* vrow = P + ((size_t)b * 4096 + sj) * NPO + 1536 + h * 128 + hv * 64 + sc * 8;
    const bf16_t* irow = P + ((size_t)b * 4096 + lane) * NPO + 2560 + h;
    bf16_t* orow = P + ((size_t)b * 4096) * NPO + 1536 + h * 128 + 16 * (hv * 4 + (w & 3)) + 4 * fq;
    const float bi = p.in[25][h], bfv = p.in[26][h];
    float m_prev = 0.f;
    f32x4 Sacc[4];
#pragma unroll
    for (int i = 0; i < 4; ++i) Sacc[i] = (f32x4){0.f, 0.f, 0.f, 0.f};
    if (ROLE == 1 && tid < 128) NV[tid] = 0.f;
    u32x4 rq1, rq2, rk1, rk2, rv1 = (u32x4){0u, 0u, 0u, 0u}; bf16_t ri, rf;
#define MLM_LOAD(t0) do { const bf16_t* qp_ = qrow + (size_t)(t0) * 1024; rq1 = *(const u32x4*)qp_; rq2 = *(const u32x4*)(qp_ + 64); rk1 = *(const u32x4*)(qp_ + 512); rk2 = *(const u32x4*)(qp_ + 576); \
        if (ROLE == 0) { rv1 = *(const u32x4*)(vrow + (size_t)(t0) * NPO); } \
        ri = irow[(size_t)(t0) * NPO]; rf = irow[(size_t)(t0) * NPO + 4]; } while (0)
    MLM_LOAD(0);
    for (int tile = 0; tile < 64; ++tile) {
        float wv, qscv, env, cs;
        {
            const float fi = bf2f(ri) + bi, lf = logsigmoid_f(bf2f(rf) + bfv);
            const float F = wave_scan_add(lf, lane);
            const float g = fi - F;
            const float pm = wave_scan_max(g, lane);
            const float Mj = fmaxf(m_prev, pm);
            const float mu = readlane_f(Mj, 63);
            wv = __expf(g - mu); qscv = __expf(mu - Mj); env = __expf(-(F + Mj)); cs = __expf(m_prev - mu);
            m_prev = readlane_f(F, 63) + mu;
        }
        {
            const float wvs = __shfl(wv, sj);
            float a[8];
            *(LAS u32x4*)(Qb + sj * LD + sc * 8) = rq1; *(LAS u32x4*)(Qb + sj * LD + 64 + sc * 8) = rq2;
            unpack8(rk1, a);
#pragma unroll
            for (int i = 0; i < 8; ++i) a[i] *= wvs;
            *(LAS u32x4*)(Kb + sj * LD + sc * 8) = pack8(a);
            unpack8(rk2, a);
#pragma unroll
            for (int i = 0; i < 8; ++i) a[i] *= wvs;
            *(LAS u32x4*)(Kb + sj * LD + 64 + sc * 8) = pack8(a);
            if (ROLE == 0) { *(LAS u32x4*)(Vb + sj * LD + hv * 64 + sc * 8) = rv1; }
        }
        __syncthreads();
        if (tile + 1 < 64) MLM_LOAD((tile + 1) * 64);
        if (ROLE == 1) {
            const int kd = tid & 127, kp = tid >> 7;
            float ks = 0.f;
#pragma unroll
            for (int s2 = 0; s2 < 16; ++s2) ks += bf2f(Kb[(kp * 16 + s2) * LD + kd]);
            KS[kp * 128 + kd] = ks;
        }
        if (ROLE == 1) mfma_chunk_p<128, 2>(Qb, Kb, Pb, DP, w, lane); else mfma_chunk_p<128, 0>(Qb, Kb, Pb, nullptr, w, lane);
        __syncthreads();
        if (ROLE == 1) {
            const int l = tid >> 3, part = tid & 7;
            float qn = 0.f;
#pragma unroll
            for (int i = 0; i < 2; ++i) { float qv[8]; unpack8(*(const LAS u32x4*)(Qb + l * LD + part * 16 + i * 8), qv);
                const f32x4 n0 = *(const LAS f32x4*)(NV + part * 16 + i * 8), n1 = *(const LAS f32x4*)(NV + part * 16 + i * 8 + 4);
                qn += qv[0] * n0[0] + qv[1] * n0[1] + qv[2] * n0[2] + qv[3] * n0[3] + qv[4] * n1[0] + qv[5] * n1[1] + qv[6] * n1[2] + qv[7] * n1[3]; }
            qn = reduce8(qn);
            const float qs_l = __shfl(qscv, l), en_l = __shfl(env, l);
            if (part == 0) {
                const float dsum = (DP[l] + DP[64 + l]) + (DP[128 + l] + DP[192 + l]);
                const size_t o = ((size_t)b * 4096 + tile * 64 + l) * 4 + h;
                DEN[o] = (dsum + cs * qn) * qs_l; EN[o] = en_l;
            }
        }
        if (ROLE == 0) mfma_chunk_os<128, 2>(Qb, Kb, Vb, STb, Pb, Sacc, orow, NPO, tile, cs, qscv, nullptr, w, lane, hv);
        __syncthreads();
        if (ROLE == 1 && tid < 128) NV[tid] = cs * NV[tid] + ((KS[tid] + KS[128 + tid]) + (KS[256 + tid] + KS[384 + tid]));
    }
#undef MLM_LOAD
}

__device__ __forceinline__ void mix_mlstm_num_db(const Params& p, ldsp_t lds, int item) {
    const int b = item >> 3, h = (item >> 1) & 3, hv = item & 1;
    constexpr int LD = 136, PLD = 72, TB = 64 * LD;
    LAS bf16_t* Qb = (LAS bf16_t*)lds; LAS bf16_t* Kb = Qb + 2 * TB; LAS bf16_t* Vb = Kb + 2 * TB; LAS bf16_t* STb = Vb + 2 * TB; LAS bf16_t* Pb = STb + 128 * LD;
    const int tid = threadIdx.x, lane = tid & 63, w = __builtin_amdgcn_readfirstlane(tid >> 6), fq = lane >> 4;
    const int sj = tid >> 3, sc = tid & 7;
    bf16_t* P = (bf16_t*)(p.ws + WS_R); const bf16_t* QKB = (const bf16_t*)(p.ws + WS_QKB);
    const bf16_t* qrow = QKB + ((size_t)b * 4096 + sj) * 1024 + h * 128 + sc * 8;
    const bf16_t* vrow = P + ((size_t)b * 4096 + sj) * NPO + 1536 + h * 128 + hv * 64 + sc * 8;
    const bf16_t* irow = P + ((size_t)b * 4096 + lane) * NPO + 2560 + h;
    bf16_t* orow = P + ((size_t)b * 4096) * NPO + 1536 + h * 128 + 16 * (hv * 4 + (w & 3)) + 4 * fq;
    const float bi = p.in[25][h], bfv = p.in[26][h];
    float m_prev = 0.f;
    f32x4 Sacc[4];
#pragma unroll
    for (int i = 0; i < 4; ++i) Sacc[i] = (f32x4){0.f, 0.f, 0.f, 0.f};
    u32x4 rq1, rq2, rk1, rk2, rv1; bf16_t ri, rf;
    float qs_n, cs_n;
#define MLN_LOAD(t0) do { const bf16_t* qp_ = qrow + (size_t)(t0) * 1024; rq1 = *(const u32x4*)qp_; rq2 = *(const u32x4*)(qp_ + 64); rk1 = *(const u32x4*)(qp_ + 512); rk2 = *(const u32x4*)(qp_ + 576); \
        rv1 = *(const u32x4*)(vrow + (size_t)(t0) * NPO); ri = irow[(size_t)(t0) * NPO]; rf = irow[(size_t)(t0) * NPO + 4]; } while (0)
#define MLN_STAGE(bi_) do { \
        const float fi = bf2f(ri) + bi, lf = logsigmoid_f(bf2f(rf) + bfv); \
        const float F = wave_scan_add(lf, lane); \
        const float g = fi - F; \
        const float pm = wave_scan_max(g, lane); \
        const float Mj = fmaxf(m_prev, pm); \
        const float mu = readlane_f(Mj, 63); \
        const float wv = __expf(g - mu); qs_n = __expf(mu - Mj); cs_n = __expf(m_prev - mu); \
        m_prev = readlane_f(F, 63) + mu; \
        const float wvs = __shfl(wv, sj); \
        LAS bf16_t* Qd = Qb + (bi_) * TB; LAS bf16_t* Kd = Kb + (bi_) * TB; LAS bf16_t* Vd = Vb + (bi_) * TB; \
        float a[8]; \
        *(LAS u32x4*)(Qd + sj * LD + sc * 8) = rq1; *(LAS u32x4*)(Qd + sj * LD + 64 + sc * 8) = rq2; \
        unpack8(rk1, a); _Pragma("unroll") for (int i = 0; i < 8; ++i) a[i] *= wvs; \
        *(LAS u32x4*)(Kd + sj * LD + sc * 8) = pack8(a); \
        unpack8(rk2, a); _Pragma("unroll") for (int i = 0; i < 8; ++i) a[i] *= wvs; \
        *(LAS u32x4*)(Kd + sj * LD + 64 + sc * 8) = pack8(a); \
        *(LAS u32x4*)(Vd + sj * LD + hv * 64 + sc * 8) = rv1; } while (0)
    MLN_LOAD(0);
    MLN_STAGE(0);
    float qscv = qs_n, cs = cs_n;
    __syncthreads();
    MLN_LOAD(64);
    for (int tile = 0; tile < 64; ++tile) {
        const int cur = tile & 1;
        mfma_chunk_p<128, 0>(Qb + cur * TB, Kb + cur * TB, Pb, nullptr, w, lane);
        __syncthreads();
        mfma_chunk_os<128, 2>(Qb + cur * TB, Kb + cur * TB, Vb + cur * TB, STb, Pb, Sacc, orow, NPO, tile, cs, qscv, nullptr, w, lane, hv);
        if (tile + 1 < 64) { MLN_STAGE(cur ^ 1); if (tile + 2 < 64) MLN_LOAD((tile + 2) * 64); }
        __syncthreads();
        qscv = qs_n; cs = cs_n;
    }
#undef MLN_LOAD
#undef MLN_STAGE
}

__device__ __forceinline__ void mix_gla_mfma(const Params& p, ldsp_t lds, int item) {
    const int b = item >> 3, h = (item >> 1) & 3, hv = item & 1;
    constexpr int LD = 72, PLD = 72;
    constexpr int TQ = 64 * LD, TV = 64 * 136;
    LAS bf16_t* Qb = (LAS bf16_t*)lds; LAS bf16_t* Kb = Qb + 2 * TQ; LAS bf16_t* Vb = Kb + 2 * TQ; LAS bf16_t* STb = Vb + 2 * TV; LAS bf16_t* Pb = STb + 128 * LD;
    LAS float* EBE = (LAS float*)(Pb + 64 * PLD);
    const int tid = threadIdx.x, lane = tid & 63, w = __builtin_amdgcn_readfirstlane(tid >> 6), fq = lane >> 4;
    const int sj = tid >> 3, sc = tid & 7;
    bf16_t* P = (bf16_t*)(p.ws + WS_R);
    float bl[8];
    { const f32x4 b0 = *(const f32x4*)(p.in[10] + h * 64 + 8 * w), b1 = *(const f32x4*)(p.in[10] + h * 64 + 8 * w + 4);
      bl[0] = b0[0]; bl[1] = b0[1]; bl[2] = b0[2]; bl[3] = b0[3]; bl[4] = b1[0]; bl[5] = b1[1]; bl[6] = b1[2]; bl[7] = b1[3]; }
    const bf16_t* trow = P + ((size_t)b * 4096 + lane) * NPE + h * 64 + 8 * w;
    const bf16_t* vrow = P + ((size_t)b * 4096 + sj) * NPE + 2560 + h * 128 + hv * 64 + sc * 8;
    bf16_t* orow = P + ((size_t)b * 4096) * NPE + 2560 + h * 128 + 16 * (hv * 4 + (w & 3)) + 4 * fq;
    f32x4 Sacc[2];
#pragma unroll
    for (int i = 0; i < 2; ++i) Sacc[i] = (f32x4){0.f, 0.f, 0.f, 0.f};
    u32x4 rq, rk, rz, rv1;
#define GLM_LOAD(t0) do { const bf16_t* tp_ = trow + (size_t)(t0) * NPE; rq = *(const u32x4*)(tp_ + 2048); rk = *(const u32x4*)(tp_ + 2304); rz = *(const u32x4*)(tp_ + 3584); \
        rv1 = *(const u32x4*)(vrow + (size_t)(t0) * NPE); } while (0)
#define GLM_STAGE(bi) do { float z[8], q[8], k[8]; \
            unpack8(rz, z); unpack8(rq, q); unpack8(rk, k); \
            _Pragma("unroll") for (int i = 0; i < 8; ++i) { \
                const float la = logsigmoid_fast(z[i] + bl[i]) * (1.0f / 16.0f); \
                const float bs = wave_scan_add(la, lane); \
                const float e = __expf(bs); \
                q[i] *= e; k[i] *= 0.125f * __expf(-bs); \
                if (lane == 63) EBE[(bi) * 64 + 8 * w + i] = e; } \
            *(LAS u32x4*)(Qb + (bi) * TQ + lane * LD + 8 * w) = pack8(q); \
            *(LAS u32x4*)(Kb + (bi) * TQ + lane * LD + 8 * w) = pack8(k); \
            *(LAS u32x4*)(Vb + (bi) * TV + sj * 136 + hv * 64 + sc * 8) = rv1; } while (0)
    GLM_LOAD(0);
    GLM_STAGE(0);
    __syncthreads();
    GLM_LOAD(64);
    for (int tile = 0; tile < 64; ++tile) {
        const int cur = tile & 1;
        mfma_chunk_p<64, 1>(Qb + cur * TQ, Kb + cur * TQ, Pb, nullptr, w, lane);
        __syncthreads();
        mfma_chunk_os<64, 1>(Qb + cur * TQ, Kb + cur * TQ, Vb + cur * TV, STb, Pb, Sacc, orow, NPE, tile, 1.0f, 1.0f, EBE + cur * 64, w, lane, hv);
        if (tile + 1 < 64) { GLM_STAGE(cur ^ 1); if (tile + 2 < 64) GLM_LOAD((tile + 2) * 64); }
        __syncthreads();
    }
#undef GLM_STAGE
#undef GLM_LOAD
}

__device__ __forceinline__ void mix_lru_fused(const Params& p, ldsp_t lds, int item) {
    const int b = item >> 3, g = item & 7;
    constexpr int LD = 72;
    LAS bf16_t* Wg = (LAS bf16_t*)lds; LAS bf16_t* XCb = Wg + 128 * LD;
    LAS float* LAs = (LAS float*)(XCb + 64 * LD); LAS float* Us = LAs + 4096; LAS float* AA = Us + 4096; LAS float* BB = AA + 512;
    const int tid = threadIdx.x, lane = tid & 63, w = __builtin_amdgcn_readfirstlane(tid >> 6), fr = lane & 15, fq = lane >> 4;
    const int j = tid & 63, seg = tid >> 6, c = g * 64 + j;
    const int r_ = tid >> 3, cc = tid & 7, mt = w & 3;
    const bf16_t* P = (const bf16_t*)(p.ws + WS_R); bf16_t* OB = (bf16_t*)(p.ws + WS_OB);
#pragma unroll
    for (int k = 0; k < 16; ++k) { const int idx = tid + 512 * k, n = idx >> 6, i = idx & 63;
        const float v = (n < 64) ? p.in[16][g * 4096 + i * 64 + n] : p.in[18][g * 4096 + i * 64 + (n - 64)];
        Wg[n * LD + i] = f2bf(v); }
    float ba_[2][4], bx_[2][4], sp_[2][4], cw[4][8], cb[8];
#pragma unroll
    for (int q2 = 0; q2 < 2; ++q2)
#pragma unroll
        for (int r = 0; r < 4; ++r) { const int cch = g * 64 + 16 * (2 * (w >> 2) + q2) + 4 * fq + r;
            ba_[q2][r] = p.in[17][cch]; bx_[q2][r] = p.in[19][cch]; sp_[q2][r] = 8.0f * log1pf(__expf(-p.in[20][cch])); }
#pragma unroll
    for (int q = 0; q < 4; ++q) { const f32x4 a0 = *(const f32x4*)(p.in[14] + q * 512 + g * 64 + cc * 8), a1 = *(const f32x4*)(p.in[14] + q * 512 + g * 64 + cc * 8 + 4);
        cw[q][0] = a0[0]; cw[q][1] = a0[1]; cw[q][2] = a0[2]; cw[q][3] = a0[3]; cw[q][4] = a1[0]; cw[q][5] = a1[1]; cw[q][6] = a1[2]; cw[q][7] = a1[3]; }
    { const f32x4 a0 = *(const f32x4*)(p.in[15] + g * 64 + cc * 8), a1 = *(const f32x4*)(p.in[15] + g * 64 + cc * 8 + 4);
        cb[0] = a0[0]; cb[1] = a0[1]; cb[2] = a0[2]; cb[3] = a0[3]; cb[4] = a1[0]; cb[5] = a1[1]; cb[6] = a1[2]; cb[7] = a1[3]; }
    const bf16_t* lxp = P + ((size_t)b * 4096 + r_) * NPO + 512 + g * 64 + cc * 8;
    const bf16_t* lyp = P + ((size_t)b * 4096 + seg * 8) * NPO + c;
    bf16_t* obp = OB + ((size_t)b * 4096 + seg * 8) * 1024 + c;
    float hc = 0.f;
    u32x4 rx[4]; bf16_t ry[8];
#define LRF_LOAD(t0) do { _Pragma("unroll") for (int q = 0; q < 4; ++q) { rx[q] = (u32x4){0u, 0u, 0u, 0u}; if ((t0) + r_ - 3 + q >= 0) rx[q] = *(const u32x4*)(lxp + ((long)(t0) - 3 + q) * NPO); } \
        _Pragma("unroll") for (int q = 0; q < 8; ++q) ry[q] = lyp[(size_t)((t0) + q) * NPO]; } while (0)
    LRF_LOAD(0);
    for (int tile = 0; tile < 64; ++tile) {
        float lyv[8];
        {
            float acc[8];
#pragma unroll
            for (int e = 0; e < 8; ++e) acc[e] = cb[e];
#pragma unroll
            for (int q = 0; q < 4; ++q) { float x[8]; unpack8(rx[q], x);
#pragma unroll
                for (int e = 0; e < 8; ++e) acc[e] = fmaf(cw[q][e], x[e], acc[e]); }
            *(LAS u32x4*)(XCb + r_ * LD + cc * 8) = pack8(acc);
#pragma unroll
            for (int q = 0; q < 8; ++q) lyv[q] = bf2f(ry[q]);
        }
        __syncthreads();
        if (tile + 1 < 64) LRF_LOAD((tile + 1) * 64);
#pragma unroll
        for (int q2 = 0; q2 < 2; ++q2) {
            const int nt = 2 * (w >> 2) + q2;
            f32x4 accA = (f32x4){0.f, 0.f, 0.f, 0.f}, accX = (f32x4){0.f, 0.f, 0.f, 0.f};
#pragma unroll
            for (int kk = 0; kk < 2; ++kk) { const bf16x8 xf = row_frag(XCb, LD, mt, kk, fr, fq);
                accA = __builtin_amdgcn_mfma_f32_16x16x32_bf16(row_frag(Wg, LD, nt, kk, fr, fq), xf, accA, 0, 0, 0);
                accX = __builtin_amdgcn_mfma_f32_16x16x32_bf16(row_frag(Wg, LD, 4 + nt, kk, fr, fq), xf, accX, 0, 0, 0); }
            const int c0 = 16 * nt + 4 * fq;
            const u32x2 xw = *(const LAS u32x2*)(XCb + (16 * mt + fr) * LD + c0);
            const float xc4[4] = {bflo(xw.x), bfhi(xw.x), bflo(xw.y), bfhi(xw.y)};
            f32x4 lav, uv;
#pragma unroll
            for (int r = 0; r < 4; ++r) {
                const float rr = sigmoid_f(accA[r] + ba_[q2][r]), ig = sigmoid_f(accX[r] + bx_[q2][r]);
                const float la = -sp_[q2][r] * rr;
                const float x2 = 2.0f * la;
                const float om = -x2 * fmaf(x2, fmaf(x2, fmaf(x2, fmaf(x2, fmaf(x2, 1.0f / 720.0f, 1.0f / 120.0f), 1.0f / 24.0f), 1.0f / 6.0f), 0.5f), 1.0f);
                lav[r] = la; uv[r] = __builtin_amdgcn_sqrtf(om) * (ig * xc4[r]);
            }
            *(LAS f32x4*)(LAs + (16 * mt + fr) * 64 + c0) = lav; *(LAS f32x4*)(Us + (16 * mt + fr) * 64 + c0) = uv;
        }
        __syncthreads();
        float ap[8], hl[8]; float A = 1.f, hloc = 0.f;
#pragma unroll
        for (int q = 0; q < 8; ++q) { const float a = __expf(LAs[(seg * 8 + q) * 64 + j]); hloc = fmaf(a, hloc, Us[(seg * 8 + q) * 64 + j]); A *= a; ap[q] = A; hl[q] = hloc; }
        AA[seg * 64 + j] = A; BB[seg * 64 + j] = hloc;
        __syncthreads();
        float hin = hc, run = hc;
#pragma unroll
        for (int s2 = 0; s2 < 8; ++s2) { run = fmaf(AA[s2 * 64 + j], run, BB[s2 * 64 + j]); if (s2 < seg) hin = run; }
        hc = run;
#pragma unroll
        for (int q = 0; q < 8; ++q) {
            const float hv = fmaf(ap[q], hin, hl[q]);
            const float y = lyv[q];
            const float u3 = 0.7978845608028654f * (y + 0.044715f * y * y * y);
            const float th = 1.0f - 2.0f * __builtin_amdgcn_rcpf(1.0f + __expf(2.0f * u3));
            obp[(size_t)(tile * 64 + q) * 1024] = f2bf(hv * 0.5f * y * (1.0f + th));
        }
    }
#undef LRF_LOAD
}

__device__ __forceinline__ void phase_qkproj(const Params& p, ldsp_t lds) {
    constexpr int LD = 136;
    LAS bf16_t* MCb = (LAS bf16_t*)lds;
    const bf16_t* MLQK = (const bf16_t*)(p.ws + WS_MLQK); const bf16_t* P = (const bf16_t*)(p.ws + WS_R); bf16_t* QKB = (bf16_t*)(p.ws + WS_QKB);
    const int tid = threadIdx.x, lane = tid & 63, w = __builtin_amdgcn_readfirstlane(tid >> 6), fr = lane & 15, fq = lane >> 4;
    const int tp = tid >> 4, c16 = tid & 15;
    int hcur = -1;
    bf16x8 wf[2][4];
    float cw[4][8], cb[8];
    u32x4 rx[5];
#define QKP_LOAD(job_) do { const int h_ = (job_) & 3, t_ = ((job_) >> 2) * 64 + 2 * tp; const int pos_ = t_ & 4095; \
        _Pragma("unroll") for (int q = 0; q < 5; ++q) { rx[q] = (u32x4){0u, 0u, 0u, 0u}; if (pos_ - 3 + q >= 0) rx[q] = *(const u32x4*)(P + (size_t)(t_ - 3 + q) * NPO + 1024 + h_ * 128 + c16 * 8); } } while (0)
    int job = blockIdx.x;
    if (job < 2048) QKP_LOAD(job);
    for (; job < 2048; job += gridDim.x) {
        const int h = job & 3, tk0 = (job >> 2) * 64;
        if (h != hcur) {
            hcur = h;
#pragma unroll
            for (int q2 = 0; q2 < 2; ++q2) { const int n = 2 * w + q2; const int gr = (n < 8) ? (h * 128 + 16 * n + fr) : (512 + h * 128 + 16 * (n - 8) + fr);
#pragma unroll
                for (int kk = 0; kk < 4; ++kk) wf[q2][kk] = *(const bf16x8*)(MLQK + (size_t)gr * 512 + h * 128 + 32 * kk + 8 * fq); }
#pragma unroll
            for (int q = 0; q < 4; ++q) { const f32x4 a0 = *(const f32x4*)(p.in[21] + q * 512 + h * 128 + c16 * 8), a1 = *(const f32x4*)(p.in[21] + q * 512 + h * 128 + c16 * 8 + 4);
                cw[q][0] = a0[0]; cw[q][1] = a0[1]; cw[q][2] = a0[2]; cw[q][3] = a0[3]; cw[q][4] = a1[0]; cw[q][5] = a1[1]; cw[q][6] = a1[2]; cw[q][7] = a1[3]; }
            { const f32x4 a0 = *(const f32x4*)(p.in[22] + h * 128 + c16 * 8), a1 = *(const f32x4*)(p.in[22] + h * 128 + c16 * 8 + 4);
                cb[0] = a0[0]; cb[1] = a0[1]; cb[2] = a0[2]; cb[3] = a0[3]; cb[4] = a1[0]; cb[5] = a1[1]; cb[6] = a1[2]; cb[7] = a1[3]; }
        }
        {
            float x[5][8];
#pragma unroll
            for (int q = 0; q < 5; ++q) unpack8(rx[q], x[q]);
#pragma unroll
            for (int tt = 0; tt < 2; ++tt) {
                float o[8];
#pragma unroll
                for (int e = 0; e < 8; ++e) o[e] = silu_f(cb[e] + cw[0][e] * x[tt][e] + cw[1][e] * x[tt + 1][e] + cw[2][e] * x[tt + 2][e] + cw[3][e] * x[tt + 3][e]);
                *(LAS u32x4*)(MCb + (2 * tp + tt) * LD + c16 * 8) = pack8(o);
            }
        }
        __syncthreads();
        if (job + (int)gridDim.x < 2048) QKP_LOAD(job + (int)gridDim.x);
#pragma unroll
        for (int m = 0; m < 4; ++m) {
            bf16x8 af[4];
#pragma unroll
            for (int kk = 0; kk < 4; ++kk) af[kk] = row_frag(MCb, LD, m, kk, fr, fq);
#pragma unroll
            for (int q2 = 0; q2 < 2; ++q2) {
                f32x4 acc = (f32x4){0.f, 0.f, 0.f, 0.f};
#pragma unroll
                for (int kk = 0; kk < 4; ++kk) acc = __builtin_amdgcn_mfma_f32_16x16x32_bf16(wf[q2][kk], af[kk], acc, 0, 0, 0);
                const int n = 2 * w + q2;
                const int dstcol = (n < 8) ? (h * 128 + 16 * n + 4 * fq) : (512 + h * 128 + 16 * (n - 8) + 4 * fq);
                u32x2 pk; pk.x = pg8::cvt_pk_bf16(acc[0], acc[1]); pk.y = pg8::cvt_pk_bf16(acc[2], acc[3]);
                *(u32x2*)(QKB + (size_t)(tk0 + 16 * m + fr) * 1024 + dstcol) = pk;
            }
        }
        __syncthreads();
    }
#undef QKP_LOAD
}

__device__ __forceinline__ void phase_fin_even(const Params& p) {
    const bf16_t* P = (const bf16_t*)(p.ws + WS_R); bf16_t* OB = (bf16_t*)(p.ws + WS_OB); const float* hw = p.in[11];
    const int tid = threadIdx.x, lane = tid & 63, w = tid >> 6, hh = lane >> 4, l16 = lane & 15;
    for (int idx = blockIdx.x * 8 + w; idx < 2 * M; idx += gridDim.x * 8) {
        const int t = idx >> 1, grp = idx & 1;
        const bf16_t* row = P + (size_t)t * NPE;
        const int ocol = (grp ? 2560 : 1024) + hh * 128 + l16 * 8, gcol = (grp ? 3072 : 1536) + hh * 128 + l16 * 8;
        float o[8], g[8];
        unpack8(*(const u32x4*)(row + ocol), o); unpack8(*(const u32x4*)(row + gcol), g);
        float ss = 0.f;
#pragma unroll
        for (int i = 0; i < 8; ++i) ss = fmaf(o[i], o[i], ss);
        ss = reduce16(ss);
        const float rs = rsqrtf(ss * (1.0f / 128.0f) + EPS);
        const int oc = grp * 512 + hh * 128 + l16 * 8;
        const f32x4 w0 = *(const f32x4*)(hw + oc), w1 = *(const f32x4*)(hw + oc + 4);
        float y[8];
#pragma unroll
        for (int i = 0; i < 8; ++i) y[i] = o[i] * rs * silu_f(g[i]) * (i < 4 ? w0[i & 3] : w1[i & 3]);
        *(u32x4*)(OB + (size_t)t * 1024 + oc) = pack8(y);
    }
}
__device__ __forceinline__ void phase_fin_odd(const Params& p) {
    const bf16_t* P = (const bf16_t*)(p.ws + WS_R); bf16_t* OB = (bf16_t*)(p.ws + WS_OB); const float* nw = p.in[27];
    const float* DEN = (const float*)(p.ws + WS_DEN); const float* EN = (const float*)(p.ws + WS_EN);
    const int tid = threadIdx.x, lane = tid & 63, w = tid >> 6, hh = lane >> 4, l16 = lane & 15;
    for (int t = blockIdx.x * 8 + w; t < M; t += gridDim.x * 8) {
        const bf16_t* row = P + (size_t)t * NPO;
        float nu[8], g[8];
        unpack8(*(const u32x4*)(row + 1536 + hh * 128 + l16 * 8), nu); unpack8(*(const u32x4*)(row + 2048 + hh * 128 + l16 * 8), g);
        const float den = DEN[(size_t)t * 4 + hh], en = EN[(size_t)t * 4 + hh];
        const float inv = __builtin_amdgcn_rcpf(fmaxf(fabsf(den), en));
        float hm[8]; float ss = 0.f;
#pragma unroll
        for (int i = 0; i < 8; ++i) { hm[i] = sigmoid_f(g[i]) * nu[i] * inv; ss = fmaf(hm[i], hm[i], ss); }
        ss = reduce16(ss);
        const float rs = rsqrtf(ss * (1.0f / 128.0f) + EPS);
        const int oc = hh * 128 + l16 * 8;
        const f32x4 w0 = *(const f32x4*)(nw + oc), w1 = *(const f32x4*)(nw + oc + 4);
        float y[8];
#pragma unroll
        for (int i = 0; i < 8; ++i) { y[i] = hm[i] * rs * (i < 4 ? w0[i & 3] : w1[i & 3]); }
        *(u32x4*)(OB + (size_t)t * 1024 + 512 + oc) = pack8(y);
    }
}
__device__ __forceinline__ void phase_final(const Params& p) {
    float* out = p.out; const bf16_t* XB = (const bf16_t*)(p.ws + WS_XB); const float* SS = (const float*)(p.ws + WS_SS) + (size_t)6 * 16 * M; const float* fw = p.in[29];
    const int tid = threadIdx.x, lane = tid & 63, w = tid >> 6;
    for (int row = blockIdx.x * 8 + w; row < M; row += gridDim.x * 8) {
        const float rs = row_rs(SS, row);
#pragma unroll
        for (int i = 0; i < 2; ++i) {
            float h[8]; unpack8(*(const u32x4*)(XB + (size_t)row * 1024 + (lane + 64 * i) * 8), h);
            const f32x4 w0 = *(const f32x4*)(fw + (lane + 64 * i) * 8), w1 = *(const f32x4*)(fw + (lane + 64 * i) * 8 + 4);
            f32x4 o0, o1;
            o0[0] = h[0] * rs * w0[0]; o0[1] = h[1] * rs * w0[1]; o0[2] = h[2] * rs * w0[2]; o0[3] = h[3] * rs * w0[3];
            o1[0] = h[4] * rs * w1[0]; o1[1] = h[5] * rs * w1[1]; o1[2] = h[6] * rs * w1[2]; o1[3] = h[7] * rs * w1[3];
            *(f32x4*)(out + (size_t)row * 1024 + (lane + 64 * i) * 8) = o0; *(f32x4*)(out + (size_t)row * 1024 + (lane + 64 * i) * 8 + 4) = o1;
        }
    }
}

__host__ __device__ inline bool phase_active(int ph) { return !(ph == 4 || ph == 5 || ph == 15); }
constexpr int N_PHASES = 22;
__device__ __forceinline__ void load_params(Params& q, ldsp_t lds) {
    const LAS unsigned* tab = (const LAS unsigned*)(lds + LDS_CTRL);
#pragma unroll
    for (int k = 0; k < 32; ++k) {
        const unsigned lo = __builtin_amdgcn_readfirstlane(tab[2 * k]), hi = __builtin_amdgcn_readfirstlane(tab[2 * k + 1]);
        const unsigned long long v = ((unsigned long long)hi << 32) | lo;
        if (k < 30) q.in[k] = (const float*)(const __attribute__((address_space(1))) float*)v; else if (k == 30) q.out = (float*)(__attribute__((address_space(1))) float*)v; else q.ws = (unsigned char*)(__attribute__((address_space(1))) unsigned char*)v;
    }
}
#define PHASE_BEGIN(k) if (lo <= (k) && (k) < hi) { asm volatile("" ::: "memory"); Params p; load_params(p, lds); unsigned char* ws = p.ws; (void)ws;
#define PHASE_END(k) if ((k) + 1 < hi) { xcd_barrier(xb); } }
template <int L> __device__ __forceinline__ void layer_phases(ldsp_t lds, cg::grid_group& grid, XcdBarrier& xb, const int lo, const int hi) {
    constexpr int B0 = 1 + 10 * L;
    PHASE_BEGIN(B0 + 0)
        { EpiSwiGLU E{(bf16_t*)(ws + WS_R), (const float*)(ws + WS_SS) + (size_t)(3 * L + 0) * 16 * M, (LAS float*)(lds + LDS_CTRL + 512), -1};
        run_gemm<EpiSwiGLU>(lds, (const bf16_t*)(ws + WS_XB), (const bf16_t*)(ws + WS_WGU + (size_t)(L * 2 + 0) * SZ_WGU), 5632, 1024, E); }
    PHASE_END(B0 + 0)
    PHASE_BEGIN(B0 + 1)
        { EpiResid E{(bf16_t*)(ws + WS_XB), (float*)(ws + WS_SS) + (size_t)(3 * L + 1) * 16 * M, 0.5f};
        run_gemm<EpiResid>(lds, (const bf16_t*)(ws + WS_R), (const bf16_t*)(ws + WS_WD + (size_t)(L * 2 + 0) * SZ_WD), 1024, 2816, E); }
    PHASE_END(B0 + 1)
    PHASE_BEGIN(B0 + 2)
        { EpiProj E{(bf16_t*)(ws + WS_R), L ? NPO : NPE, (const float*)(ws + WS_SS) + (size_t)(3 * L + 1) * 16 * M, (LAS float*)(lds + LDS_CTRL + 512), -1};
        run_gemm<EpiProj>(lds, (const bf16_t*)(ws + WS_XB), (const bf16_t*)(ws + (L ? WS_OWIN : WS_EWIN)), L ? NPO : NPE, 1024, E); }
    PHASE_END(B0 + 2)
    if (L == 1) {
        PHASE_BEGIN(B0 + 3)
            phase_qkproj(p, lds);
        PHASE_END(B0 + 3)
    }
    PHASE_BEGIN(B0 + 5)
        if (L == 0) {
            for (int it = blockIdx.x; it < 128; it += gridDim.x) { if (it < 64) mix_retention_mfma(p, lds, it); else mix_gla_mfma(p, lds, it - 64); __syncthreads(); }
        } else {
            for (int it = blockIdx.x; it < 160; it += gridDim.x) { if (it < 64) mix_mlstm_num_db(p, lds, it); else if (it < 96) mix_mlstm_mfma<1>(p, lds, it - 64); else mix_lru_fused(p, lds, it - 96); __syncthreads(); }
        }
    PHASE_END(B0 + 5)
    PHASE_BEGIN(B0 + 6)
        { if (L == 0) phase_fin_even(p); else phase_fin_odd(p); }
    PHASE_END(B0 + 6)
    PHASE_BEGIN(B0 + 7)
        { EpiResid E{(bf16_t*)(ws + WS_XB), (float*)(ws + WS_SS) + (size_t)(3 * L + 2) * 16 * M, 1.0f};
        run_gemm<EpiResid>(lds, (const bf16_t*)(ws + WS_OB), (const bf16_t*)(ws + (L ? WS_OWOUT : WS_EWOUT)), 1024, 1024, E); }
    PHASE_END(B0 + 7)
    PHASE_BEGIN(B0 + 8)
        { EpiSwiGLU E{(bf16_t*)(ws + WS_R), (const float*)(ws + WS_SS) + (size_t)(3 * L + 2) * 16 * M, (LAS float*)(lds + LDS_CTRL + 512), -1};
        run_gemm<EpiSwiGLU>(lds, (const bf16_t*)(ws + WS_XB), (const bf16_t*)(ws + WS_WGU + (size_t)(L * 2 + 1) * SZ_WGU), 5632, 1024, E); }
    PHASE_END(B0 + 8)
    PHASE_BEGIN(B0 + 9)
        { EpiResid E{(bf16_t*)(ws + WS_XB), (float*)(ws + WS_SS) + (size_t)(3 * L + 3) * 16 * M, 0.5f};
        run_gemm<EpiResid>(lds, (const bf16_t*)(ws + WS_R), (const bf16_t*)(ws + WS_WD + (size_t)(L * 2 + 1) * SZ_WD), 1024, 2816, E); }
    PHASE_END(B0 + 9)
}
__global__ void __launch_bounds__(512, 2) mega(Params p0) {
    extern __shared__ __attribute__((aligned(16))) unsigned char ldsraw[];
    ldsp_t lds = (ldsp_t)ldsraw;
    cg::grid_group grid = cg::this_grid();
    if (threadIdx.x == 0) {
        LAS unsigned long long* tab = (LAS unsigned long long*)(lds + LDS_CTRL);
#pragma unroll
        for (int k = 0; k < 30; ++k) tab[k] = (unsigned long long)p0.in[k];
        tab[30] = (unsigned long long)p0.out; tab[31] = (unsigned long long)p0.ws;
        LAS unsigned* st = (LAS unsigned*)(lds + LDS_CTRL + 256); st[0] = 0u; st[1] = 0u; st[2] = 0u; st[3] = 0u;
    }
    __syncthreads();
    const int lo = p0.ph_lo, hi = p0.ph_hi;
    if (hi > 1000) grid.sync();
    XcdBarrier xb; xb.bar = nullptr; xb.x = 0u; xb.st = nullptr;
    if (hi - lo > 1) xb = xcd_barrier_post((unsigned*)(p0.ws + WS_BAR), (volatile LAS unsigned*)(lds + LDS_CTRL + 256));
    PHASE_BEGIN(0)
        phase_prep(p, lds);
    PHASE_END(0)
    layer_phases<0>(lds, grid, xb, lo, hi);
    layer_phases<1>(lds, grid, xb, lo, hi);
    PHASE_BEGIN(21)
        phase_final(p);
    PHASE_END(21)
}

extern "C" void kernel_launch(void* const* d_in, const int* in_sizes, int n_in, void* d_out, int out_size, void* d_ws, size_t ws_size, hipStream_t stream) {
    static int grid = 0;
    if (grid == 0) {
        if (n_in != 30 || out_size != M * 1024 || ws_size < WS_END) { fprintf(stderr, "kernel_launch: unexpected problem (n_in %d out %d ws %zu need %zu)\n", n_in, out_size, ws_size, (size_t)WS_END); grid = -1; return; }
        int dev = 0, cus = 0, per_cu = 0;
        hipGetDevice(&dev); hipDeviceGetAttribute(&cus, hipDeviceAttributeMultiprocessorCount, dev);
        if (hipFuncSetAttribute((const void*)mega, hipFuncAttributeMaxDynamicSharedMemorySize, LDS_BYTES) != hipSuccess) { fprintf(stderr, "kernel_launch: hipFuncSetAttribute failed\n"); }
        if (hipOccupancyMaxActiveBlocksPerMultiprocessor(&per_cu, (const void*)mega, 512, LDS_BYTES) != hipSuccess || per_cu < 1) { fprintf(stderr, "kernel_launch: occupancy query says %d\n", per_cu); per_cu = 1; }
        (void)hipGetLastError();
        grid = cus * per_cu; if (grid > 256) grid = 256; if (grid < 1) grid = 256;
    }
    if (grid < 0) return;
    Params p{};
    for (int i = 0; i < 30; ++i) p.in[i] = (const float*)d_in[i];
    p.out = (float*)d_out; p.ws = (unsigned char*)d_ws;
#if MK_N_LAUNCHES == 1
    p.ph_lo = 0; p.ph_hi = N_PHASES;
    if (hipMemsetAsync((unsigned char*)d_ws + WS_BAR, 0, 16384, stream) != hipSuccess) { fprintf(stderr, "kernel_launch: hipMemsetAsync of the barrier words failed\n"); return; }
    void* args[] = {&p};
    hipError_t e = hipLaunchCooperativeKernel((const void*)mega, dim3(grid), dim3(512), args, LDS_BYTES, stream);
    if (e != hipSuccess) fprintf(stderr, "kernel_launch: cooperative launch failed: %s (grid %d)\n", hipGetErrorString(e), grid);
#else
    for (int ph = 0; ph < N_PHASES; ++ph) {
        if (!phase_active(ph)) continue;
        p.ph_lo = ph; p.ph_hi = ph + 1;
        hipLaunchKernelGGL(mega, dim3(grid), dim3(512), LDS_BYTES, stream, p);
    }
#endif
}
```

```cpp
#include <hip/hip_runtime.h>
#include <hip/hip_cooperative_groups.h>
#include <cstdio>
namespace cg = cooperative_groups;
#ifndef MK_N_LAUNCHES
#define MK_N_LAUNCHES 1
#endif
namespace pg8 {
#define PG8_LAS __attribute__((address_space(3)))
typedef unsigned short bf16_t;
typedef short bf16x8 __attribute__((ext_vector_type(8)));
typedef float f32x4 __attribute__((ext_vector_type(4)));
typedef unsigned u32x4 __attribute__((ext_vector_type(4)));
constexpr int BM = 256, BK = 64, HALF = 128, HTB = HALF * BK * 2  , STAGE_BYTES = 8 * HTB, NXCD = 8, WGM = 8;

__host__ __device__ __forceinline__ int lds_byte(int r, int c) { const int st = (r >> 4) * 2 + (c >> 5), rr = r & 15, cc = c & 31, ob = rr * 64 + cc * 2; return st * 1024 + (ob ^ (((ob >> 9) & 1) << 5)); }
__host__ __device__ __forceinline__ void stage_rc(int b, int& R, int& C) { const int st = b / 1024, sb = b % 1024, swz = sb ^ (((sb >> 9) & 1) << 5); R = (st >> 1) * 16 + swz / 64; C = (st & 1) * 32 + (swz % 64) / 2; }
__host__ __device__ __forceinline__ int perm32(int rho) { const int n = rho >> 4, i = rho & 15; return 8 * (i >> 2) + 4 * n + (i & 3); }

struct Unit { int pm, pn; };
struct Gemm { const bf16_t* A; const bf16_t* Bt; int M, N, K; };

struct StaticOrder {
    int nM, nN, nwg, G, c;
    __host__ __device__ void init(int M, int N, int G_, int c_) { nM = M / BM; nN = N / BM; nwg = nM * nN; G = G_; c = c_; }
    __host__ __device__ bool next(int i, Unit& u) const {
        const long L = (long)i * G + c; if (L >= nwg) return false;
        int wgid = (int)L; { const int q = nwg / NXCD, r = nwg % NXCD, xcd = wgid % NXCD, off = wgid / NXCD; wgid = (xcd < r ? xcd * (q + 1) : r * (q + 1) + (xcd - r) * q) + off; }
        const int nig = WGM * nN, gid = wgid / nig, fm = gid * WGM, gsz = (nM - fm) < WGM ? (nM - fm) : WGM;
        u.pm = fm + ((wgid % nig) % gsz); u.pn = (wgid % nig) / gsz; return true;
    }
    __device__ __forceinline__ void a_ready(const Unit&) const {}
    __device__ __forceinline__ void done(const Unit&) const {}
};
typedef __bf16 bf16x2_native __attribute__((ext_vector_type(2)));
__device__ __forceinline__ unsigned cvt_pk_bf16(float lo, float hi) { const bf16x2_native v = {(__bf16)lo, (__bf16)hi}; return __builtin_bit_cast(unsigned, v); }
typedef float f32x2 __attribute__((ext_vector_type(2)));
template <class Epi, class Sched, bool STAMP = false>
__device__ __forceinline__ void gemm_phase(PG8_LAS unsigned char* lds, const Gemm g, const Sched& S, const Epi& E, unsigned long long* stamps) {
    const int tid = threadIdx.x, wid = __builtin_amdgcn_readfirstlane(tid >> 6), lane = tid & 63, wr = wid >> 2, wc = wid & 3, fr = lane & 15, fq = lane >> 4;
    const int K = g.K, nt = K / BK;
    int ts_lo = 0, ts_hi = 0, nts = 0; const unsigned long long rt_entry = STAMP ? (unsigned long long)wall_clock64() : 0ull;
#define PG8_STAMP() do { if (STAMP && wid == 0 && nts < 64) { const unsigned long long _c = (unsigned long long)clock64(); \
        ts_lo = (lane == nts) ? (int)(unsigned)_c : ts_lo; ts_hi = (lane == nts) ? (int)(unsigned)(_c >> 32) : ts_hi; ++nts; } } while (0)
    PG8_STAMP();
    unsigned voffA[2], voffB[2];
#pragma unroll
    for (int i = 0; i < 2; ++i) { int R, C; stage_rc(tid * 16 + i * 8192, R, C); const int Rb = Epi::PERM ? ((R & ~31) + perm32(R & 31)) : R;
        voffA[i] = (unsigned)(R * K + C) * 2u; voffB[i] = (unsigned)(Rb * K + C) * 2u; }
    const size_t kstep = (size_t)(BK * 2);
    const size_t hstep = (size_t)HALF * K * 2;
    const size_t tstep = 2 * hstep;
    const unsigned ldsw = (unsigned)wid * 1024u;
    const int aoff = lds_byte(wr * 64 + fr, fq * 8), boff = lds_byte(wc * 32 + fr, fq * 8);
#define PG8_SA(b, h) (((b) * 2 + (h)) * HTB)
#define PG8_SB(b, h) ((4 + (b) * 2 + (h)) * HTB)
#define PG8_STAGE(bufoff, gbase, voff) do { _Pragma("unroll") for (int _i = 0; _i < 2; ++_i) \
        __builtin_amdgcn_global_load_lds((const unsigned*)((const char*)(gbase) + (voff)[_i]), (PG8_LAS unsigned*)(lds + (bufoff) + ldsw + _i * 8192), 16, 0, 0); } while (0)
#define PG8_LDA(dst, b, h) do { _Pragma("unroll") for (int m = 0; m < 4; ++m) _Pragma("unroll") for (int k = 0; k < 2; ++k) dst[m][k] = *(const PG8_LAS bf16x8*)(lds + PG8_SA(b, h) + aoff + m * 2048 + k * 1024); } while (0)
#define PG8_LDB(dst, b, h) do { _Pragma("unroll") for (int n = 0; n < 2; ++n) _Pragma("unroll") for (int k = 0; k < 2; ++k) dst[n][k] = *(const PG8_LAS bf16x8*)(lds + PG8_SB(b, h) + boff + n * 2048 + k * 1024); } while (0)
#define PG8_MMA(ai, bj, At, Bt) do { __builtin_amdgcn_s_setprio(1); _Pragma("unroll") for (int m = 0; m < 4; ++m) _Pragma("unroll") for (int n = 0; n < 2; ++n) _Pragma("unroll") for (int k = 0; k < 2; ++k) \
        acc[ai][bj][m][n] = __builtin_amdgcn_mfma_f32_16x16x32_bf16(Bt[n][k], At[m][k], acc[ai][bj][m][n], 0, 0, 0); __builtin_amdgcn_s_setprio(0); } while (0)
#define PG8_WAIT_V(n) asm volatile("s_waitcnt vmcnt(" #n ")" ::: "memory")
#define PG8_WAIT_L(n) asm volatile("s_waitcnt lgkmcnt(" #n ")" ::: "memory")
#define PG8_BAR __builtin_amdgcn_s_barrier()
#define PG8_SCHED __builtin_amdgcn_sched_barrier(0)
    Unit cur, nxt; int ui = 0;
    if (!S.next(0, cur)) return;
    f32x4 acc[2][2][4][2];
#pragma unroll
    for (int a = 0; a < 2; ++a)
#pragma unroll
        for (int b = 0; b < 2; ++b)
#pragma unroll
            for (int m = 0; m < 4; ++m)
#pragma unroll
                for (int n = 0; n < 2; ++n) acc[a][b][m][n] = (f32x4){0.f, 0.f, 0.f, 0.f};
    bf16x8 At[4][2], B0[2][2], B1[2][2];
    const char* cA = (const char*)g.A + (size_t)cur.pm * tstep; const char* cB = (const char*)g.Bt + (size_t)cur.pn * tstep;
    S.a_ready(cur);
    PG8_STAGE(PG8_SB(0, 0), cB, voffB); PG8_STAGE(PG8_SA(0, 0), cA, voffA); PG8_STAGE(PG8_SB(0, 1), cB + hstep, voffB); PG8_STAGE(PG8_SA(0, 1), cA + hstep, voffA);
    if (wr == 1) PG8_BAR;
    PG8_WAIT_V(4); PG8_BAR;
    PG8_STAGE(PG8_SB(1, 0), cB + kstep, voffB); PG8_STAGE(PG8_SA(1, 0), cA + kstep, voffA); PG8_STAGE(PG8_SB(1, 1), cB + hstep + kstep, voffB);
    PG8_WAIT_V(6); PG8_BAR;
    PG8_STAMP();
    for (;;) {
        const bool has_next = S.next(ui + 1, nxt);
        const char* nA = has_next ? (const char*)g.A + (size_t)nxt.pm * tstep : cA; const char* nB = has_next ? (const char*)g.Bt + (size_t)nxt.pn * tstep : cB;
        for (int t = 0; t < nt; t += 2) {
            const bool last = (t == nt - 2);
            const char* a1 = cA + (size_t)(t + 1) * kstep;
            const char* a2 = last ? nA : cA + (size_t)(t + 2) * kstep; const char* b2 = last ? nB : cB + (size_t)(t + 2) * kstep;
            const char* a3 = a2 + kstep; const char* b3 = b2 + kstep;
            if (last && has_next) S.a_ready(nxt);
            PG8_LDB(B0, 0, 0); PG8_SCHED; PG8_LDA(At, 0, 0); PG8_STAGE(PG8_SA(1, 1), a1 + hstep, voffA);
            PG8_WAIT_L(8); PG8_BAR; PG8_WAIT_L(0); PG8_MMA(0, 0, At, B0); PG8_BAR; PG8_SCHED;
            PG8_LDB(B1, 0, 1); PG8_STAGE(PG8_SB(0, 0), b2, voffB);
            PG8_BAR; PG8_WAIT_L(0); PG8_MMA(0, 1, At, B1); PG8_BAR;
            PG8_LDA(At, 0, 1); PG8_STAGE(PG8_SA(0, 0), a2, voffA);
            PG8_BAR; PG8_WAIT_L(0); PG8_MMA(1, 0, At, B0); PG8_BAR; PG8_SCHED;
            PG8_STAGE(PG8_SB(0, 1), b2 + hstep, voffB);
            PG8_WAIT_V(6); PG8_BAR; PG8_MMA(1, 1, At, B1); PG8_BAR;
            PG8_LDB(B0, 1, 0); PG8_SCHED; PG8_LDA(At, 1, 0); PG8_STAGE(PG8_SA(0, 1), a2 + hstep, voffA);
            PG8_WAIT_L(8); PG8_BAR; PG8_WAIT_L(0); PG8_MMA(0, 0, At, B0); PG8_BAR; PG8_SCHED;
            PG8_LDB(B1, 1, 1); PG8_STAGE(PG8_SB(1, 0), b3, voffB);
            PG8_BAR; PG8_WAIT_L(0); PG8_MMA(0, 1, At, B1); PG8_BAR;
            PG8_LDA(At, 1, 1); PG8_STAGE(PG8_SA(1, 0), a3, voffA);
            PG8_BAR; PG8_WAIT_L(0); PG8_MMA(1, 0, At, B0); PG8_BAR; PG8_SCHED;
            PG8_STAGE(PG8_SB(1, 1), b3 + hstep, voffB);
            PG8_WAIT_V(6); PG8_BAR; PG8_MMA(1, 1, At, B1); PG8_BAR;
        }
        PG8_STAMP();
        if constexpr (!Epi::AFTER_DRAIN) { E(acc, cur, wr, wc, fr, fq); S.done(cur); }
        PG8_STAMP();
        if (!has_next) break;
#pragma unroll
        for (int a = 0; a < 2; ++a)
#pragma unroll
            for (int b = 0; b < 2; ++b)
#pragma unroll
                for (int m = 0; m < 4; ++m)
#pragma unroll
                    for (int n = 0; n < 2; ++n) acc[a][b][m][n] = (f32x4){0.f, 0.f, 0.f, 0.f};
        cur = nxt; cA = nA; cB = nB; ++ui;
    }
    PG8_WAIT_V(0);
    if (wr == 0) PG8_BAR;
    PG8_BAR;
    if constexpr (Epi::AFTER_DRAIN) { E.fused(acc, cur, wr, wc, fr, fq, lds, wid, lane); S.done(cur); }
    PG8_STAMP();
    if (STAMP && wid == 0) { stamps[lane] = lane < nts ? (((unsigned long long)(unsigned)ts_hi << 32) | (unsigned)ts_lo) : 0ull;
        if (lane == 62) stamps[62] = rt_entry; if (lane == 63) stamps[63] = (unsigned long long)wall_clock64(); }
#undef PG8_STAMP
#undef PG8_SA
#undef PG8_SB
#undef PG8_STAGE
#undef PG8_LDA
#undef PG8_LDB
#undef PG8_MMA
#undef PG8_WAIT_V
#undef PG8_WAIT_L
#undef PG8_BAR
#undef PG8_SCHED
}
}
#ifndef LAS
#define LAS __attribute__((address_space(3)))
#endif
#define XB_TMO      128
#define XB_XCNT(j)  (256  + 64 * (j))
#define XB_XSUB(j)  (1280 + 64 * (j))
#define XB_XGEN(j)  (2304 + 64 * (j))
#define XB_TOP      3328
#define XB_TOPGEN   3392
#define XCD_BAR_WORDS 3456
#define XB_SPIN_CAP (1u << 18)

__device__ __forceinline__ unsigned xb_ld(unsigned* p)              { return __hip_atomic_load(p, __ATOMIC_RELAXED, __HIP_MEMORY_SCOPE_AGENT); }
__device__ __forceinline__ unsigned xb_add(unsigned* p, unsigned v) { return __hip_atomic_fetch_add(p, v, __ATOMIC_RELAXED, __HIP_MEMORY_SCOPE_AGENT); }
__device__ __forceinline__ unsigned xb_xcc_id() { return (unsigned)__builtin_amdgcn_s_getreg((3 << 11) | 20) & 0xFu; }
#define XB_SPIN(cond, bar) do { unsigned _sp = 0; while (cond) { __builtin_amdgcn_s_sleep(1); \
    if ((++_sp & 255u) == 0u) { if (xb_ld(&(bar)[XB_TMO])) break; if (_sp > XB_SPIN_CAP) { atomicAdd(&(bar)[XB_TMO], 1u); break; } } } } while (0)

struct XcdBarrier {
    unsigned* bar; unsigned x;
    volatile LAS unsigned* st;
};

__device__ __forceinline__ XcdBarrier xcd_barrier_post(unsigned* bar, volatile LAS unsigned* st) {
    XcdBarrier b; b.bar = bar; b.x = xb_xcc_id(); b.st = st;
    if (threadIdx.x == 0) (void)xb_add(&bar[XB_XCNT(b.x)], 1u);
    return b;
}
__device__ __forceinline__ void xcd_barrier_complete(unsigned* bar, unsigned x, unsigned& nloc, unsigned& nx) {
    const unsigned G = gridDim.x * gridDim.y * gridDim.z;
    unsigned sum, cnt, mine, sp = 0u;
    for (;;) {
        sum = 0u; cnt = 0u; mine = 0u;
#pragma unroll
        for (unsigned j = 0; j < 16; ++j) { const unsigned c = xb_ld(&bar[XB_XCNT(j)]); sum += c; cnt += (c > 0u) ? 1u : 0u; mine = (j == x) ? c : mine; }
        if (sum == G) break;
        __builtin_amdgcn_s_sleep(1);
        if ((++sp & 255u) == 0u) { if (xb_ld(&bar[XB_TMO])) break; if (sp > XB_SPIN_CAP) { atomicAdd(&bar[XB_TMO], 1u); break; } }
    }
    nloc = mine > 0u ? mine : 1u; nx = cnt > 0u ? cnt : 1u;
}

__device__ __forceinline__ void xcd_barrier(const XcdBarrier& b) {
    asm volatile("s_waitcnt vmcnt(0)" ::: "memory");
    __syncthreads();
    if (threadIdx.x == 0) {
        unsigned* bar = b.bar;
        __builtin_amdgcn_s_waitcnt(0);
        unsigned nloc = b.st[0], nx = b.st[1];
        if (nloc == 0u) { xcd_barrier_complete(bar, b.x, nloc, nx); b.st[0] = nloc; b.st[1] = nx; }
        const unsigned old = xb_add(&bar[XB_XSUB(b.x)], 1u);
        const unsigned gen = old / nloc;
        if (old + 1u == (gen + 1u) * nloc) {
            __builtin_amdgcn_fence(__ATOMIC_RELEASE, "agent");
            asm volatile("s_waitcnt vmcnt(0)" ::: "memory");
            const unsigned og = xb_add(&bar[XB_TOP], 1u);
            const unsigned tg = og / nx;
            if (og + 1u == (tg + 1u) * nx) xb_add(&bar[XB_TOPGEN], 1u);
            else XB_SPIN(xb_ld(&bar[XB_TOPGEN]) == tg, bar);
            __builtin_amdgcn_fence(__ATOMIC_ACQUIRE, "agent");
            xb_add(&bar[XB_XGEN(b.x)], 1u);
            asm volatile("s_waitcnt vmcnt(0)" ::: "memory");
        } else {
            XB_SPIN(xb_ld(&bar[XB_XGEN(b.x)]) == gen, bar);
            __builtin_amdgcn_fence(__ATOMIC_ACQUIRE, "agent");
            asm volatile("s_waitcnt vmcnt(0)" ::: "memory");
        }
    }
    __syncthreads();
}


using pg8::bf16_t; using pg8::bf16x8; using pg8::f32x4; using pg8::u32x4;
typedef unsigned u32x2 __attribute__((ext_vector_type(2)));
#define LAS __attribute__((address_space(3)))
typedef LAS unsigned char* ldsp_t;

constexpr int M = 32768, NPE = 3840, NPO = 2816;
constexpr float EPS = 1e-6f;
constexpr int LDS_CTRL = 155648;
constexpr int LDS_BYTES = 159744;

constexpr size_t SZ_WGU = (size_t)5632 * 1024 * 2, SZ_WD = (size_t)1024 * 2816 * 2;
constexpr size_t WS_WGU = 0;
constexpr size_t WS_WD = WS_WGU + 4 * SZ_WGU;
constexpr size_t WS_EWIN = WS_WD + 4 * SZ_WD;
constexpr size_t WS_OWIN = WS_EWIN + (size_t)NPE * 1024 * 2;
constexpr size_t WS_EWOUT = WS_OWIN + (size_t)NPO * 1024 * 2;
constexpr size_t WS_OWOUT = WS_EWOUT + (size_t)1024 * 1024 * 2;
constexpr size_t WS_MLQK = WS_OWOUT + (size_t)1024 * 1024 * 2;
constexpr size_t WS_ROPE = WS_MLQK + (size_t)1024 * 512 * 2;
constexpr size_t WS_SS = WS_ROPE + (size_t)2 * 4096 * 64 * 4;
constexpr size_t WS_DEN = WS_SS + (size_t)7 * 16 * M * 4;
constexpr size_t WS_EN = WS_DEN + (size_t)M * 4 * 4;
constexpr size_t WS_XB = WS_EN + (size_t)M * 4 * 4;
constexpr size_t WS_OB = WS_XB + (size_t)M * 1024 * 2;
constexpr size_t WS_R = WS_OB + (size_t)M * 1024 * 2;
constexpr size_t WS_QKB = WS_R + (size_t)M * NPO * 2;
constexpr size_t WS_BAR = WS_R + (size_t)M * NPE * 2;
constexpr size_t WS_END = WS_BAR + 16384;

struct Params { const float* in[30]; float* out; unsigned char* ws; int ph_lo, ph_hi; };

__device__ __forceinline__ float bflo(unsigned w) { return __uint_as_float(w << 16); }
__device__ __forceinline__ float bfhi(unsigned w) { return __uint_as_float(w & 0xffff0000u); }
__device__ __forceinline__ float bf2f(bf16_t b) { return __uint_as_float(((unsigned)b) << 16); }
__device__ __forceinline__ bf16_t f2bf(float f) { return (bf16_t)(pg8::cvt_pk_bf16(f, 0.f) & 0xffffu); }
__device__ __forceinline__ float sigmoid_f(float x) { return __builtin_amdgcn_rcpf(1.f + __expf(-x)); }
__device__ __forceinline__ float silu_f(float x) { return x * __builtin_amdgcn_rcpf(1.f + __expf(-x)); }
template <int CTRL> __device__ __forceinline__ float dpp_add(float v) { return v + __int_as_float(__builtin_amdgcn_update_dpp(0, __float_as_int(v), CTRL, 0xF, 0xF, true)); }
__device__ __forceinline__ float reduce8(float o) { o = dpp_add<0xB1>(o); o = dpp_add<0x4E>(o); o = dpp_add<0x141>(o); return o; }
__device__ __forceinline__ float reduce16(float o) { return dpp_add<0x140>(reduce8(o)); }
__device__ __forceinline__ float logsigmoid_f(float z) { return fminf(z, 0.f) - log1pf(__expf(-fabsf(z))); }
__device__ __forceinline__ void unpack8(const u32x4 w, float (&f)[8]) {
    f[0] = bflo(w.x); f[1] = bfhi(w.x); f[2] = bflo(w.y); f[3] = bfhi(w.y); f[4] = bflo(w.z); f[5] = bfhi(w.z); f[6] = bflo(w.w); f[7] = bfhi(w.w);
}
__device__ __forceinline__ u32x4 pack8(const float (&f)[8]) {
    u32x4 w; w.x = pg8::cvt_pk_bf16(f[0], f[1]); w.y = pg8::cvt_pk_bf16(f[2], f[3]); w.z = pg8::cvt_pk_bf16(f[4], f[5]); w.w = pg8::cvt_pk_bf16(f[6], f[7]); return w;
}

__device__ __forceinline__ float row_rs(const float* ssb, int row) {
    const f32x4* q = (const f32x4*)(ssb + (size_t)row * 16);
    const f32x4 a = q[0], b = q[1], c = q[2], d = q[3];
    const float s = ((a[0] + a[1]) + (a[2] + a[3])) + ((b[0] + b[1]) + (b[2] + b[3])) + ((c[0] + c[1]) + (c[2] + c[3])) + ((d[0] + d[1]) + (d[2] + d[3]));
    return rsqrtf(s * (1.0f / 1024.0f) + EPS);
}
__device__ __forceinline__ void panel_rs(const float* ss, LAS float* rsl, int& cur_pm, int pm) {
    if (pm != cur_pm) {
        cur_pm = pm;
        if (threadIdx.x < 256) rsl[threadIdx.x] = row_rs(ss, pm * 256 + (int)threadIdx.x);
        asm volatile("s_waitcnt lgkmcnt(0)" ::: "memory");
        __builtin_amdgcn_s_barrier();
        asm volatile("" ::: "memory");
    }
}
struct EpiSwiGLU {
    static constexpr bool PERM = true, AFTER_DRAIN = false;
    bf16_t* G; const float* ss; LAS float* rsl; mutable int cur_pm;
    __device__ __forceinline__ void operator()(const f32x4 (&acc)[2][2][4][2], const pg8::Unit& u, int wr, int wc, int fr, int fq) const {
        const int row0 = u.pm * 256 + wr * 64 + fr, col0 = u.pn * 128 + wc * 32 + 8 * fq;
        panel_rs(ss, rsl, cur_pm, u.pm);
        float rsv[2][4];
#pragma unroll
        for (int ai = 0; ai < 2; ++ai)
#pragma unroll
            for (int m = 0; m < 4; ++m) rsv[ai][m] = rsl[wr * 64 + fr + ai * 128 + m * 16];
#pragma unroll
        for (int ai = 0; ai < 2; ++ai)
#pragma unroll
            for (int m = 0; m < 4; ++m) {
                const int row = row0 + ai * 128 + m * 16;
                const float rs = rsv[ai][m];
                float o[8];
#pragma unroll
                for (int n = 0; n < 2; ++n)
#pragma unroll
                    for (int j = 0; j < 4; ++j) { const float g = acc[ai][0][m][n][j] * rs, uu = acc[ai][1][m][n][j] * rs; o[n * 4 + j] = silu_f(g) * uu; }
                *(u32x4*)(G + (size_t)row * 2816 + col0) = pack8(o);
            }
    }
};
struct EpiResid {
    static constexpr bool PERM = true, AFTER_DRAIN = false;
    bf16_t* xb; float* ssn; float scale;
    __device__ __forceinline__ void operator()(const f32x4 (&acc)[2][2][4][2], const pg8::Unit& u, int wr, int wc, int fr, int fq) const {
        const int row0 = u.pm * 256 + wr * 64 + fr, col0 = u.pn * 256 + wc * 32 + 8 * fq;
        u32x4 rr[2][4][2];
#pragma unroll
        for (int ai = 0; ai < 2; ++ai)
#pragma unroll
            for (int m = 0; m < 4; ++m)
#pragma unroll
                for (int bj = 0; bj < 2; ++bj) rr[ai][m][bj] = *(const u32x4*)(xb + (size_t)(row0 + ai * 128 + m * 16) * 1024 + col0 + bj * 128);
#pragma unroll
        for (int ai = 0; ai < 2; ++ai)
#pragma unroll
            for (int m = 0; m < 4; ++m) {
                const int row = row0 + ai * 128 + m * 16;
                float part = 0.f;
#pragma unroll
                for (int bj = 0; bj < 2; ++bj) {
                    float r[8], h[8];
                    unpack8(rr[ai][m][bj], r);
#pragma unroll
                    for (int n = 0; n < 2; ++n)
#pragma unroll
                        for (int j = 0; j < 4; ++j) { h[n * 4 + j] = fmaf(acc[ai][bj][m][n][j], scale, r[n * 4 + j]); part = fmaf(h[n * 4 + j], h[n * 4 + j], part); }
                    *(u32x4*)(xb + (size_t)row * 1024 + col0 + bj * 128) = pack8(h);
                }
                part += __shfl_xor(part, 16); part += __shfl_xor(part, 32);
                if (fq == 0) ssn[(size_t)row * 16 + (u.pn * 4 + wc)] = part;
            }
    }
};
struct EpiProj {
    static constexpr bool PERM = true, AFTER_DRAIN = false;
    bf16_t* P; int ld; const float* ss; LAS float* rsl; mutable int cur_pm;
    __device__ __forceinline__ void operator()(const f32x4 (&acc)[2][2][4][2], const pg8::Unit& u, int wr, int wc, int fr, int fq) const {
        const int row0 = u.pm * 256 + wr * 64 + fr, col0 = u.pn * 256 + wc * 32 + 8 * fq;
        if (ss) panel_rs(ss, rsl, cur_pm, u.pm);
        float rsv[2][4];
#pragma unroll
        for (int ai = 0; ai < 2; ++ai)
#pragma unroll
            for (int m = 0; m < 4; ++m) rsv[ai][m] = ss ? rsl[wr * 64 + fr + ai * 128 + m * 16] : 1.0f;
#pragma unroll
        for (int ai = 0; ai < 2; ++ai)
#pragma unroll
            for (int m = 0; m < 4; ++m) {
                const int row = row0 + ai * 128 + m * 16;
                const float rs = rsv[ai][m];
#pragma unroll
                for (int bj = 0; bj < 2; ++bj) {
                    float o[8];
#pragma unroll
                    for (int n = 0; n < 2; ++n)
#pragma unroll
                        for (int j = 0; j < 4; ++j) o[n * 4 + j] = acc[ai][bj][m][n][j] * rs;
                    *(u32x4*)(P + (size_t)row * ld + col0 + bj * 128) = pack8(o);
                }
            }
    }
};
template <class Epi> __device__ __forceinline__ void run_gemm(ldsp_t lds, const bf16_t* A, const bf16_t* Bt, int N, int K, const Epi& E) {
    pg8::Gemm g{A, Bt, M, N, K}; pg8::StaticOrder S; S.init(M, N, (int)gridDim.x, (int)blockIdx.x);
    pg8::gemm_phase<Epi, pg8::StaticOrder>(lds, g, S, E, nullptr);
}

struct CvtJob { const float* src; const float* scale; bf16_t* dst; int K, N, mode; };
__device__ __forceinline__ void get_job(const Params& p, int j, CvtJob& J) {
    unsigned char* ws = p.ws;
    if (j < 4) { const int l = j >> 1, f = j & 1; J.src = (f ? p.in[6] : p.in[2]) + (size_t)l * 1024 * 5632; J.scale = (f ? p.in[5] : p.in[1]) + l * 1024;
        J.dst = (bf16_t*)(ws + WS_WGU + (size_t)j * SZ_WGU); J.K = 1024; J.N = 5632; J.mode = 1; }
    else if (j < 8) { const int jj = j - 4, l = jj >> 1, f = jj & 1; J.src = (f ? p.in[7] : p.in[3]) + (size_t)l * 2816 * 1024; J.scale = nullptr;
        J.dst = (bf16_t*)(ws + WS_WD + (size_t)jj * SZ_WD); J.K = 2816; J.N = 1024; J.mode = 0; }
    else if (j == 8) { J.src = p.in[8]; J.scale = p.in[4]; J.dst = (bf16_t*)(ws + WS_EWIN); J.K = 1024; J.N = 3600; J.mode = 0; }
    else if (j == 9) { J.src = p.in[13]; J.scale = p.in[4] + 1024; J.dst = (bf16_t*)(ws + WS_OWIN); J.K = 1024; J.N = 2568; J.mode = 0; }
    else if (j == 10) { J.src = p.in[12]; J.scale = nullptr; J.dst = (bf16_t*)(ws + WS_EWOUT); J.K = 1024; J.N = 1024; J.mode = 0; }
    else { J.src = p.in[28]; J.scale = nullptr; J.dst = (bf16_t*)(ws + WS_OWOUT); J.K = 1024; J.N = 1024; J.mode = 0; }
}
__device__ __forceinline__ void cvt_tile_load(const Params& p, int t, int tid, f32x4& v0, f32x4& v1, float& s0, float& s1, bf16_t*& dst) {
    int j, tt;
    if (t < 5632) { j = t / 1408; tt = t % 1408; }
    else if (t < 8448) { j = 4 + (t - 5632) / 704; tt = (t - 5632) % 704; }
    else if (t < 9344) { j = 8; tt = t - 8448; }
    else if (t < 10048) { j = 9; tt = t - 9344; }
    else if (t < 10304) { j = 10; tt = t - 10048; }
    else { j = 11; tt = t - 10304; }
    CvtJob J; get_job(p, j, J);
    const int kbn = J.K >> 6, nb = tt / kbn, kb = tt % kbn;
    const int srccol0 = (J.mode == 1) ? (((nb & 3) < 2) ? 128 * (nb >> 2) + 64 * (nb & 3) : 2816 + 128 * (nb >> 2) + 64 * ((nb & 3) - 2)) : 64 * nb;
    const int r = tid >> 4, col = srccol0 + (tid & 15) * 4, k0 = kb * 64 + r;
    v0 = (f32x4){0.f, 0.f, 0.f, 0.f}; v1 = v0;
    if (col < J.N) { v0 = *(const f32x4*)(J.src + (size_t)k0 * J.N + col); v1 = *(const f32x4*)(J.src + (size_t)(k0 + 32) * J.N + col); }
    s0 = J.scale ? J.scale[k0] : 1.0f; s1 = J.scale ? J.scale[k0 + 32] : 1.0f;
    dst = J.dst + (size_t)(nb * 64 + (tid >> 3)) * J.K + kb * 64 + (tid & 7) * 8;
}
__device__ __forceinline__ void phase_prep(const Params& p, ldsp_t lds) {
    const int tid = threadIdx.x, lane = tid & 63, w = tid >> 6;
    LAS float* tb = (LAS float*)lds;
    {
        f32x4 v0, v1; float s0, s1; bf16_t* dst;
        int t = blockIdx.x;
        if (t < 10560) cvt_tile_load(p, t, tid, v0, v1, s0, s1, dst);
        for (; t < 10560; t += gridDim.x) {
            { const int r = tid >> 4, c4 = (tid & 15) * 4;
              tb[r * 65 + c4 + 0] = v0[0] * s0; tb[r * 65 + c4 + 1] = v0[1] * s0; tb[r * 65 + c4 + 2] = v0[2] * s0; tb[r * 65 + c4 + 3] = v0[3] * s0;
              tb[(r + 32) * 65 + c4 + 0] = v1[0] * s1; tb[(r + 32) * 65 + c4 + 1] = v1[1] * s1; tb[(r + 32) * 65 + c4 + 2] = v1[2] * s1; tb[(r + 32) * 65 + c4 + 3] = v1[3] * s1; }
            __syncthreads();
            bf16_t* const dcur = dst;
            if (t + (int)gridDim.x < 10560) cvt_tile_load(p, t + (int)gridDim.x, tid, v0, v1, s0, s1, dst);
            { const int nl = tid >> 3, kc = (tid & 7) * 8;
              float o[8];
#pragma unroll
              for (int e = 0; e < 8; ++e) o[e] = tb[(kc + e) * 65 + nl];
              *(u32x4*)dcur = pack8(o); }
            __syncthreads();
        }
    }
    {
        const float* x = p.in[0]; bf16_t* XB = (bf16_t*)(p.ws + WS_XB); float* SS = (float*)(p.ws + WS_SS);
        for (int row = blockIdx.x * 8 + w; row < M; row += gridDim.x * 8) {
            const f32x4* xr = (const f32x4*)(x + (size_t)row * 1024);
            float ss = 0.f;
#pragma unroll
            for (int i = 0; i < 4; ++i) {
                const f32x4 v = xr[lane + 64 * i];
                ss += (v[0] * v[0] + v[1] * v[1]) + (v[2] * v[2] + v[3] * v[3]);
                u32x2 pk; pk.x = pg8::cvt_pk_bf16(v[0], v[1]); pk.y = pg8::cvt_pk_bf16(v[2], v[3]);
                *(u32x2*)(XB + (size_t)row * 1024 + (lane + 64 * i) * 4) = pk;
            }
#pragma unroll
            for (int o = 32; o >= 1; o >>= 1) ss += __shfl_xor(ss, o);
            if (lane < 16) SS[(size_t)row * 16 + lane] = (lane == 0) ? ss : 0.f;
        }
    }
    {
        float* rc = (float*)(p.ws + WS_ROPE); float* rsn = rc + 4096 * 64;
        for (int i = blockIdx.x * 512 + tid; i < 4096 * 64; i += gridDim.x * 512) {
            const int pos = i >> 6, j = i & 63;
            const float inv = exp2f(-(float)j * (13.287712379549449f / 64.0f));
            double rev = (double)pos * (double)inv * 0.15915494309189535;
            rev -= rint(rev);
            const float r = (float)(rev * 6.283185307179586);
            rc[i] = cosf(r); rsn[i] = sinf(r);
        }
    }
    {
        bf16_t* W = (bf16_t*)(p.ws + WS_EWIN) + (size_t)3584 * 1024;
        for (int i = blockIdx.x * 512 + tid; i < 256 * 1024; i += gridDim.x * 512) {
            const int c = i >> 10, k = i & 1023;
            const float* wr = p.in[8] + (size_t)k * 3600 + 3584;
            float acc = 0.f;
#pragma unroll
            for (int r = 0; r < 16; ++r) acc = fmaf(wr[r], p.in[9][r * 256 + c], acc);
            W[i] = f2bf(acc * p.in[4][k]);
        }
    }
    {
        bf16_t* W = (bf16_t*)(p.ws + WS_MLQK);
        for (int i = blockIdx.x * 512 + tid; i < 1024 * 512; i += gridDim.x * 512) {
            const int n = i >> 9, k = i & 511, h = (n & 511) >> 7, j = n & 127;
            float v = 0.f;
            if ((k >> 7) == h) v = (n < 512) ? p.in[23][h * 16384 + (k & 127) * 128 + j] : p.in[24][h * 16384 + (k & 127) * 128 + j] * 0.08838834764831845f;
            W[i] = f2bf(v);
        }
    }
}

#define MIX_FMA8(S, ka, kb, vv) do { S[0] = fmaf(ka[0], vv, S[0]); S[1] = fmaf(ka[1], vv, S[1]); S[2] = fmaf(ka[2], vv, S[2]); S[3] = fmaf(ka[3], vv, S[3]); \
    S[4] = fmaf(kb[0], vv, S[4]); S[5] = fmaf(kb[1], vv, S[5]); S[6] = fmaf(kb[2], vv, S[6]); S[7] = fmaf(kb[3], vv, S[7]); } while (0)
#define MIX_DOT8(o, S, qa, qb) do { o = qa[0] * S[0]; o = fmaf(qa[1], S[1], o); o = fmaf(qa[2], S[2], o); o = fmaf(qa[3], S[3], o); \
    o = fmaf(qb[0], S[4], o); o = fmaf(qb[1], S[5], o); o = fmaf(qb[2], S[6], o); o = fmaf(qb[3], S[7], o); } while (0)

typedef short s16x4 __attribute__((ext_vector_type(4)));
__device__ __forceinline__ bf16x8 tr_frag(const LAS bf16_t* T, int LD, int c16, int ks, int lane) {
    const int g = lane >> 4, q = (lane & 15) >> 2, pp = lane & 3;
    const LAS bf16_t* a0 = T + (32 * ks + 8 * g + q) * LD + 16 * c16 + 4 * pp;
    const s16x4 lo = __builtin_amdgcn_ds_read_tr16_b64_v4i16((LAS s16x4*)a0);
    const s16x4 hi = __builtin_amdgcn_ds_read_tr16_b64_v4i16((LAS s16x4*)(a0 + 4 * LD));
    return (bf16x8){lo[0], lo[1], lo[2], lo[3], hi[0], hi[1], hi[2], hi[3]};
}
__device__ __forceinline__ bf16x8 row_frag(const LAS bf16_t* T, int LD, int r16, int kk, int fr, int fq) {
    return *(const LAS bf16x8*)(T + (16 * r16 + fr) * LD + 32 * kk + 8 * fq);
}
__device__ __forceinline__ void st_bf16x4(LAS bf16_t* dst, const f32x4 v) { u32x2 pk; pk.x = pg8::cvt_pk_bf16(v[0], v[1]); pk.y = pg8::cvt_pk_bf16(v[2], v[3]); *(LAS u32x2*)dst = pk; }

template <int CTRL> __device__ __forceinline__ float dpp_mov_old(float oldv, float v) { return __int_as_float(__builtin_amdgcn_update_dpp(__float_as_int(oldv), __float_as_int(v), CTRL, 0xF, 0xF, false)); }
__device__ __forceinline__ float readlane_f(float v, int l) { return __int_as_float(__builtin_amdgcn_readlane(__float_as_int(v), l)); }
__device__ __forceinline__ float wave_scan_add(float x, int lane) {
    x += dpp_mov_old<0x111>(0.f, x); x += dpp_mov_old<0x112>(0.f, x); x += dpp_mov_old<0x114>(0.f, x); x += dpp_mov_old<0x118>(0.f, x);
    const float t0 = readlane_f(x, 15), t1 = readlane_f(x, 31), t2 = readlane_f(x, 47);
    const int row = lane >> 4;
    return x + ((row >= 1 ? t0 : 0.f) + (row >= 2 ? t1 : 0.f) + (row >= 3 ? t2 : 0.f));
}
__device__ __forceinline__ float wave_scan_max(float x, int lane) {
    const float ninf = -__builtin_huge_valf();
    x = fmaxf(x, dpp_mov_old<0x111>(ninf, x)); x = fmaxf(x, dpp_mov_old<0x112>(ninf, x)); x = fmaxf(x, dpp_mov_old<0x114>(ninf, x)); x = fmaxf(x, dpp_mov_old<0x118>(ninf, x));
    const float t0 = readlane_f(x, 15), t1 = readlane_f(x, 31), t2 = readlane_f(x, 47);
    const int row = lane >> 4;
    const float pre = fmaxf(row >= 1 ? t0 : ninf, fmaxf(row >= 2 ? t1 : ninf, row >= 3 ? t2 : ninf));
    return fmaxf(x, pre);
}
__device__ __forceinline__ float logsigmoid_fast(float z) { return fminf(z, 0.f) - __logf(1.0f + __expf(-fabsf(z))); }
template <int DK, int MODE>
__device__ __forceinline__ void mfma_chunk_p(const LAS bf16_t* Qb, const LAS bf16_t* Kb, LAS bf16_t* Pb, LAS float* DP, int w, int lane) {
    constexpr int LD = DK + 8, PLD = 72, KS = DK / 32;
    const int fr = lane & 15, fq = lane >> 4, ts = w & 3;
#pragma unroll
    for (int tt = 0; tt < 2; ++tt) {
        const int tl = 2 * (w >> 2) + tt;
        f32x4 acc = (f32x4){0.f, 0.f, 0.f, 0.f};
        if (ts <= tl) {
#pragma unroll
            for (int kk = 0; kk < KS; ++kk) acc = __builtin_amdgcn_mfma_f32_16x16x32_bf16(row_frag(Kb, LD, ts, kk, fr, fq), row_frag(Qb, LD, tl, kk, fr, fq), acc, 0, 0, 0);
            if (ts == tl) {
#pragma unroll
                for (int r = 0; r < 4; ++r) if (4 * fq + r > fr) acc[r] = 0.f;
            }
        }
        st_bf16x4(Pb + (16 * tl + fr) * PLD + 16 * ts + 4 * fq, acc);
        if (MODE == 2) { float part = (acc[0] + acc[1]) + (acc[2] + acc[3]); part += __shfl_xor(part, 16); part += __shfl_xor(part, 32); if (fq == 0) DP[ts * 64 + 16 * tl + fr] = part; }
    }
}
template <int DK, int MODE>
__device__ __forceinline__ void mfma_chunk_os(const LAS bf16_t* Qb, const LAS bf16_t* Kb, const LAS bf16_t* Vb, LAS bf16_t* STb, const LAS bf16_t* Pb, f32x4 (&Sacc)[DK / 32],
                                              bf16_t* orow, int ldo, int tile, float cs, float qscv, const LAS float* EBE, int w, int lane, int hv) {
    constexpr int LD = DK + 8, PLD = 72, KS = DK / 32, DTH = DK / 32;
    const int fr = lane & 15, fq = lane >> 4, vt = w & 3, hh = w >> 2, vabs = hv * 4 + vt;
    const bf16x8 vt0 = tr_frag(Vb, 136, vabs, 0, lane), vt1 = tr_frag(Vb, 136, vabs, 1, lane);
    bf16x8 st[KS];
#pragma unroll
    for (int kk = 0; kk < KS; ++kk) st[kk] = row_frag(STb + (tile & 1) * 64 * LD, LD, vt, kk, fr, fq);
#pragma unroll
    for (int tt = 0; tt < 2; ++tt) {
        const int tl = 2 * hh + tt;
        f32x4 accP = (f32x4){0.f, 0.f, 0.f, 0.f}, accS = (f32x4){0.f, 0.f, 0.f, 0.f};
        accP = __builtin_amdgcn_mfma_f32_16x16x32_bf16(vt0, *(const LAS bf16x8*)(Pb + (16 * tl + fr) * PLD + 8 * fq), accP, 0, 0, 0);
        accP = __builtin_amdgcn_mfma_f32_16x16x32_bf16(vt1, *(const LAS bf16x8*)(Pb + (16 * tl + fr) * PLD + 32 + 8 * fq), accP, 0, 0, 0);
        if (tile > 0) {
#pragma unroll
            for (int kk = 0; kk < KS; ++kk) accS = __builtin_amdgcn_mfma_f32_16x16x32_bf16(st[kk], row_frag(Qb, LD, tl, kk, fr, fq), accS, 0, 0, 0);
        }
        f32x4 o;
        if (MODE == 2) { const float qs = __shfl(qscv, 16 * tl + fr); o = (accP + accS * cs) * qs; } else o = accP + accS;
        u32x2 pk; pk.x = pg8::cvt_pk_bf16(o[0], o[1]); pk.y = pg8::cvt_pk_bf16(o[2], o[3]);
        *(u32x2*)(orow + (size_t)(tile * 64 + 16 * tl + fr) * ldo) = pk;
    }
#pragma unroll
    for (int i = 0; i < DTH; ++i) {
        const int dt = hh * DTH + i;
        if (MODE == 2) Sacc[i] = Sacc[i] * cs;
        Sacc[i] = __builtin_amdgcn_mfma_f32_16x16x32_bf16(tr_frag(Kb, LD, dt, 0, lane), vt0, Sacc[i], 0, 0, 0);
        Sacc[i] = __builtin_amdgcn_mfma_f32_16x16x32_bf16(tr_frag(Kb, LD, dt, 1, lane), vt1, Sacc[i], 0, 0, 0);
        if (MODE == 1) Sacc[i] = Sacc[i] * *(const LAS f32x4*)(EBE + 16 * dt + 4 * fq);
        if (MODE == 0) Sacc[i] = Sacc[i] * cs;
        st_bf16x4(STb + ((tile + 1) & 1) * 64 * LD + (16 * vt + fr) * LD + 16 * dt + 4 * fq, Sacc[i]);
    }
}

__device__ __forceinline__ void mix_retention_mfma(const Params& p, ldsp_t lds, int item) {
    const int b = item >> 3, h = (item >> 1) & 3, hv = item & 1;
    constexpr int LD = 136, PLD = 72;
    constexpr int TB = 64 * LD;
    LAS bf16_t* Qb = (LAS bf16_t*)lds; LAS bf16_t* Kb = Qb + 2 * TB; LAS bf16_t* Vb = Kb + 2 * TB; LAS bf16_t* STb = Vb + 2 * TB; LAS bf16_t* Pb = STb + 128 * LD;
    const int tid = threadIdx.x, lane = tid & 63, w = __builtin_amdgcn_readfirstlane(tid >> 6), fq = lane >> 4;
    const int sj = tid >> 3, sc = tid & 7;
    bf16_t* P = (bf16_t*)(p.ws + WS_R);
    const float* ropec = (const float*)(p.ws + WS_ROPE); const float* ropes = ropec + 4096 * 64;
    const float l2g = log2f(1.0f - exp2f(-5.0f - (float)h));
    const float gT = exp2f(64.0f * l2g);
    const float dq = exp2f((float)(sj + 1) * l2g), dkk = exp2f(-(float)(sj + 1) * l2g) * 0.08838834764831845f;
    const bf16_t* qrow = P + ((size_t)b * 4096 + sj) * NPE + h * 128 + sc * 8;
    bf16_t* orow = P + ((size_t)b * 4096) * NPE + 1024 + h * 128 + 16 * (hv * 4 + (w & 3)) + 4 * fq;
    f32x4 Sacc[4];
#pragma unroll
    for (int i = 0; i < 4; ++i) Sacc[i] = (f32x4){0.f, 0.f, 0.f, 0.f};
    u32x4 rq1, rq2, rk1, rk2, rv; f32x4 c0, c1, s0, s1;
#define RETM_LOAD(t0) do { const bf16_t* qp_ = qrow + (size_t)(t0) * NPE; rq1 = *(const u32x4*)qp_; rq2 = *(const u32x4*)(qp_ + 64); rk1 = *(const u32x4*)(qp_ + 512); rk2 = *(const u32x4*)(qp_ + 576); \
        rv = *(const u32x4*)(qp_ + 1024 + hv * 64); \
        const float* cp_ = ropec + ((t0) + sj) * 64 + sc * 8; c0 = *(const f32x4*)cp_; c1 = *(const f32x4*)(cp_ + 4); \
        const float* sp_ = ropes + ((t0) + sj) * 64 + sc * 8; s0 = *(const f32x4*)sp_; s1 = *(const f32x4*)(sp_ + 4); } while (0)
#define RETM_STAGE(bi) do { LAS bf16_t* Qd = Qb + (bi) * TB; LAS bf16_t* Kd = Kb + (bi) * TB; LAS bf16_t* Vd = Vb + (bi) * TB; \
            float a[8], bb[8], o1[8], o2[8]; \
            unpack8(rq1, a); unpack8(rq2, bb); \
            _Pragma("unroll") for (int i = 0; i < 4; ++i) { o1[i] = (a[i] * c0[i] - bb[i] * s0[i]) * dq; o2[i] = (a[i] * s0[i] + bb[i] * c0[i]) * dq; \
                                          o1[4 + i] = (a[4 + i] * c1[i] - bb[4 + i] * s1[i]) * dq; o2[4 + i] = (a[4 + i] * s1[i] + bb[4 + i] * c1[i]) * dq; } \
            *(LAS u32x4*)(Qd + sj * LD + sc * 8) = pack8(o1); *(LAS u32x4*)(Qd + sj * LD + 64 + sc * 8) = pack8(o2); \
            unpack8(rk1, a); unpack8(rk2, bb); \
            _Pragma("unroll") for (int i = 0; i < 4; ++i) { o1[i] = (a[i] * c0[i] - bb[i] * s0[i]) * dkk; o2[i] = (a[i] * s0[i] + bb[i] * c0[i]) * dkk; \
                                          o1[4 + i] = (a[4 + i] * c1[i] - bb[4 + i] * s1[i]) * dkk; o2[4 + i] = (a[4 + i] * s1[i] + bb[4 + i] * c1[i]) * dkk; } \
            *(LAS u32x4*)(Kd + sj * LD + sc * 8) = pack8(o1); *(LAS u32x4*)(Kd + sj * LD + 64 + sc * 8) = pack8(o2); \
            *(LAS u32x4*)(Vd + sj * LD + hv * 64 + sc * 8) = rv; } while (0)
    RETM_LOAD(0);
    RETM_STAGE(0);
    __syncthreads();
    RETM_LOAD(64);
    for (int tile = 0; tile < 64; ++tile) {
        const int cur = tile & 1;
        mfma_chunk_p<128, 0>(Qb + cur * TB, Kb + cur * TB, Pb, nullptr, w, lane);
        __syncthreads();
        mfma_chunk_os<128, 0>(Qb + cur * TB, Kb + cur * TB, Vb + cur * TB, STb, Pb, Sacc, orow, NPE, tile, gT, 1.0f, nullptr, w, lane, hv);
        if (tile + 1 < 64) { RETM_STAGE(cur ^ 1); if (tile + 2 < 64) RETM_LOAD((tile + 2) * 64); }
        __syncthreads();
    }
#undef RETM_STAGE
#undef RETM_LOAD
}

template <int ROLE>
__device__ __forceinline__ void mix_mlstm_mfma(const Params& p, ldsp_t lds, int item) {
    const int b = (ROLE == 0) ? (item >> 3) : (item >> 2), h = (ROLE == 0) ? ((item >> 1) & 3) : (item & 3), hv = (ROLE == 0) ? (item & 1) : 0;
    constexpr int LD = 136, PLD = 72;
    LAS bf16_t* Qb = (LAS bf16_t*)lds; LAS bf16_t* Kb = Qb + 64 * LD; LAS bf16_t* Vb = Kb + 64 * LD; LAS bf16_t* STb = Vb + 64 * LD; LAS bf16_t* Pb = STb + 128 * LD;
    LAS float* DP = (LAS float*)(Pb + 64 * PLD); LAS float* NV = DP + 256; LAS float* KS = NV + 128;
    const int tid = threadIdx.x, lane = tid & 63, w = __builtin_amdgcn_readfirstlane(tid >> 6), fq = lane >> 4;
    const int sj = tid >> 3, sc = tid & 7;
    bf16_t* P = (bf16_t*)(p.ws + WS_R); const bf16_t* QKB = (const bf16_t*)(p.ws + WS_QKB);
    float* DEN = (float*)(p.ws + WS_DEN); float* EN = (float*)(p.ws + WS_EN);
    const bf16_t* qrow = QKB + ((size_t)b * 4096 + sj) * 1024 + h * 128 + sc * 8;
    const bf16_t* vrow = P + ((size_t)b * 4096 + sj) * NPO + 1536 + h * 128 + hv * 64 + sc * 8;
    const bf16_t* irow = P + ((size_t)b * 4096 + lane) * NPO + 2560 + h;
    bf16_t* orow = P + ((size_t)b * 4096) * NPO + 1536 + h * 128 + 16 * (hv * 4 + (w & 3)) + 4 * fq;
    const float bi = p.in[25][h], bfv = p.in[26][h];
    float m_prev = 0.f;
    f32x4 Sacc[4];
#pragma unroll
    for (int i = 0; i < 4; ++i) Sacc[i] = (f32x4){0.f, 0.f, 0.f, 0.f};
    if (ROLE == 1 && tid < 128) NV[tid] = 0.f;
    u32x4 rq1, rq2, rk1, rk2, rv1 = (u32x4){0u, 0u, 0u, 0u}; bf16_t ri, rf;
#define MLM_LOAD(t0) do { const bf16_t* qp_ = qrow + (size_t)(t0) * 1024; rq1 = *(const u32x4*)qp_; rq2 = *(const u32x4*)(qp_ + 64); rk1 = *(const u32x4*)(qp_ + 512); rk2 = *(const u32x4*)(qp_ + 576); \
        if (ROLE == 0) { rv1 = *(const u32x4*)(vrow + (size_t)(t0) * NPO); } \
        ri = irow[(size_t)(t0) * NPO]; rf = irow[(size_t)(t0) * NPO + 4]; } while (0)
    MLM_LOAD(0);
    for (int tile = 0; tile < 64; ++tile) {
        float wv, qscv, env, cs;
        {
            const float fi = bf2f(ri) + bi, lf = logsigmoid_f(bf2f(rf) + bfv);
            const float F = wave_scan_add(lf, lane);
            const float g = fi - F;
            const float pm = wave_scan_max(g, lane);
            const float Mj = fmaxf(m_prev, pm);
            const float mu = readlane_f(Mj, 63);
            wv = __expf(g - mu); qscv = __expf(mu - Mj); env = __expf(-(F + Mj)); cs = __expf(m_prev - mu);
            m_prev = readlane_f(F, 63) + mu;
        }
        {
            const float wvs = __shfl(wv, sj);
            float a[8];
            *(LAS u32x4*)(Qb + sj * LD + sc * 8) = rq1; *(LAS u32x4*)(Qb + sj * LD + 64 + sc * 8) = rq2;
            unpack8(rk1, a);
#pragma unroll
            for (int i = 0; i < 8; ++i) a[i] *= wvs;
            *(LAS u32x4*)(Kb + sj * LD + sc * 8) = pack8(a);
            unpack8(rk2, a);
#pragma unroll
            for (int i = 0; i < 8; ++i) a[i] *= wvs;
            *(LAS u32x4*)(Kb + sj * LD + 64 + sc * 8) = pack8(a);
            if (ROLE == 0) { *(LAS u32x4*)(Vb + sj * LD + hv * 64 + sc * 8) = rv1; }
        }
        __syncthreads();
        if (tile + 1 < 64) MLM_LOAD((tile + 1) * 64);
        if (ROLE == 1) {
            const int kd = tid & 127, kp = tid >> 7;
            float ks = 0.f;
#pragma unroll
            for (int s2 = 0; s2 < 16; ++s2) ks += bf2f(Kb[(kp * 16 + s2) * LD + kd]);
            KS[kp * 128 + kd] = ks;
        }
        if (ROLE == 1) mfma_chunk_p<128, 2>(Qb, Kb, Pb, DP, w, lane); else mfma_chunk_p<128, 0>(Qb, Kb, Pb, nullptr, w, lane);
        __syncthreads();
        if (ROLE == 1) {
            const int l = tid >> 3, part = tid & 7;
            float qn = 0.f;
#pragma unroll
            for (int i = 0; i < 2; ++i) { float qv[8]; unpack8(*(const LAS u32x4*)(Qb + l * LD + part * 16 + i * 8), qv);
                const f32x4 n0 = *(const LAS f32x4*)(NV + part * 16 + i * 8), n1 = *(const LAS f32x4*)(NV + part * 16 + i * 8 + 4);
                qn += qv[0] * n0[0] + qv[1] * n0[1] + qv[2] * n0[2] + qv[3] * n0[3] + qv[4] * n1[0] + qv[5] * n1[1] + qv[6] * n1[2] + qv[7] * n1[3]; }
            qn = reduce8(qn);
            const float qs_l = __shfl(qscv, l), en_l = __shfl(env, l);
            if (part == 0) {
                const float dsum = (DP[l] + DP[64 + l]) + (DP[128 + l] + DP[192 + l]);
                const size_t o = ((size_t)b * 4096 + tile * 64 + l) * 4 + h;
                DEN[o] = (dsum + cs * qn) * qs_l; EN[o] = en_l;
            }
        }
        if (ROLE == 0) mfma_chunk_os<128, 2>(Qb, Kb, Vb, STb, Pb, Sacc, orow, NPO, tile, cs, qscv, nullptr, w, lane, hv);
        __syncthreads();
        if (ROLE == 1 && tid < 128) NV[tid] = cs * NV[tid] + ((KS[tid] + KS[128 + tid]) + (KS[256 + tid] + KS[384 + tid]));
    }
#undef MLM_LOAD
}

__device__ __forceinline__ void mix_mlstm_num_db(const Params& p, ldsp_t lds, int item) {
    const int b = item >> 3, h = (item >> 1) & 3, hv = item & 1;
    constexpr int LD = 136, PLD = 72, TB = 64 * LD;
    LAS bf16_t* Qb = (LAS bf16_t*)lds; LAS bf16_t* Kb = Qb + 2 * TB; LAS bf16_t* Vb = Kb + 2 * TB; LAS bf16_t* STb = Vb + 2 * TB; LAS bf16_t* Pb = STb + 128 * LD;
    const int tid = threadIdx.x, lane = tid & 63, w = __builtin_amdgcn_readfirstlane(tid >> 6), fq = lane >> 4;
    const int sj = tid >> 3, sc = tid & 7;
    bf16_t* P = (bf16_t*)(p.ws + WS_R); const bf16_t* QKB = (const bf16_t*)(p.ws + WS_QKB);
    const bf16_t* qrow = QKB + ((size_t)b * 4096 + sj) * 1024 + h * 128 + sc * 8;
    const bf16_t* vrow = P + ((size_t)b * 4096 + sj) * NPO + 1536 + h * 128 + hv * 64 + sc * 8;
    const bf16_t* irow = P + ((size_t)b * 4096 + lane) * NPO + 2560 + h;
    bf16_t* orow = P + ((size_t)b * 4096) * NPO + 1536 + h * 128 + 16 * (hv * 4 + (w & 3)) + 4 * fq;
    const float bi = p.in[25][h], bfv = p.in[26][h];
    float m_prev = 0.f;
    f32x4 Sacc[4];
#pragma unroll
    for (int i = 0; i < 4; ++i) Sacc[i] = (f32x4){0.f, 0.f, 0.f, 0.f};
    u32x4 rq1, rq2, rk1, rk2, rv1; bf16_t ri, rf;
    float qs_n, cs_n;
#define MLN_LOAD(t0) do { const bf16_t* qp_ = qrow + (size_t)(t0) * 1024; rq1 = *(const u32x4*)qp_; rq2 = *(const u32x4*)(qp_ + 64); rk1 = *(const u32x4*)(qp_ + 512); rk2 = *(const u32x4*)(qp_ + 576); \
        rv1 = *(const u32x4*)(vrow + (size_t)(t0) * NPO); ri = irow[(size_t)(t0) * NPO]; rf = irow[(size_t)(t0) * NPO + 4]; } while (0)
#define MLN_STAGE(bi_) do { \
        const float fi = bf2f(ri) + bi, lf = logsigmoid_f(bf2f(rf) + bfv); \
        const float F = wave_scan_add(lf, lane); \
        const float g = fi - F; \
        const float pm = wave_scan_max(g, lane); \
        const float Mj = fmaxf(m_prev, pm); \
        const float mu = readlane_f(Mj, 63); \
        const float wv = __expf(g - mu); qs_n = __expf(mu - Mj); cs_n = __expf(m_prev - mu); \
        m_prev = readlane_f(F, 63) + mu; \
        const float wvs = __shfl(wv, sj); \
        LAS bf16_t* Qd = Qb + (bi_) * TB; LAS bf16_t* Kd = Kb + (bi_) * TB; LAS bf16_t* Vd = Vb + (bi_) * TB; \
        float a[8]; \
        *(LAS u32x4*)(Qd + sj * LD + sc * 8) = rq1; *(LAS u32x4*)(Qd + sj * LD + 64 + sc * 8) = rq2; \
        unpack8(rk1, a); _Pragma("unroll") for (int i = 0; i < 8; ++i) a[i] *= wvs; \
        *(LAS u32x4*)(Kd + sj * LD + sc * 8) = pack8(a); \
        unpack8(rk2, a); _Pragma("unroll") for (int i = 0; i < 8; ++i) a[i] *= wvs; \
        *(LAS u32x4*)(Kd + sj * LD + 64 + sc * 8) = pack8(a); \
        *(LAS u32x4*)(Vd + sj * LD + hv * 64 + sc * 8) = rv1; } while (0)
    MLN_LOAD(0);
    MLN_STAGE(0);
    float qscv = qs_n, cs = cs_n;
    __syncthreads();
    MLN_LOAD(64);
    for (int tile = 0; tile < 64; ++tile) {
        const int cur = tile & 1;
        mfma_chunk_p<128, 0>(Qb + cur * TB, Kb + cur * TB, Pb, nullptr, w, lane);
        __syncthreads();
        mfma_chunk_os<128, 2>(Qb + cur * TB, Kb + cur * TB, Vb + cur * TB, STb, Pb, Sacc, orow, NPO, tile, cs, qscv, nullptr, w, lane, hv);
        if (tile + 1 < 64) { MLN_STAGE(cur ^ 1); if (tile + 2 < 64) MLN_LOAD((tile + 2) * 64); }
        __syncthreads();
        qscv = qs_n; cs = cs_n;
    }
#undef MLN_LOAD
#undef MLN_STAGE
}

__device__ __forceinline__ void mix_mlstm_den(const Params& p, ldsp_t lds, int item) {
    const int b = item >> 2, h = item & 3;
    LAS float* PART = (LAS float*)lds;
    const int tid = threadIdx.x, lane = tid & 63, w = __builtin_amdgcn_readfirstlane(tid >> 6);
    const bf16_t* P = (const bf16_t*)(p.ws + WS_R); const bf16_t* QKB = (const bf16_t*)(p.ws + WS_QKB);
    float* DEN = (float*)(p.ws + WS_DEN); float* EN = (float*)(p.ws + WS_EN);
    const bf16_t* qrow = QKB + ((size_t)b * 4096 + lane) * 1024 + h * 128 + 16 * w;
    const bf16_t* irow = P + ((size_t)b * 4096 + lane) * NPO + 2560 + h;
    const float bi = p.in[25][h], bfv = p.in[26][h];
    float m_prev = 0.f;
    float nst[16];
#pragma unroll
    for (int i = 0; i < 16; ++i) nst[i] = 0.f;
    u32x4 rq1, rq2, rk1, rk2; bf16_t ri, rf;
#define MLD_LOAD(t0) do { const bf16_t* qp_ = qrow + (size_t)(t0) * 1024; rq1 = *(const u32x4*)qp_; rq2 = *(const u32x4*)(qp_ + 8); rk1 = *(const u32x4*)(qp_ + 512); rk2 = *(const u32x4*)(qp_ + 520); \
        ri = irow[(size_t)(t0) * NPO]; rf = irow[(size_t)(t0) * NPO + 4]; } while (0)
    MLD_LOAD(0);
    for (int tile = 0; tile < 64; ++tile) {
        const float fi = bf2f(ri) + bi, lf = logsigmoid_f(bf2f(rf) + bfv);
        const float F = wave_scan_add(lf, lane);
        const float g = fi - F;
        const float pm = wave_scan_max(g, lane);
        const float Mj = fmaxf(m_prev, pm);
        const float mu = readlane_f(Mj, 63);
        const float wv = __expf(g - mu), qscv = __expf(mu - Mj), env = __expf(-(F + Mj)), cs = __expf(m_prev - mu);
        m_prev = readlane_f(F, 63) + mu;
        float q[16], k[16];
        { float t8[8]; unpack8(rq1, t8);
#pragma unroll
          for (int i = 0; i < 8; ++i) q[i] = t8[i];
          unpack8(rq2, t8);
#pragma unroll
          for (int i = 0; i < 8; ++i) q[8 + i] = t8[i];
          unpack8(rk1, t8);
#pragma unroll
          for (int i = 0; i < 8; ++i) k[i] = t8[i];
          unpack8(rk2, t8);
#pragma unroll
          for (int i = 0; i < 8; ++i) k[8 + i] = t8[i]; }
        if (tile + 1 < 64) MLD_LOAD((tile + 1) * 64);
        float part = 0.f;
#pragma unroll
        for (int i = 0; i < 16; ++i) {
            const float c = wave_scan_add(k[i] * wv, lane);
            part = fmaf(q[i], fmaf(cs, nst[i], c), part);
            nst[i] = fmaf(cs, nst[i], readlane_f(c, 63));
        }
        PART[((tile & 1) * 8 + w) * 64 + lane] = part;
        __syncthreads();
        if (w == 0) {
            const LAS float* pp = PART + (tile & 1) * 512 + lane;
            const float d = ((pp[0] + pp[64]) + (pp[128] + pp[192])) + ((pp[256] + pp[320]) + (pp[384] + pp[448]));
            const size_t o = ((size_t)b * 4096 + tile * 64 + lane) * 4 + h;
            DEN[o] = d * qscv; EN[o] = env;
        }
    }
#undef MLD_LOAD
}

__device__ __forceinline__ void mix_gla_mfma(const Params& p, ldsp_t lds, int item) {
    const int b = item >> 3, h = (item >> 1) & 3, hv = item & 1;
    constexpr int LD = 72, PLD = 72;
    constexpr int TQ = 64 * LD, TV = 64 * 136;
    LAS bf16_t* Qb = (LAS bf16_t*)lds; LAS bf16_t* Kb = Qb + 2 * TQ; LAS bf16_t* Vb = Kb + 2 * TQ; LAS bf16_t* STb = Vb + 2 * TV; LAS bf16_t* Pb = STb + 128 * LD;
    LAS float* EBE = (LAS float*)(Pb + 64 * PLD);
    const int tid = threadIdx.x, lane = tid & 63, w = __builtin_amdgcn_readfirstlane(tid >> 6), fq = lane >> 4;
    const int sj = tid >> 3, sc = tid & 7;
    bf16_t* P = (bf16_t*)(p.ws + WS_R);
    float bl[8];
    { const f32x4 b0 = *(const f32x4*)(p.in[10] + h * 64 + 8 * w), b1 = *(const f32x4*)(p.in[10] + h * 64 + 8 * w + 4);
      bl[0] = b0[0]; bl[1] = b0[1]; bl[2] = b0[2]; bl[3] = b0[3]; bl[4] = b1[0]; bl[5] = b1[1]; bl[6] = b1[2]; bl[7] = b1[3]; }
    const bf16_t* trow = P + ((size_t)b * 4096 + lane) * NPE + h * 64 + 8 * w;
    const bf16_t* vrow = P + ((size_t)b * 4096 + sj) * NPE + 2560 + h * 128 + hv * 64 + sc * 8;
    bf16_t* orow = P + ((size_t)b * 4096) * NPE + 2560 + h * 128 + 16 * (hv * 4 + (w & 3)) + 4 * fq;
    f32x4 Sacc[2];
#pragma unroll
    for (int i = 0; i < 2; ++i) Sacc[i] = (f32x4){0.f, 0.f, 0.f, 0.f};
    u32x4 rq, rk, rz, rv1;
#define GLM_LOAD(t0) do { const bf16_t* tp_ = trow + (size_t)(t0) * NPE; rq = *(const u32x4*)(tp_ + 2048); rk = *(const u32x4*)(tp_ + 2304); rz = *(const u32x4*)(tp_ + 3584); \
        rv1 = *(const u32x4*)(vrow + (size_t)(t0) * NPE); } while (0)
#define GLM_STAGE(bi) do { float z[8], q[8], k[8]; \
            unpack8(rz, z); unpack8(rq, q); unpack8(rk, k); \
            _Pragma("unroll") for (int i = 0; i < 8; ++i) { \
                const float la = logsigmoid_fast(z[i] + bl[i]) * (1.0f / 16.0f); \
                const float bs = wave_scan_add(la, lane); \
                const float e = __expf(bs); \
                q[i] *= e; k[i] *= 0.125f * __expf(-bs); \
                if (lane == 63) EBE[(bi) * 64 + 8 * w + i] = e; } \
            *(LAS u32x4*)(Qb + (bi) * TQ + lane * LD + 8 * w) = pack8(q); \
            *(LAS u32x4*)(Kb + (bi) * TQ + lane * LD + 8 * w) = pack8(k); \
            *(LAS u32x4*)(Vb + (bi) * TV + sj * 136 + hv * 64 + sc * 8) = rv1; } while (0)
    GLM_LOAD(0);
    GLM_STAGE(0);
    __syncthreads();
    GLM_LOAD(64);
    for (int tile = 0; tile < 64; ++tile) {
        const int cur = tile & 1;
        mfma_chunk_p<64, 1>(Qb + cur * TQ, Kb + cur * TQ, Pb, nullptr, w, lane);
        __syncthreads();
        mfma_chunk_os<64, 1>(Qb + cur * TQ, Kb + cur * TQ, Vb + cur * TV, STb, Pb, Sacc, orow, NPE, tile, 1.0f, 1.0f, EBE + cur * 64, w, lane, hv);
        if (tile + 1 < 64) { GLM_STAGE(cur ^ 1); if (tile + 2 < 64) GLM_LOAD((tile + 2) * 64); }
        __syncthreads();
    }
#undef GLM_STAGE
#undef GLM_LOAD
}

__device__ __forceinline__ void mix_lru_fused(const Params& p, ldsp_t lds, int item) {
    const int b = item >> 4, g = (item >> 1) & 7, ch = item & 1;
    constexpr int LD = 72;
    LAS bf16_t* Wg = (LAS bf16_t*)lds; LAS bf16_t* XCb = Wg + 64 * LD;
    LAS float* LAs = (LAS float*)(XCb + 64 * LD); LAS float* Us = LAs + 2048; LAS float* AA = Us + 2048; LAS float* BB = AA + 512;
    const int tid = threadIdx.x, lane = tid & 63, w = __builtin_amdgcn_readfirstlane(tid >> 6), fr = lane & 15, fq = lane >> 4;
    const int j = tid & 31, seg = tid >> 5, c = g * 64 + ch * 32 + j;
    const int r_ = tid >> 3, cc = tid & 7, mt = w & 3, q2 = w >> 2;
    const bf16_t* P = (const bf16_t*)(p.ws + WS_R); bf16_t* OB = (bf16_t*)(p.ws + WS_OB);
#pragma unroll
    for (int k = 0; k < 8; ++k) { const int idx = tid + 512 * k, n = idx >> 6, i = idx & 63;
        const float v = (n < 32) ? p.in[16][g * 4096 + i * 64 + ch * 32 + n] : p.in[18][g * 4096 + i * 64 + ch * 32 + (n - 32)];
        Wg[n * LD + i] = f2bf(v); }
    float ba_[4], bx_[4], sp_[4], cw[4][8], cb[8];
#pragma unroll
    for (int r = 0; r < 4; ++r) { const int cch = g * 64 + ch * 32 + 16 * q2 + 4 * fq + r;
        ba_[r] = p.in[17][cch]; bx_[r] = p.in[19][cch]; sp_[r] = 8.0f * log1pf(__expf(-p.in[20][cch])); }
#pragma unroll
    for (int q = 0; q < 4; ++q) { const f32x4 a0 = *(const f32x4*)(p.in[14] + q * 512 + g * 64 + cc * 8), a1 = *(const f32x4*)(p.in[14] + q * 512 + g * 64 + cc * 8 + 4);
        cw[q][0] = a0[0]; cw[q][1] = a0[1]; cw[q][2] = a0[2]; cw[q][3] = a0[3]; cw[q][4] = a1[0]; cw[q][5] = a1[1]; cw[q][6] = a1[2]; cw[q][7] = a1[3]; }
    { const f32x4 a0 = *(const f32x4*)(p.in[15] + g * 64 + cc * 8), a1 = *(const f32x4*)(p.in[15] + g * 64 + cc * 8 + 4);
        cb[0] = a0[0]; cb[1] = a0[1]; cb[2] = a0[2]; cb[3] = a0[3]; cb[4] = a1[0]; cb[5] = a1[1]; cb[6] = a1[2]; cb[7] = a1[3]; }
    const bf16_t* lxp = P + ((size_t)b * 4096 + r_) * NPO + 512 + g * 64 + cc * 8;
    const bf16_t* lyp = P + ((size_t)b * 4096 + seg * 4) * NPO + c;
    bf16_t* obp = OB + ((size_t)b * 4096 + seg * 4) * 1024 + c;
    float hc = 0.f;
    u32x4 rx[4]; bf16_t ry[4];
#define LRF_LOAD(t0) do { _Pragma("unroll") for (int q = 0; q < 4; ++q) { rx[q] = (u32x4){0u, 0u, 0u, 0u}; if ((t0) + r_ - 3 + q >= 0) rx[q] = *(const u32x4*)(lxp + ((long)(t0) - 3 + q) * NPO); } \
        _Pragma("unroll") for (int q = 0; q < 4; ++q) ry[q] = lyp[(size_t)((t0) + q) * NPO]; } while (0)
    LRF_LOAD(0);
    for (int tile = 0; tile < 64; ++tile) {
        float lyv[4];
        {
            float acc[8];
#pragma unroll
            for (int e = 0; e < 8; ++e) acc[e] = cb[e];
#pragma unroll
            for (int q = 0; q < 4; ++q) { float x[8]; unpack8(rx[q], x);
#pragma unroll
                for (int e = 0; e < 8; ++e) acc[e] = fmaf(cw[q][e], x[e], acc[e]); }
            *(LAS u32x4*)(XCb + r_ * LD + cc * 8) = pack8(acc);
#pragma unroll
            for (int q = 0; q < 4; ++q) lyv[q] = bf2f(ry[q]);
        }
        __syncthreads();
        if (tile + 1 < 64) LRF_LOAD((tile + 1) * 64);
        {
            f32x4 accA = (f32x4){0.f, 0.f, 0.f, 0.f}, accX = (f32x4){0.f, 0.f, 0.f, 0.f};
#pragma unroll
            for (int kk = 0; kk < 2; ++kk) { const bf16x8 xf = row_frag(XCb, LD, mt, kk, fr, fq);
                accA = __builtin_amdgcn_mfma_f32_16x16x32_bf16(row_frag(Wg, LD, q2, kk, fr, fq), xf, accA, 0, 0, 0);
                accX = __builtin_amdgcn_mfma_f32_16x16x32_bf16(row_frag(Wg, LD, 2 + q2, kk, fr, fq), xf, accX, 0, 0, 0); }
            const int c0 = 16 * q2 + 4 * fq;
            const u32x2 xw = *(const LAS u32x2*)(XCb + (16 * mt + fr) * LD + ch * 32 + c0);
            const float xc4[4] = {bflo(xw.x), bfhi(xw.x), bflo(xw.y), bfhi(xw.y)};
            f32x4 lav, uv;
#pragma unroll
            for (int r = 0; r < 4; ++r) {
                const float rr = sigmoid_f(accA[r] + ba_[r]), ig = sigmoid_f(accX[r] + bx_[r]);
                const float la = -sp_[r] * rr;
                const float x2 = 2.0f * la;
                const float om = -x2 * fmaf(x2, fmaf(x2, fmaf(x2, fmaf(x2, fmaf(x2, 1.0f / 720.0f, 1.0f / 120.0f), 1.0f / 24.0f), 1.0f / 6.0f), 0.5f), 1.0f);
                lav[r] = la; uv[r] = __builtin_amdgcn_sqrtf(om) * (ig * xc4[r]);
            }
            *(LAS f32x4*)(LAs + (16 * mt + fr) * 32 + c0) = lav; *(LAS f32x4*)(Us + (16 * mt + fr) * 32 + c0) = uv;
        }
        __syncthreads();
        float ap[4], hl[4]; float A = 1.f, hloc = 0.f;
#pragma unroll
        for (int q = 0; q < 4; ++q) { const float a = __expf(LAs[(seg * 4 + q) * 32 + j]); hloc = fmaf(a, hloc, Us[(seg * 4 + q) * 32 + j]); A *= a; ap[q] = A; hl[q] = hloc; }
        AA[seg * 32 + j] = A; BB[seg * 32 + j] = hloc;
        __syncthreads();
        float hin = hc, run = hc;
#pragma unroll
        for (int s2 = 0; s2 < 16; ++s2) { run = fmaf(AA[s2 * 32 + j], run, BB[s2 * 32 + j]); if (s2 < seg) hin = run; }
        hc = run;
#pragma unroll
        for (int q = 0; q < 4; ++q) {
            const float hv = fmaf(ap[q], hin, hl[q]);
            const float y = lyv[q];
            const float u3 = 0.7978845608028654f * (y + 0.044715f * y * y * y);
            const float th = 1.0f - 2.0f * __builtin_amdgcn_rcpf(1.0f + __expf(2.0f * u3));
            obp[(size_t)(tile * 64 + q) * 1024] = f2bf(hv * 0.5f * y * (1.0f + th));
        }
    }
#undef LRF_LOAD
}

__device__ __forceinline__ void phase_qkproj(const Params& p, ldsp_t lds) {
    constexpr int LD = 136;
    LAS bf16_t* MCb = (LAS bf16_t*)lds;
    const bf16_t* MLQK = (const bf16_t*)(p.ws + WS_MLQK); const bf16_t* P = (const bf16_t*)(p.ws + WS_R); bf16_t* QKB = (bf16_t*)(p.ws + WS_QKB);
    const int tid = threadIdx.x, lane = tid & 63, w = __builtin_amdgcn_readfirstlane(tid >> 6), fr = lane & 15, fq = lane >> 4;
    const int tp = tid >> 4, c16 = tid & 15;
    int hcur = -1;
    bf16x8 wf[2][4];
    float cw[4][8], cb[8];
    u32x4 rx[5];
#define QKP_LOAD(job_) do { const int h_ = (job_) & 3, t_ = ((job_) >> 2) * 64 + 2 * tp; const int pos_ = t_ & 4095; \
        _Pragma("unroll") for (int q = 0; q < 5; ++q) { rx[q] = (u32x4){0u, 0u, 0u, 0u}; if (pos_ - 3 + q >= 0) rx[q] = *(const u32x4*)(P + (size_t)(t_ - 3 + q) * NPO + 1024 + h_ * 128 + c16 * 8); } } while (0)
    int job = blockIdx.x;
    if (job < 2048) QKP_LOAD(job);
    for (; job < 2048; job += gridDim.x) {
        const int h = job & 3, tk0 = (job >> 2) * 64;
        if (h != hcur) {
            hcur = h;
#pragma unroll
            for (int q2 = 0; q2 < 2; ++q2) { const int n = 2 * w + q2; const int gr = (n < 8) ? (h * 128 + 16 * n + fr) : (512 + h * 128 + 16 * (n - 8) + fr);
#pragma unroll
                for (int kk = 0; kk < 4; ++kk) wf[q2][kk] = *(const bf16x8*)(MLQK + (size_t)gr * 512 + h * 128 + 32 * kk + 8 * fq); }
#pragma unroll
            for (int q = 0; q < 4; ++q) { const f32x4 a0 = *(const f32x4*)(p.in[21] + q * 512 + h * 128 + c16 * 8), a1 = *(const f32x4*)(p.in[21] + q * 512 + h * 128 + c16 * 8 + 4);
                cw[q][0] = a0[0]; cw[q][1] = a0[1]; cw[q][2] = a0[2]; cw[q][3] = a0[3]; cw[q][4] = a1[0]; cw[q][5] = a1[1]; cw[q][6] = a1[2]; cw[q][7] = a1[3]; }
            { const f32x4 a0 = *(const f32x4*)(p.in[22] + h * 128 + c16 * 8), a1 = *(const f32x4*)(p.in[22] + h * 128 + c16 * 8 + 4);
                cb[0] = a0[0]; cb[1] = a0[1]; cb[2] = a0[2]; cb[3] = a0[3]; cb[4] = a1[0]; cb[5] = a1[1]; cb[6] = a1[2]; cb[7] = a1[3]; }
        }
        {
            float x[5][8];
#pragma unroll
            for (int q = 0; q < 5; ++q) unpack8(rx[q], x[q]);
#pragma unroll
            for (int tt = 0; tt < 2; ++tt) {
                float o[8];
#pragma unroll
                for (int e = 0; e < 8; ++e) o[e] = silu_f(cb[e] + cw[0][e] * x[tt][e] + cw[1][e] * x[tt + 1][e] + cw[2][e] * x[tt + 2][e] + cw[3][e] * x[tt + 3][e]);
                *(LAS u32x4*)(MCb + (2 * tp + tt) * LD + c16 * 8) = pack8(o);
            }
        }
        __syncthreads();
        if (job + (int)gridDim.x < 2048) QKP_LOAD(job + (int)gridDim.x);
#pragma unroll
        for (int m = 0; m < 4; ++m) {
            bf16x8 af[4];
#pragma unroll
            for (int kk = 0; kk < 4; ++kk) af[kk] = row_frag(MCb, LD, m, kk, fr, fq);
#pragma unroll
            for (int q2 = 0; q2 < 2; ++q2) {
                f32x4 acc = (f32x4){0.f, 0.f, 0.f, 0.f};
#pragma unroll
                for (int kk = 0; kk < 4; ++kk) acc = __builtin_amdgcn_mfma_f32_16x16x32_bf16(wf[q2][kk], af[kk], acc, 0, 0, 0);
                const int n = 2 * w + q2;
                const int dstcol = (n < 8) ? (h * 128 + 16 * n + 4 * fq) : (512 + h * 128 + 16 * (n - 8) + 4 * fq);
                u32x2 pk; pk.x = pg8::cvt_pk_bf16(acc[0], acc[1]); pk.y = pg8::cvt_pk_bf16(acc[2], acc[3]);
                *(u32x2*)(QKB + (size_t)(tk0 + 16 * m + fr) * 1024 + dstcol) = pk;
            }
        }
        __syncthreads();
    }
#undef QKP_LOAD
}

__device__ __forceinline__ void phase_fin_even(const Params& p) {
    const bf16_t* P = (const bf16_t*)(p.ws + WS_R); bf16_t* OB = (bf16_t*)(p.ws + WS_OB); const float* hw = p.in[11];
    const int tid = threadIdx.x, lane = tid & 63, w = tid >> 6, hh = lane >> 4, l16 = lane & 15;
    for (int idx = blockIdx.x * 8 + w; idx < 2 * M; idx += gridDim.x * 8) {
        const int t = idx >> 1, grp = idx & 1;
        const bf16_t* row = P + (size_t)t * NPE;
        const int ocol = (grp ? 2560 : 1024) + hh * 128 + l16 * 8, gcol = (grp ? 3072 : 1536) + hh * 128 + l16 * 8;
        float o[8], g[8];
        unpack8(*(const u32x4*)(row + ocol), o); unpack8(*(const u32x4*)(row + gcol), g);
        float ss = 0.f;
#pragma unroll
        for (int i = 0; i < 8; ++i) ss = fmaf(o[i], o[i], ss);
        ss = reduce16(ss);
        const float rs = rsqrtf(ss * (1.0f / 128.0f) + EPS);
        const int oc = grp * 512 + hh * 128 + l16 * 8;
        const f32x4 w0 = *(const f32x4*)(hw + oc), w1 = *(const f32x4*)(hw + oc + 4);
        float y[8];
#pragma unroll
        for (int i = 0; i < 8; ++i) y[i] = o[i] * rs * silu_f(g[i]) * (i < 4 ? w0[i & 3] : w1[i & 3]);
        *(u32x4*)(OB + (size_t)t * 1024 + oc) = pack8(y);
    }
}
__device__ __forceinline__ void phase_fin_odd(const Params& p) {
    const bf16_t* P = (const bf16_t*)(p.ws + WS_R); bf16_t* OB = (bf16_t*)(p.ws + WS_OB); const float* nw = p.in[27];
    const float* DEN = (const float*)(p.ws + WS_DEN); const float* EN = (const float*)(p.ws + WS_EN);
    const int tid = threadIdx.x, lane = tid & 63, w = tid >> 6, hh = lane >> 4, l16 = lane & 15;
    for (int t = blockIdx.x * 8 + w; t < M; t += gridDim.x * 8) {
        const bf16_t* row = P + (size_t)t * NPO;
        float nu[8], g[8];
        unpack8(*(const u32x4*)(row + 1536 + hh * 128 + l16 * 8), nu); unpack8(*(const u32x4*)(row + 2048 + hh * 128 + l16 * 8), g);
        const float den = DEN[(size_t)t * 4 + hh], en = EN[(size_t)t * 4 + hh];
        const float inv = __builtin_amdgcn_rcpf(fmaxf(fabsf(den), en));
        float hm[8]; float ss = 0.f;
#pragma unroll
        for (int i = 0; i < 8; ++i) { hm[i] = sigmoid_f(g[i]) * nu[i] * inv; ss = fmaf(hm[i], hm[i], ss); }
        ss = reduce16(ss);
        const float rs = rsqrtf(ss * (1.0f / 128.0f) + EPS);
        const int oc = hh * 128 + l16 * 8;
        const f32x4 w0 = *(const f32x4*)(nw + oc), w1 = *(const f32x4*)(nw + oc + 4);
        float y[8];
#pragma unroll
        for (int i = 0; i < 8; ++i) { y[i] = hm[i] * rs * (i < 4 ? w0[i & 3] : w1[i & 3]); }
        *(u32x4*)(OB + (size_t)t * 1024 + 512 + oc) = pack8(y);
    }
}
__device__ __forceinline__ void phase_final(const Params& p) {
    float* out = p.out; const bf16_t* XB = (const bf16_t*)(p.ws + WS_XB); const float* SS = (const float*)(p.ws + WS_SS) + (size_t)6 * 16 * M; const float* fw = p.in[29];
    const int tid = threadIdx.x, lane = tid & 63, w = tid >> 6;
    for (int row = blockIdx.x * 8 + w; row < M; row += gridDim.x * 8) {
        const float rs = row_rs(SS, row);
#pragma unroll
        for (int i = 0; i < 2; ++i) {
            float h[8]; unpack8(*(const u32x4*)(XB + (size_t)row * 1024 + (lane + 64 * i) * 8), h);
            const f32x4 w0 = *(const f32x4*)(fw + (lane + 64 * i) * 8), w1 = *(const f32x4*)(fw + (lane + 64 * i) * 8 + 4);
            f32x4 o0, o1;
            o0[0] = h[0] * rs * w0[0]; o0[1] = h[1] * rs * w0[1]; o0[2] = h[2] * rs * w0[2]; o0[3] = h[3] * rs * w0[3];
            o1[0] = h[4] * rs * w1[0]; o1[1] = h[5] * rs * w1[1]; o1[2] = h[6] * rs * w1[2]; o1[3] = h[7] * rs * w1[3];
            *(f32x4*)(out + (size_t)row * 1024 + (lane + 64 * i) * 8) = o0; *(f32x4*)(out + (size_t)row * 1024 + (lane + 64 * i) * 8 + 4) = o1;
        }
    }
}

__host__ __device__ inline bool phase_active(int ph) { return !(ph == 4 || ph == 5 || ph == 15); }
constexpr int N_PHASES = 22;
__device__ __forceinline__ void load_params(Params& q, ldsp_t lds) {
    const LAS unsigned* tab = (const LAS unsigned*)(lds + LDS_CTRL);
#pragma unroll
    for (int k = 0; k < 32; ++k) {
        const unsigned lo = __builtin_amdgcn_readfirstlane(tab[2 * k]), hi = __builtin_amdgcn_readfirstlane(tab[2 * k + 1]);
        const unsigned long long v = ((unsigned long long)hi << 32) | lo;
        if (k < 30) q.in[k] = (const float*)(const __attribute__((address_space(1))) float*)v; else if (k == 30) q.out = (float*)(__attribute__((address_space(1))) float*)v; else q.ws = (unsigned char*)(__attribute__((address_space(1))) unsigned char*)v;
    }
}
#define PHASE_BEGIN(k) if (lo <= (k) && (k) < hi) { asm volatile("" ::: "memory"); Params p; load_params(p, lds); unsigned char* ws = p.ws; (void)ws;
#define PHASE_END(k) if ((k) + 1 < hi) { xcd_barrier(xb); } }
template <int L> __device__ __forceinline__ void layer_phases(ldsp_t lds, cg::grid_group& grid, XcdBarrier& xb, const int lo, const int hi) {
    constexpr int B0 = 1 + 10 * L;
    PHASE_BEGIN(B0 + 0)
        { EpiSwiGLU E{(bf16_t*)(ws + WS_R), (const float*)(ws + WS_SS) + (size_t)(3 * L + 0) * 16 * M, (LAS float*)(lds + LDS_CTRL + 512), -1};
        run_gemm<EpiSwiGLU>(lds, (const bf16_t*)(ws + WS_XB), (const bf16_t*)(ws + WS_WGU + (size_t)(L * 2 + 0) * SZ_WGU), 5632, 1024, E); }
    PHASE_END(B0 + 0)
    PHASE_BEGIN(B0 + 1)
        { EpiResid E{(bf16_t*)(ws + WS_XB), (float*)(ws + WS_SS) + (size_t)(3 * L + 1) * 16 * M, 0.5f};
        run_gemm<EpiResid>(lds, (const bf16_t*)(ws + WS_R), (const bf16_t*)(ws + WS_WD + (size_t)(L * 2 + 0) * SZ_WD), 1024, 2816, E); }
    PHASE_END(B0 + 1)
    PHASE_BEGIN(B0 + 2)
        { EpiProj E{(bf16_t*)(ws + WS_R), L ? NPO : NPE, (const float*)(ws + WS_SS) + (size_t)(3 * L + 1) * 16 * M, (LAS float*)(lds + LDS_CTRL + 512), -1};
        run_gemm<EpiProj>(lds, (const bf16_t*)(ws + WS_XB), (const bf16_t*)(ws + (L ? WS_OWIN : WS_EWIN)), L ? NPO : NPE, 1024, E); }
    PHASE_END(B0 + 2)
    if (L == 1) {
        PHASE_BEGIN(B0 + 3)
            phase_qkproj(p, lds);
        PHASE_END(B0 + 3)
    }
    PHASE_BEGIN(B0 + 5)
        if (L == 0) {
            for (int it = blockIdx.x; it < 128; it += gridDim.x) { if (it < 64) mix_retention_mfma(p, lds, it); else mix_gla_mfma(p, lds, it - 64); __syncthreads(); }
        } else {
            for (int it = blockIdx.x; it < 224; it += gridDim.x) { if (it < 64) mix_mlstm_num_db(p, lds, it); else if (it < 96) mix_mlstm_den(p, lds, it - 64); else mix_lru_fused(p, lds, it - 96); __syncthreads(); }
        }
    PHASE_END(B0 + 5)
    PHASE_BEGIN(B0 + 6)
        { if (L == 0) phase_fin_even(p); else phase_fin_odd(p); }
    PHASE_END(B0 + 6)
    PHASE_BEGIN(B0 + 7)
        { EpiResid E{(bf16_t*)(ws + WS_XB), (float*)(ws + WS_SS) + (size_t)(3 * L + 2) * 16 * M, 1.0f};
        run_gemm<EpiResid>(lds, (const bf16_t*)(ws + WS_OB), (const bf16_t*)(ws + (L ? WS_OWOUT : WS_EWOUT)), 1024, 1024, E); }
    PHASE_END(B0 + 7)
    PHASE_BEGIN(B0 + 8)
        { EpiSwiGLU E{(bf16_t*)(ws + WS_R), (const float*)(ws + WS_SS) + (size_t)(3 * L + 2) * 16 * M, (LAS float*)(lds + LDS_CTRL + 512), -1};
        run_gemm<EpiSwiGLU>(lds, (const bf16_t*)(ws + WS_XB), (const bf16_t*)(ws + WS_WGU + (size_t)(L * 2 + 1) * SZ_WGU), 5632, 1024, E); }
    PHASE_END(B0 + 8)
    PHASE_BEGIN(B0 + 9)
        { EpiResid E{(bf16_t*)(ws + WS_XB), (float*)(ws + WS_SS) + (size_t)(3 * L + 3) * 16 * M, 0.5f};
        run_gemm<EpiResid>(lds, (const bf16_t*)(ws + WS_R), (const bf16_t*)(ws + WS_WD + (size_t)(L * 2 + 1) * SZ_WD), 1024, 2816, E); }
    PHASE_END(B0 + 9)
}
__global__ void __launch_bounds__(512, 2) mega(Params p0) {
    extern __shared__ __attribute__((aligned(16))) unsigned char ldsraw[];
    ldsp_t lds = (ldsp_t)ldsraw;
    cg::grid_group grid = cg::this_grid();
    if (threadIdx.x == 0) {
        LAS unsigned long long* tab = (LAS unsigned long long*)(lds + LDS_CTRL);
#pragma unroll
        for (int k = 0; k < 30; ++k) tab[k] = (unsigned long long)p0.in[k];
        tab[30] = (unsigned long long)p0.out; tab[31] = (unsigned long long)p0.ws;
        LAS unsigned* st = (LAS unsigned*)(lds + LDS_CTRL + 256); st[0] = 0u; st[1] = 0u; st[2] = 0u; st[3] = 0u;
    }
    __syncthreads();
    const int lo = p0.ph_lo, hi = p0.ph_hi;
    if (hi > 1000) grid.sync();
    XcdBarrier xb; xb.bar = nullptr; xb.x = 0u; xb.st = nullptr;
    if (hi - lo > 1) xb = xcd_barrier_post((unsigned*)(p0.ws + WS_BAR), (volatile LAS unsigned*)(lds + LDS_CTRL + 256));
    PHASE_BEGIN(0)
        phase_prep(p, lds);
    PHASE_END(0)
    layer_phases<0>(lds, grid, xb, lo, hi);
    layer_phases<1>(lds, grid, xb, lo, hi);
    PHASE_BEGIN(21)
        phase_final(p);
    PHASE_END(21)
}

extern "C" void kernel_launch(void* const* d_in, const int* in_sizes, int n_in, void* d_out, int out_size, void* d_ws, size_t ws_size, hipStream_t stream) {
    static int grid = 0;
    if (grid == 0) {
        if (n_in != 30 || out_size != M * 1024 || ws_size < WS_END) { fprintf(stderr, "kernel_launch: unexpected problem (n_in %d out %d ws %zu need %zu)\n", n_in, out_size, ws_size, (size_t)WS_END); grid = -1; return; }
        int dev = 0, cus = 0, per_cu = 0;
        hipGetDevice(&dev); hipDeviceGetAttribute(&cus, hipDeviceAttributeMultiprocessorCount, dev);
        if (hipFuncSetAttribute((const void*)mega, hipFuncAttributeMaxDynamicSharedMemorySize, LDS_BYTES) != hipSuccess) { fprintf(stderr, "kernel_launch: hipFuncSetAttribute failed\n"); }
        if (hipOccupancyMaxActiveBlocksPerMultiprocessor(&per_cu, (const void*)mega, 512, LDS_BYTES) != hipSuccess || per_cu < 1) { fprintf(stderr, "kernel_launch: occupancy query says %d\n", per_cu); per_cu = 1; }
        (void)hipGetLastError();
        grid = cus * per_cu; if (grid > 256) grid = 256; if (grid < 1) grid = 256;
    }
    if (grid < 0) return;
    Params p{};
    for (int i = 0; i < 30; ++i) p.in[i] = (const float*)d_in[i];
    p.out = (float*)d_out; p.ws = (unsigned char*)d_ws;
#if MK_N_LAUNCHES == 1
    p.ph_lo = 0; p.ph_hi = N_PHASES;
    if (hipMemsetAsync((unsigned char*)d_ws + WS_BAR, 0, 16384, stream) != hipSuccess) { fprintf(stderr, "kernel_launch: hipMemsetAsync of the barrier words failed\n"); return; }
    void* args[] = {&p};
    hipError_t e = hipLaunchCooperativeKernel((const void*)mega, dim3(grid), dim3(512), args, LDS_BYTES, stream);
    if (e != hipSuccess) fprintf(stderr, "kernel_launch: cooperative launch failed: %s (grid %d)\n", hipGetErrorString(e), grid);
#else
    for (int ph = 0; ph < N_PHASES; ++ph) {
        if (!phase_active(ph)) continue;
        p.ph_lo = ph; p.ph_hi = ph + 1;
        hipLaunchKernelGGL(mega, dim3(grid), dim3(512), LDS_BYTES, stream, p);
    }
#endif
}
```

```cpp
#include <hip/hip_runtime.h>
#include <hip/hip_cooperative_groups.h>
#include <cstdio>
namespace cg = cooperative_groups;
#ifndef MK_N_LAUNCHES
#define MK_N_LAUNCHES 1
#endif
namespace pg8 {
#define PG8_LAS __attribute__((address_space(3)))
typedef unsigned short bf16_t;
typedef short bf16x8 __attribute__((ext_vector_type(8)));
typedef float f32x4 __attribute__((ext_vector_type(4)));
typedef unsigned u32x4 __attribute__((ext_vector_type(4)));
constexpr int BM = 256, BK = 64, HALF = 128, HTB = HALF * BK * 2  , STAGE_BYTES = 8 * HTB, NXCD = 8, WGM = 8;

__host__ __device__ __forceinline__ int lds_byte(int r, int c) { const int st = (r >> 4) * 2 + (c >> 5), rr = r & 15, cc = c & 31, ob = rr * 64 + cc * 2; return st * 1024 + (ob ^ (((ob >> 9) & 1) << 5)); }
__host__ __device__ __forceinline__ void stage_rc(int b, int& R, int& C) { const int st = b / 1024, sb = b % 1024, swz = sb ^ (((sb >> 9) & 1) << 5); R = (st >> 1) * 16 + swz / 64; C = (st & 1) * 32 + (swz % 64) / 2; }
__host__ __device__ __forceinline__ int perm32(int rho) { const int n = rho >> 4, i = rho & 15; return 8 * (i >> 2) + 4 * n + (i & 3); }

struct Unit { int pm, pn; };
struct Gemm { const bf16_t* A; const bf16_t* Bt; int M, N, K; };

struct StaticOrder {
    int nM, nN, nwg, G, c;
    __host__ __device__ void init(int M, int N, int G_, int c_) { nM = M / BM; nN = N / BM; nwg = nM * nN; G = G_; c = c_; }
    __host__ __device__ bool next(int i, Unit& u) const {
        const long L = (long)i * G + c; if (L >= nwg) return false;
        int wgid = (int)L; { const int q = nwg / NXCD, r = nwg % NXCD, xcd = wgid % NXCD, off = wgid / NXCD; wgid = (xcd < r ? xcd * (q + 1) : r * (q + 1) + (xcd - r) * q) + off; }
        const int nig = WGM * nN, gid = wgid / nig, fm = gid * WGM, gsz = (nM - fm) < WGM ? (nM - fm) : WGM;
        u.pm = fm + ((wgid % nig) % gsz); u.pn = (wgid % nig) / gsz; return true;
    }
    __device__ __forceinline__ void a_ready(const Unit&) const {}
    __device__ __forceinline__ void done(const Unit&) const {}
};
typedef __bf16 bf16x2_native __attribute__((ext_vector_type(2)));
__device__ __forceinline__ unsigned cvt_pk_bf16(float lo, float hi) { const bf16x2_native v = {(__bf16)lo, (__bf16)hi}; return __builtin_bit_cast(unsigned, v); }
typedef float f32x2 __attribute__((ext_vector_type(2)));
template <class Epi, class Sched, bool STAMP = false>
__device__ __forceinline__ void gemm_phase(PG8_LAS unsigned char* lds, const Gemm g, const Sched& S, const Epi& E, unsigned long long* stamps) {
    const int tid = threadIdx.x, wid = __builtin_amdgcn_readfirstlane(tid >> 6), lane = tid & 63, wr = wid >> 2, wc = wid & 3, fr = lane & 15, fq = lane >> 4;
    const int K = g.K, nt = K / BK;
    int ts_lo = 0, ts_hi = 0, nts = 0; const unsigned long long rt_entry = STAMP ? (unsigned long long)wall_clock64() : 0ull;
#define PG8_STAMP() do { if (STAMP && wid == 0 && nts < 64) { const unsigned long long _c = (unsigned long long)clock64(); \
        ts_lo = (lane == nts) ? (int)(unsigned)_c : ts_lo; ts_hi = (lane == nts) ? (int)(unsigned)(_c >> 32) : ts_hi; ++nts; } } while (0)
    PG8_STAMP();
    unsigned voffA[2], voffB[2];
#pragma unroll
    for (int i = 0; i < 2; ++i) { int R, C; stage_rc(tid * 16 + i * 8192, R, C); const int Rb = Epi::PERM ? ((R & ~31) + perm32(R & 31)) : R;
        voffA[i] = (unsigned)(R * K + C) * 2u; voffB[i] = (unsigned)(Rb * K + C) * 2u; }
    const size_t kstep = (size_t)(BK * 2);
    const size_t hstep = (size_t)HALF * K * 2;
    const size_t tstep = 2 * hstep;
    const unsigned ldsw = (unsigned)wid * 1024u;
    const int aoff = lds_byte(wr * 64 + fr, fq * 8), boff = lds_byte(wc * 32 + fr, fq * 8);
#define PG8_SA(b, h) (((b) * 2 + (h)) * HTB)
#define PG8_SB(b, h) ((4 + (b) * 2 + (h)) * HTB)
#define PG8_STAGE(bufoff, gbase, voff) do { _Pragma("unroll") for (int _i = 0; _i < 2; ++_i) \
        __builtin_amdgcn_global_load_lds((const unsigned*)((const char*)(gbase) + (voff)[_i]), (PG8_LAS unsigned*)(lds + (bufoff) + ldsw + _i * 8192), 16, 0, 0); } while (0)
#define PG8_LDA(dst, b, h) do { _Pragma("unroll") for (int m = 0; m < 4; ++m) _Pragma("unroll") for (int k = 0; k < 2; ++k) dst[m][k] = *(const PG8_LAS bf16x8*)(lds + PG8_SA(b, h) + aoff + m * 2048 + k * 1024); } while (0)
#define PG8_LDB(dst, b, h) do { _Pragma("unroll") for (int n = 0; n < 2; ++n) _Pragma("unroll") for (int k = 0; k < 2; ++k) dst[n][k] = *(const PG8_LAS bf16x8*)(lds + PG8_SB(b, h) + boff + n * 2048 + k * 1024); } while (0)
#define PG8_MMA(ai, bj, At, Bt) do { __builtin_amdgcn_s_setprio(1); _Pragma("unroll") for (int m = 0; m < 4; ++m) _Pragma("unroll") for (int n = 0; n < 2; ++n) _Pragma("unroll") for (int k = 0; k < 2; ++k) \
        acc[ai][bj][m][n] = __builtin_amdgcn_mfma_f32_16x16x32_bf16(Bt[n][k], At[m][k], acc[ai][bj][m][n], 0, 0, 0); __builtin_amdgcn_s_setprio(0); } while (0)
#define PG8_WAIT_V(n) asm volatile("s_waitcnt vmcnt(" #n ")" ::: "memory")
#define PG8_WAIT_L(n) asm volatile("s_waitcnt lgkmcnt(" #n ")" ::: "memory")
#define PG8_BAR __builtin_amdgcn_s_barrier()
#define PG8_SCHED __builtin_amdgcn_sched_barrier(0)
    Unit cur, nxt; int ui = 0;
    if (!S.next(0, cur)) return;
    f32x4 acc[2][2][4][2];
#pragma unroll
    for (int a = 0; a < 2; ++a)
#pragma unroll
        for (int b = 0; b < 2; ++b)
#pragma unroll
            for (int m = 0; m < 4; ++m)
#pragma unroll
                for (int n = 0; n < 2; ++n) acc[a][b][m][n] = (f32x4){0.f, 0.f, 0.f, 0.f};
    bf16x8 At[4][2], B0[2][2], B1[2][2];
    const char* cA = (const char*)g.A + (size_t)cur.pm * tstep; const char* cB = (const char*)g.Bt + (size_t)cur.pn * tstep;
    S.a_ready(cur);
    PG8_STAGE(PG8_SB(0, 0), cB, voffB); PG8_STAGE(PG8_SA(0, 0), cA, voffA); PG8_STAGE(PG8_SB(0, 1), cB + hstep, voffB); PG8_STAGE(PG8_SA(0, 1), cA + hstep, voffA);
    if (wr == 1) PG8_BAR;
    PG8_WAIT_V(4); PG8_BAR;
    PG8_STAGE(PG8_SB(1, 0), cB + kstep, voffB); PG8_STAGE(PG8_SA(1, 0), cA + kstep, voffA); PG8_STAGE(PG8_SB(1, 1), cB + hstep + kstep, voffB);
    PG8_WAIT_V(6); PG8_BAR;
    PG8_STAMP();
    for (;;) {
        const bool has_next = S.next(ui + 1, nxt);
        const char* nA = has_next ? (const char*)g.A + (size_t)nxt.pm * tstep : cA; const char* nB = has_next ? (const char*)g.Bt + (size_t)nxt.pn * tstep : cB;
        for (int t = 0; t < nt; t += 2) {
            const bool last = (t == nt - 2);
            const char* a1 = cA + (size_t)(t + 1) * kstep;
            const char* a2 = last ? nA : cA + (size_t)(t + 2) * kstep; const char* b2 = last ? nB : cB + (size_t)(t + 2) * kstep;
            const char* a3 = a2 + kstep; const char* b3 = b2 + kstep;
            if (last && has_next) S.a_ready(nxt);
            PG8_LDB(B0, 0, 0); PG8_SCHED; PG8_LDA(At, 0, 0); PG8_STAGE(PG8_SA(1, 1), a1 + hstep, voffA);
            PG8_WAIT_L(8); PG8_BAR; PG8_WAIT_L(0); PG8_MMA(0, 0, At, B0); PG8_BAR; PG8_SCHED;
            PG8_LDB(B1, 0, 1); PG8_STAGE(PG8_SB(0, 0), b2, voffB);
            PG8_BAR; PG8_WAIT_L(0); PG8_MMA(0, 1, At, B1); PG8_BAR;
            PG8_LDA(At, 0, 1); PG8_STAGE(PG8_SA(0, 0), a2, voffA);
            PG8_BAR; PG8_WAIT_L(0); PG8_MMA(1, 0, At, B0); PG8_BAR; PG8_SCHED;
            PG8_STAGE(PG8_SB(0, 1), b2 + hstep, voffB);
            PG8_WAIT_V(6); PG8_BAR; PG8_MMA(1, 1, At, B1); PG8_BAR;
            PG8_LDB(B0, 1, 0); PG8_SCHED; PG8_LDA(At, 1, 0); PG8_STAGE(PG8_SA(0, 1), a2 + hstep, voffA);
            PG8_WAIT_L(8); PG8_BAR; PG8_WAIT_L(0); PG8_MMA(0, 0, At, B0); PG8_BAR; PG8_SCHED;
            PG8_LDB(B1, 1, 1); PG8_STAGE(PG8_SB(1, 0), b3, voffB);
            PG8_BAR; PG8_WAIT_L(0); PG8_MMA(0, 1, At, B1); PG8_BAR;
            PG8_LDA(At, 1, 1); PG8_STAGE(PG8_SA(1, 0), a3, voffA);
            PG8_BAR; PG8_WAIT_L(0); PG8_MMA(1, 0, At, B0); PG8_BAR; PG8_SCHED;
            PG8_STAGE(PG8_SB(1, 1), b3 + hstep, voffB);
            PG8_WAIT_V(6); PG8_BAR; PG8_MMA(1, 1, At, B1); PG8_BAR;
        }
        PG8_STAMP();
        if constexpr (!Epi::AFTER_DRAIN) { E(acc, cur, wr, wc, fr, fq); S.done(cur); }
        PG8_STAMP();
        if (!has_next) break;
#pragma unroll
        for (int a = 0; a < 2; ++a)
#pragma unroll
            for (int b = 0; b < 2; ++b)
#pragma unroll
                for (int m = 0; m < 4; ++m)
#pragma unroll
                    for (int n = 0; n < 2; ++n) acc[a][b][m][n] = (f32x4){0.f, 0.f, 0.f, 0.f};
        cur = nxt; cA = nA; cB = nB; ++ui;
    }
    PG8_WAIT_V(0);
    if (wr == 0) PG8_BAR;
    PG8_BAR;
    if constexpr (Epi::AFTER_DRAIN) { E.fused(acc, cur, wr, wc, fr, fq, lds, wid, lane); S.done(cur); }
    PG8_STAMP();
    if (STAMP && wid == 0) { stamps[lane] = lane < nts ? (((unsigned long long)(unsigned)ts_hi << 32) | (unsigned)ts_lo) : 0ull;
        if (lane == 62) stamps[62] = rt_entry; if (lane == 63) stamps[63] = (unsigned long long)wall_clock64(); }
#undef PG8_STAMP
#undef PG8_SA
#undef PG8_SB
#undef PG8_STAGE
#undef PG8_LDA
#undef PG8_LDB
#undef PG8_MMA
#undef PG8_WAIT_V
#undef PG8_WAIT_L
#undef PG8_BAR
#undef PG8_SCHED
}
}
#ifndef LAS
#define LAS __attribute__((address_space(3)))
#endif
#define XB_TMO      128
#define XB_XCNT(j)  (256  + 64 * (j))
#define XB_XSUB(j)  (1280 + 64 * (j))
#define XB_XGEN(j)  (2304 + 64 * (j))
#define XB_TOP      3328
#define XB_TOPGEN   3392
#define XCD_BAR_WORDS 3456
#define XB_SPIN_CAP (1u << 18)

__device__ __forceinline__ unsigned xb_ld(unsigned* p)              { return __hip_atomic_load(p, __ATOMIC_RELAXED, __HIP_MEMORY_SCOPE_AGENT); }
__device__ __forceinline__ unsigned xb_add(unsigned* p, unsigned v) { return __hip_atomic_fetch_add(p, v, __ATOMIC_RELAXED, __HIP_MEMORY_SCOPE_AGENT); }
__device__ __forceinline__ unsigned xb_xcc_id() { return (unsigned)__builtin_amdgcn_s_getreg((3 << 11) | 20) & 0xFu; }
#define XB_SPIN(cond, bar) do { unsigned _sp = 0; while (cond) { __builtin_amdgcn_s_sleep(1); \
    if ((++_sp & 255u) == 0u) { if (xb_ld(&(bar)[XB_TMO])) break; if (_sp > XB_SPIN_CAP) { atomicAdd(&(bar)[XB_TMO], 1u); break; } } } } while (0)

struct XcdBarrier {
    unsigned* bar; unsigned x;
    volatile LAS unsigned* st;
};

__device__ __forceinline__ XcdBarrier xcd_barrier_post(unsigned* bar, volatile LAS unsigned* st) {
    XcdBarrier b; b.bar = bar; b.x = xb_xcc_id(); b.st = st;
    if (threadIdx.x == 0) (void)xb_add(&bar[XB_XCNT(b.x)], 1u);
    return b;
}
__device__ __forceinline__ void xcd_barrier_complete(unsigned* bar, unsigned x, unsigned& nloc, unsigned& nx) {
    const unsigned G = gridDim.x * gridDim.y * gridDim.z;
    unsigned sum, cnt, mine, sp = 0u;
    for (;;) {
        sum = 0u; cnt = 0u; mine = 0u;
#pragma unroll
        for (unsigned j = 0; j < 16; ++j) { const unsigned c = xb_ld(&bar[XB_XCNT(j)]); sum += c; cnt += (c > 0u) ? 1u : 0u; mine = (j == x) ? c : mine; }
        if (sum == G) break;
        __builtin_amdgcn_s_sleep(1);
        if ((++sp & 255u) == 0u) { if (xb_ld(&bar[XB_TMO])) break; if (sp > XB_SPIN_CAP) { atomicAdd(&bar[XB_TMO], 1u); break; } }
    }
    nloc = mine > 0u ? mine : 1u; nx = cnt > 0u ? cnt : 1u;
}

__device__ __forceinline__ void xcd_barrier(const XcdBarrier& b) {
    asm volatile("s_waitcnt vmcnt(0)" ::: "memory");
    __syncthreads();
    if (threadIdx.x == 0) {
        unsigned* bar = b.bar;
        __builtin_amdgcn_s_waitcnt(0);
        unsigned nloc = b.st[0], nx = b.st[1];
        if (nloc == 0u) { xcd_barrier_complete(bar, b.x, nloc, nx); b.st[0] = nloc; b.st[1] = nx; }
        const unsigned old = xb_add(&bar[XB_XSUB(b.x)], 1u);
        const unsigned gen = old / nloc;
        if (old + 1u == (gen + 1u) * nloc) {
            __builtin_amdgcn_fence(__ATOMIC_RELEASE, "agent");
            asm volatile("s_waitcnt vmcnt(0)" ::: "memory");
            const unsigned og = xb_add(&bar[XB_TOP], 1u);
            const unsigned tg = og / nx;
            if (og + 1u == (tg + 1u) * nx) xb_add(&bar[XB_TOPGEN], 1u);
            else XB_SPIN(xb_ld(&bar[XB_TOPGEN]) == tg, bar);
            __builtin_amdgcn_fence(__ATOMIC_ACQUIRE, "agent");
            xb_add(&bar[XB_XGEN(b.x)], 1u);
            asm volatile("s_waitcnt vmcnt(0)" ::: "memory");
        } else {
            XB_SPIN(xb_ld(&bar[XB_XGEN(b.x)]) == gen, bar);
            __builtin_amdgcn_fence(__ATOMIC_ACQUIRE, "agent");
            asm volatile("s_waitcnt vmcnt(0)" ::: "memory");
        }
    }
    __syncthreads();
}


using pg8::bf16_t; using pg8::bf16x8; using pg8::f32x4; using pg8::u32x4;
typedef unsigned u32x2 __attribute__((ext_vector_type(2)));
#define LAS __attribute__((address_space(3)))
typedef LAS unsigned char* ldsp_t;

constexpr int M = 32768, NPE = 3840, NPO = 2816;
constexpr float EPS = 1e-6f;
constexpr int LDS_CTRL = 155648;
constexpr int LDS_BYTES = 159744;

constexpr size_t SZ_WGU = (size_t)5632 * 1024 * 2, SZ_WD = (size_t)1024 * 2816 * 2;
constexpr size_t WS_WGU = 0;
constexpr size_t WS_WD = WS_WGU + 4 * SZ_WGU;
constexpr size_t WS_EWIN = WS_WD + 4 * SZ_WD;
constexpr size_t WS_OWIN = WS_EWIN + (size_t)NPE * 1024 * 2;
constexpr size_t WS_EWOUT = WS_OWIN + (size_t)NPO * 1024 * 2;
constexpr size_t WS_OWOUT = WS_EWOUT + (size_t)1024 * 1024 * 2;
constexpr size_t WS_MLQK = WS_OWOUT + (size_t)1024 * 1024 * 2;
constexpr size_t WS_ROPE = WS_MLQK + (size_t)1024 * 512 * 2;
constexpr size_t WS_SS = WS_ROPE + (size_t)2 * 4096 * 64 * 4;
constexpr size_t WS_DEN = WS_SS + (size_t)7 * 16 * M * 4;
constexpr size_t WS_EN = WS_DEN + (size_t)M * 4 * 4;
constexpr size_t WS_XB = WS_EN + (size_t)M * 4 * 4;
constexpr size_t WS_OB = WS_XB + (size_t)M * 1024 * 2;
constexpr size_t WS_R = WS_OB + (size_t)M * 1024 * 2;
constexpr size_t WS_QKB = WS_R + (size_t)M * NPO * 2;
constexpr size_t WS_BAR = WS_R + (size_t)M * NPE * 2;
constexpr size_t WS_END = WS_BAR + 16384;

struct Params { const float* in[30]; float* out; unsigned char* ws; int ph_lo, ph_hi; };

__device__ __forceinline__ float bflo(unsigned w) { return __uint_as_float(w << 16); }
__device__ __forceinline__ float bfhi(unsigned w) { return __uint_as_float(w & 0xffff0000u); }
__device__ __forceinline__ float bf2f(bf16_t b) { return __uint_as_float(((unsigned)b) << 16); }
__device__ __forceinline__ bf16_t f2bf(float f) { return (bf16_t)(pg8::cvt_pk_bf16(f, 0.f) & 0xffffu); }
__device__ __forceinline__ float sigmoid_f(float x) { return __builtin_amdgcn_rcpf(1.f + __expf(-x)); }
__device__ __forceinline__ float silu_f(float x) { return x * __builtin_amdgcn_rcpf(1.f + __expf(-x)); }
template <int CTRL> __device__ __forceinline__ float dpp_add(float v) { return v + __int_as_float(__builtin_amdgcn_update_dpp(0, __float_as_int(v), CTRL, 0xF, 0xF, true)); }
__device__ __forceinline__ float reduce8(float o) { o = dpp_add<0xB1>(o); o = dpp_add<0x4E>(o); o = dpp_add<0x141>(o); return o; }
__device__ __forceinline__ float reduce16(float o) { return dpp_add<0x140>(reduce8(o)); }
__device__ __forceinline__ float logsigmoid_f(float z) { return fminf(z, 0.f) - log1pf(__expf(-fabsf(z))); }
__device__ __forceinline__ void unpack8(const u32x4 w, float (&f)[8]) {
    f[0] = bflo(w.x); f[1] = bfhi(w.x); f[2] = bflo(w.y); f[3] = bfhi(w.y); f[4] = bflo(w.z); f[5] = bfhi(w.z); f[6] = bflo(w.w); f[7] = bfhi(w.w);
}
__device__ __forceinline__ u32x4 pack8(const float (&f)[8]) {
    u32x4 w; w.x = pg8::cvt_pk_bf16(f[0], f[1]); w.y = pg8::cvt_pk_bf16(f[2], f[3]); w.z = pg8::cvt_pk_bf16(f[4], f[5]); w.w = pg8::cvt_pk_bf16(f[6], f[7]); return w;
}

__device__ __forceinline__ float row_rs(const float* ssb, int row) {
    const f32x4* q = (const f32x4*)(ssb + (size_t)row * 16);
    const f32x4 a = q[0], b = q[1], c = q[2], d = q[3];
    const float s = ((a[0] + a[1]) + (a[2] + a[3])) + ((b[0] + b[1]) + (b[2] + b[3])) + ((c[0] + c[1]) + (c[2] + c[3])) + ((d[0] + d[1]) + (d[2] + d[3]));
    return rsqrtf(s * (1.0f / 1024.0f) + EPS);
}
__device__ __forceinline__ void panel_rs(const float* ss, LAS float* rsl, int& cur_pm, int pm) {
    if (pm != cur_pm) {
        cur_pm = pm;
        if (threadIdx.x < 256) rsl[threadIdx.x] = row_rs(ss, pm * 256 + (int)threadIdx.x);
        asm volatile("s_waitcnt lgkmcnt(0)" ::: "memory");
        __builtin_amdgcn_s_barrier();
        asm volatile("" ::: "memory");
    }
}
struct EpiSwiGLU {
    static constexpr bool PERM = true, AFTER_DRAIN = false;
    bf16_t* G; const float* ss; LAS float* rsl; mutable int cur_pm;
    __device__ __forceinline__ void operator()(const f32x4 (&acc)[2][2][4][2], const pg8::Unit& u, int wr, int wc, int fr, int fq) const {
        const int row0 = u.pm * 256 + wr * 64 + fr, col0 = u.pn * 128 + wc * 32 + 8 * fq;
        panel_rs(ss, rsl, cur_pm, u.pm);
        float rsv[2][4];
#pragma unroll
        for (int ai = 0; ai < 2; ++ai)
#pragma unroll
            for (int m = 0; m < 4; ++m) rsv[ai][m] = rsl[wr * 64 + fr + ai * 128 + m * 16];
#pragma unroll
        for (int ai = 0; ai < 2; ++ai)
#pragma unroll
            for (int m = 0; m < 4; ++m) {
                const int row = row0 + ai * 128 + m * 16;
                const float rs = rsv[ai][m];
                float o[8];
#pragma unroll
                for (int n = 0; n < 2; ++n)
#pragma unroll
                    for (int j = 0; j < 4; ++j) { const float g = acc[ai][0][m][n][j] * rs, uu = acc[ai][1][m][n][j] * rs; o[n * 4 + j] = silu_f(g) * uu; }
                *(u32x4*)(G + (size_t)row * 2816 + col0) = pack8(o);
            }
    }
};
struct EpiResid {
    static constexpr bool PERM = true, AFTER_DRAIN = false;
    bf16_t* xb; float* ssn; float scale;
    __device__ __forceinline__ void operator()(const f32x4 (&acc)[2][2][4][2], const pg8::Unit& u, int wr, int wc, int fr, int fq) const {
        const int row0 = u.pm * 256 + wr * 64 + fr, col0 = u.pn * 256 + wc * 32 + 8 * fq;
        u32x4 rr[2][4][2];
#pragma unroll
        for (int ai = 0; ai < 2; ++ai)
#pragma unroll
            for (int m = 0; m < 4; ++m)
#pragma unroll
                for (int bj = 0; bj < 2; ++bj) rr[ai][m][bj] = *(const u32x4*)(xb + (size_t)(row0 + ai * 128 + m * 16) * 1024 + col0 + bj * 128);
#pragma unroll
        for (int ai = 0; ai < 2; ++ai)
#pragma unroll
            for (int m = 0; m < 4; ++m) {
                const int row = row0 + ai * 128 + m * 16;
                float part = 0.f;
#pragma unroll
                for (int bj = 0; bj < 2; ++bj) {
                    float r[8], h[8];
                    unpack8(rr[ai][m][bj], r);
#pragma unroll
                    for (int n = 0; n < 2; ++n)
#pragma unroll
                        for (int j = 0; j < 4; ++j) { h[n * 4 + j] = fmaf(acc[ai][bj][m][n][j], scale, r[n * 4 + j]); part = fmaf(h[n * 4 + j], h[n * 4 + j], part); }
                    *(u32x4*)(xb + (size_t)row * 1024 + col0 + bj * 128) = pack8(h);
                }
                part += __shfl_xor(part, 16); part += __shfl_xor(part, 32);
                if (fq == 0) ssn[(size_t)row * 16 + (u.pn * 4 + wc)] = part;
            }
    }
};
struct EpiProj {
    static constexpr bool PERM = true, AFTER_DRAIN = false;
    bf16_t* P; int ld; const float* ss; LAS float* rsl; mutable int cur_pm;
    __device__ __forceinline__ void operator()(const f32x4 (&acc)[2][2][4][2], const pg8::Unit& u, int wr, int wc, int fr, int fq) const {
        const int row0 = u.pm * 256 + wr * 64 + fr, col0 = u.pn * 256 + wc * 32 + 8 * fq;
        if (ss) panel_rs(ss, rsl, cur_pm, u.pm);
        float rsv[2][4];
#pragma unroll
        for (int ai = 0; ai < 2; ++ai)
#pragma unroll
            for (int m = 0; m < 4; ++m) rsv[ai][m] = ss ? rsl[wr * 64 + fr + ai * 128 + m * 16] : 1.0f;
#pragma unroll
        for (int ai = 0; ai < 2; ++ai)
#pragma unroll
            for (int m = 0; m < 4; ++m) {
                const int row = row0 + ai * 128 + m * 16;
                const float rs = rsv[ai][m];
#pragma unroll
                for (int bj = 0; bj < 2; ++bj) {
                    float o[8];
#pragma unroll
                    for (int n = 0; n < 2; ++n)
#pragma unroll
                        for (int j = 0; j < 4; ++j) o[n * 4 + j] = acc[ai][bj][m][n][j] * rs;
                    *(u32x4*)(P + (size_t)row * ld + col0 + bj * 128) = pack8(o);
                }
            }
    }
};
struct GenOrder : pg8::StaticOrder {
    int skip, single;
    __device__ __forceinline__ void init2(int M_, int N_, int G_, int c_, int skip_, int single_) { skip = skip_; single = single_; init(M_, skip_ >= 0 ? N_ - 256 : N_, G_, c_); }
    __device__ __forceinline__ bool next(int i, pg8::Unit& u) const {
        if (single >= 0) { if (i != 0 || c >= nM) return false; u.pm = c; u.pn = single; return true; }
        if (!pg8::StaticOrder::next(i, u)) return false;
        if (skip >= 0 && u.pn >= skip) ++u.pn;
        return true;
    }
};
template <class Epi> __device__ __forceinline__ void run_gemm_ord(ldsp_t lds, const bf16_t* A, const bf16_t* Bt, int N, int K, const Epi& E, int skip, int single, int c) {
    pg8::Gemm g{A, Bt, M, N, K}; GenOrder S; S.init2(M, N, (int)gridDim.x, c, skip, single);
    pg8::gemm_phase<Epi, GenOrder>(lds, g, S, E, nullptr);
}
template <class Epi> __device__ __forceinline__ void run_gemm(ldsp_t lds, const bf16_t* A, const bf16_t* Bt, int N, int K, const Epi& E) {
    pg8::Gemm g{A, Bt, M, N, K}; pg8::StaticOrder S; S.init(M, N, (int)gridDim.x, (int)blockIdx.x);
    pg8::gemm_phase<Epi, pg8::StaticOrder>(lds, g, S, E, nullptr);
}

struct CvtJob { const float* src; const float* scale; bf16_t* dst; int K, N, mode; };
__device__ __forceinline__ void get_job(const Params& p, int j, CvtJob& J) {
    unsigned char* ws = p.ws;
    if (j < 4) { const int l = j >> 1, f = j & 1; J.src = (f ? p.in[6] : p.in[2]) + (size_t)l * 1024 * 5632; J.scale = (f ? p.in[5] : p.in[1]) + l * 1024;
        J.dst = (bf16_t*)(ws + WS_WGU + (size_t)j * SZ_WGU); J.K = 1024; J.N = 5632; J.mode = 1; }
    else if (j < 8) { const int jj = j - 4, l = jj >> 1, f = jj & 1; J.src = (f ? p.in[7] : p.in[3]) + (size_t)l * 2816 * 1024; J.scale = nullptr;
        J.dst = (bf16_t*)(ws + WS_WD + (size_t)jj * SZ_WD); J.K = 2816; J.N = 1024; J.mode = 0; }
    else if (j == 8) { J.src = p.in[8]; J.scale = p.in[4]; J.dst = (bf16_t*)(ws + WS_EWIN); J.K = 1024; J.N = 3600; J.mode = 0; }
    else if (j == 9) { J.src = p.in[13]; J.scale = p.in[4] + 1024; J.dst = (bf16_t*)(ws + WS_OWIN); J.K = 1024; J.N = 2568; J.mode = 0; }
    else if (j == 10) { J.src = p.in[12]; J.scale = nullptr; J.dst = (bf16_t*)(ws + WS_EWOUT); J.K = 1024; J.N = 1024; J.mode = 0; }
    else { J.src = p.in[28]; J.scale = nullptr; J.dst = (bf16_t*)(ws + WS_OWOUT); J.K = 1024; J.N = 1024; J.mode = 0; }
}
__device__ __forceinline__ void cvt_tile_load(const Params& p, int t, int tid, f32x4& v0, f32x4& v1, float& s0, float& s1, bf16_t*& dst) {
    int j, tt;
    if (t < 5632) { j = t / 1408; tt = t % 1408; }
    else if (t < 8448) { j = 4 + (t - 5632) / 704; tt = (t - 5632) % 704; }
    else if (t < 9344) { j = 8; tt = t - 8448; }
    else if (t < 10048) { j = 9; tt = t - 9344; }
    else if (t < 10304) { j = 10; tt = t - 10048; }
    else { j = 11; tt = t - 10304; }
    CvtJob J; get_job(p, j, J);
    const int kbn = J.K >> 6, nb = tt / kbn, kb = tt % kbn;
    const int srccol0 = (J.mode == 1) ? (((nb & 3) < 2) ? 128 * (nb >> 2) + 64 * (nb & 3) : 2816 + 128 * (nb >> 2) + 64 * ((nb & 3) - 2)) : 64 * nb;
    const int r = tid >> 4, col = srccol0 + (tid & 15) * 4, k0 = kb * 64 + r;
    v0 = (f32x4){0.f, 0.f, 0.f, 0.f}; v1 = v0;
    if (col < J.N) { v0 = *(const f32x4*)(J.src + (size_t)k0 * J.N + col); v1 = *(const f32x4*)(J.src + (size_t)(k0 + 32) * J.N + col); }
    s0 = J.scale ? J.scale[k0] : 1.0f; s1 = J.scale ? J.scale[k0 + 32] : 1.0f;
    dst = J.dst + (size_t)(nb * 64 + (tid >> 3)) * J.K + kb * 64 + (tid & 7) * 8;
}
__device__ __forceinline__ void phase_prep(const Params& p, ldsp_t lds) {
    const int tid = threadIdx.x, lane = tid & 63, w = tid >> 6;
    LAS float* tb = (LAS float*)lds;
    {
        f32x4 v0, v1; float s0, s1; bf16_t* dst;
        int t = blockIdx.x;
        if (t < 10560) cvt_tile_load(p, t, tid, v0, v1, s0, s1, dst);
        for (; t < 10560; t += gridDim.x) {
            { const int r = tid >> 4, c4 = (tid & 15) * 4;
              tb[r * 65 + c4 + 0] = v0[0] * s0; tb[r * 65 + c4 + 1] = v0[1] * s0; tb[r * 65 + c4 + 2] = v0[2] * s0; tb[r * 65 + c4 + 3] = v0[3] * s0;
              tb[(r + 32) * 65 + c4 + 0] = v1[0] * s1; tb[(r + 32) * 65 + c4 + 1] = v1[1] * s1; tb[(r + 32) * 65 + c4 + 2] = v1[2] * s1; tb[(r + 32) * 65 + c4 + 3] = v1[3] * s1; }
            __syncthreads();
            bf16_t* const dcur = dst;
            if (t + (int)gridDim.x < 10560) cvt_tile_load(p, t + (int)gridDim.x, tid, v0, v1, s0, s1, dst);
            { const int nl = tid >> 3, kc = (tid & 7) * 8;
              float o[8];
#pragma unroll
              for (int e = 0; e < 8; ++e) o[e] = tb[(kc + e) * 65 + nl];
              *(u32x4*)dcur = pack8(o); }
            __syncthreads();
        }
    }
    {
        const float* x = p.in[0]; bf16_t* XB = (bf16_t*)(p.ws + WS_XB); float* SS = (float*)(p.ws + WS_SS);
        for (int row = blockIdx.x * 8 + w; row < M; row += gridDim.x * 8) {
            const f32x4* xr = (const f32x4*)(x + (size_t)row * 1024);
            float ss = 0.f;
#pragma unroll
            for (int i = 0; i < 4; ++i) {
                const f32x4 v = xr[lane + 64 * i];
                ss += (v[0] * v[0] + v[1] * v[1]) + (v[2] * v[2] + v[3] * v[3]);
                u32x2 pk; pk.x = pg8::cvt_pk_bf16(v[0], v[1]); pk.y = pg8::cvt_pk_bf16(v[2], v[3]);
                *(u32x2*)(XB + (size_t)row * 1024 + (lane + 64 * i) * 4) = pk;
            }
#pragma unroll
            for (int o = 32; o >= 1; o >>= 1) ss += __shfl_xor(ss, o);
            if (lane < 16) SS[(size_t)row * 16 + lane] = (lane == 0) ? ss : 0.f;
        }
    }
    {
        float* rc = (float*)(p.ws + WS_ROPE); float* rsn = rc + 4096 * 64;
        for (int i = blockIdx.x * 512 + tid; i < 4096 * 64; i += gridDim.x * 512) {
            const int pos = i >> 6, j = i & 63;
            const float inv = exp2f(-(float)j * (13.287712379549449f / 64.0f));
            double rev = (double)pos * (double)inv * 0.15915494309189535;
            rev -= rint(rev);
            const float r = (float)(rev * 6.283185307179586);
            rc[i] = cosf(r); rsn[i] = sinf(r);
        }
    }
    {
        bf16_t* W = (bf16_t*)(p.ws + WS_EWIN) + (size_t)3584 * 1024;
        for (int i = blockIdx.x * 512 + tid; i < 256 * 1024; i += gridDim.x * 512) {
            const int c = i >> 10, k = i & 1023;
            const float* wr = p.in[8] + (size_t)k * 3600 + 3584;
            float acc = 0.f;
#pragma unroll
            for (int r = 0; r < 16; ++r) acc = fmaf(wr[r], p.in[9][r * 256 + c], acc);
            W[i] = f2bf(acc * p.in[4][k]);
        }
    }
    {
        bf16_t* W = (bf16_t*)(p.ws + WS_MLQK);
        for (int i = blockIdx.x * 512 + tid; i < 1024 * 512; i += gridDim.x * 512) {
            const int n = i >> 9, k = i & 511, h = (n & 511) >> 7, j = n & 127;
            float v = 0.f;
            if ((k >> 7) == h) v = (n < 512) ? p.in[23][h * 16384 + (k & 127) * 128 + j] : p.in[24][h * 16384 + (k & 127) * 128 + j] * 0.08838834764831845f;
            W[i] = f2bf(v);
        }
    }
}

#define MIX_FMA8(S, ka, kb, vv) do { S[0] = fmaf(ka[0], vv, S[0]); S[1] = fmaf(ka[1], vv, S[1]); S[2] = fmaf(ka[2], vv, S[2]); S[3] = fmaf(ka[3], vv, S[3]); \
    S[4] = fmaf(kb[0], vv, S[4]); S[5] = fmaf(kb[1], vv, S[5]); S[6] = fmaf(kb[2], vv, S[6]); S[7] = fmaf(kb[3], vv, S[7]); } while (0)
#define MIX_DOT8(o, S, qa, qb) do { o = qa[0] * S[0]; o = fmaf(qa[1], S[1], o); o = fmaf(qa[2], S[2], o); o = fmaf(qa[3], S[3], o); \
    o = fmaf(qb[0], S[4], o); o = fmaf(qb[1], S[5], o); o = fmaf(qb[2], S[6], o); o = fmaf(qb[3], S[7], o); } while (0)

typedef short s16x4 __attribute__((ext_vector_type(4)));
__device__ __forceinline__ bf16x8 tr_frag(const LAS bf16_t* T, int LD, int c16, int ks, int lane) {
    const int g = lane >> 4, q = (lane & 15) >> 2, pp = lane & 3;
    const LAS bf16_t* a0 = T + (32 * ks + 8 * g + q) * LD + 16 * c16 + 4 * pp;
    const s16x4 lo = __builtin_amdgcn_ds_read_tr16_b64_v4i16((LAS s16x4*)a0);
    const s16x4 hi = __builtin_amdgcn_ds_read_tr16_b64_v4i16((LAS s16x4*)(a0 + 4 * LD));
    return (bf16x8){lo[0], lo[1], lo[2], lo[3], hi[0], hi[1], hi[2], hi[3]};
}
__device__ __forceinline__ bf16x8 row_frag(const LAS bf16_t* T, int LD, int r16, int kk, int fr, int fq) {
    return *(const LAS bf16x8*)(T + (16 * r16 + fr) * LD + 32 * kk + 8 * fq);
}
__device__ __forceinline__ void st_bf16x4(LAS bf16_t* dst, const f32x4 v) { u32x2 pk; pk.x = pg8::cvt_pk_bf16(v[0], v[1]); pk.y = pg8::cvt_pk_bf16(v[2], v[3]); *(LAS u32x2*)dst = pk; }

template <int CTRL> __device__ __forceinline__ float dpp_mov_old(float oldv, float v) { return __int_as_float(__builtin_amdgcn_update_dpp(__float_as_int(oldv), __float_as_int(v), CTRL, 0xF, 0xF, false)); }
__device__ __forceinline__ float readlane_f(float v, int l) { return __int_as_float(__builtin_amdgcn_readlane(__float_as_int(v), l)); }
__device__ __forceinline__ float wave_scan_add(float x, int lane) {
    x += dpp_mov_old<0x111>(0.f, x); x += dpp_mov_old<0x112>(0.f, x); x += dpp_mov_old<0x114>(0.f, x); x += dpp_mov_old<0x118>(0.f, x);
    const float t0 = readlane_f(x, 15), t1 = readlane_f(x, 31), t2 = readlane_f(x, 47);
    const int row = lane >> 4;
    return x + ((row >= 1 ? t0 : 0.f) + (row >= 2 ? t1 : 0.f) + (row >= 3 ? t2 : 0.f));
}
__device__ __forceinline__ float wave_scan_max(float x, int lane) {
    const float ninf = -__builtin_huge_valf();
    x = fmaxf(x, dpp_mov_old<0x111>(ninf, x)); x = fmaxf(x, dpp_mov_old<0x112>(ninf, x)); x = fmaxf(x, dpp_mov_old<0x114>(ninf, x)); x = fmaxf(x, dpp_mov_old<0x118>(ninf, x));
    const float t0 = readlane_f(x, 15), t1 = readlane_f(x, 31), t2 = readlane_f(x, 47);
    const int row = lane >> 4;
    const float pre = fmaxf(row >= 1 ? t0 : ninf, fmaxf(row >= 2 ? t1 : ninf, row >= 3 ? t2 : ninf));
    return fmaxf(x, pre);
}
__device__ __forceinline__ float logsigmoid_fast(float z) { return fminf(z, 0.f) - __logf(1.0f + __expf(-fabsf(z))); }
template <int DK, int MODE>
__device__ __forceinline__ void mfma_chunk_p(const LAS bf16_t* Qb, const LAS bf16_t* Kb, LAS bf16_t* Pb, LAS float* DP, int w, int lane) {
    constexpr int LD = DK + 8, PLD = 72, KS = DK / 32;
    const int fr = lane & 15, fq = lane >> 4, ts = w & 3;
#pragma unroll
    for (int tt = 0; tt < 2; ++tt) {
        const int tl = 2 * (w >> 2) + tt;
        f32x4 acc = (f32x4){0.f, 0.f, 0.f, 0.f};
        if (ts <= tl) {
#pragma unroll
            for (int kk = 0; kk < KS; ++kk) acc = __builtin_amdgcn_mfma_f32_16x16x32_bf16(row_frag(Kb, LD, ts, kk, fr, fq), row_frag(Qb, LD, tl, kk, fr, fq), acc, 0, 0, 0);
            if (ts == tl) {
#pragma unroll
                for (int r = 0; r < 4; ++r) if (4 * fq + r > fr) acc[r] = 0.f;
            }
        }
        st_bf16x4(Pb + (16 * tl + fr) * PLD + 16 * ts + 4 * fq, acc);
        if (MODE == 2) { float part = (acc[0] + acc[1]) + (acc[2] + acc[3]); part += __shfl_xor(part, 16); part += __shfl_xor(part, 32); if (fq == 0) DP[ts * 64 + 16 * tl + fr] = part; }
    }
}
template <int DK, int MODE>
__device__ __forceinline__ void mfma_chunk_os(const LAS bf16_t* Qb, const LAS bf16_t* Kb, const LAS bf16_t* Vb, LAS bf16_t* STb, const LAS bf16_t* Pb, f32x4 (&Sacc)[DK / 32],
                                              bf16_t* orow, int ldo, int tile, float cs, float qscv, const LAS float* EBE, int w, int lane, int hv) {
    constexpr int LD = DK + 8, PLD = 72, KS = DK / 32, DTH = DK / 32;
    const int fr = lane & 15, fq = lane >> 4, vt = w & 3, hh = w >> 2, vabs = hv * 4 + vt;
    const bf16x8 vt0 = tr_frag(Vb, 136, vabs, 0, lane), vt1 = tr_frag(Vb, 136, vabs, 1, lane);
    bf16x8 st[KS];
#pragma unroll
    for (int kk = 0; kk < KS; ++kk) st[kk] = row_frag(STb + (tile & 1) * 64 * LD, LD, vt, kk, fr, fq);
#pragma unroll
    for (int tt = 0; tt < 2; ++tt) {
        const int tl = 2 * hh + tt;
        f32x4 accP = (f32x4){0.f, 0.f, 0.f, 0.f}, accS = (f32x4){0.f, 0.f, 0.f, 0.f};
        accP = __builtin_amdgcn_mfma_f32_16x16x32_bf16(vt0, *(const LAS bf16x8*)(Pb + (16 * tl + fr) * PLD + 8 * fq), accP, 0, 0, 0);
        accP = __builtin_amdgcn_mfma_f32_16x16x32_bf16(vt1, *(const LAS bf16x8*)(Pb + (16 * tl + fr) * PLD + 32 + 8 * fq), accP, 0, 0, 0);
        if (tile > 0) {
#pragma unroll
            for (int kk = 0; kk < KS; ++kk) accS = __builtin_amdgcn_mfma_f32_16x16x32_bf16(st[kk], row_frag(Qb, LD, tl, kk, fr, fq), accS, 0, 0, 0);
        }
        f32x4 o;
        if (MODE == 2) { const float qs = __shfl(qscv, 16 * tl + fr); o = (accP + accS * cs) * qs; } else o = accP + accS;
        u32x2 pk; pk.x = pg8::cvt_pk_bf16(o[0], o[1]); pk.y = pg8::cvt_pk_bf16(o[2], o[3]);
        *(u32x2*)(orow + (size_t)(tile * 64 + 16 * tl + fr) * ldo) = pk;
    }
#pragma unroll
    for (int i = 0; i < DTH; ++i) {
        const int dt = hh * DTH + i;
        if (MODE == 2) Sacc[i] = Sacc[i] * cs;
        Sacc[i] = __builtin_amdgcn_mfma_f32_16x16x32_bf16(tr_frag(Kb, LD, dt, 0, lane), vt0, Sacc[i], 0, 0, 0);
        Sacc[i] = __builtin_amdgcn_mfma_f32_16x16x32_bf16(tr_frag(Kb, LD, dt, 1, lane), vt1, Sacc[i], 0, 0, 0);
        if (MODE == 1) Sacc[i] = Sacc[i] * *(const LAS f32x4*)(EBE + 16 * dt + 4 * fq);
        if (MODE == 0) Sacc[i] = Sacc[i] * cs;
        st_bf16x4(STb + ((tile + 1) & 1) * 64 * LD + (16 * vt + fr) * LD + 16 * dt + 4 * fq, Sacc[i]);
    }
}

__device__ __forceinline__ void mix_retention_mfma(const Params& p, ldsp_t lds, int item) {
    const int b = item >> 3, h = (item >> 1) & 3, hv = item & 1;
    constexpr int LD = 136, PLD = 72;
    constexpr int TB = 64 * LD;
    LAS bf16_t* Qb = (LAS bf16_t*)lds; LAS bf16_t* Kb = Qb + 2 * TB; LAS bf16_t* Vb = Kb + 2 * TB; LAS bf16_t* STb = Vb + 2 * TB; LAS bf16_t* Pb = STb + 128 * LD;
    const int tid = threadIdx.x, lane = tid & 63, w = __builtin_amdgcn_readfirstlane(tid >> 6), fq = lane >> 4;
    const int sj = tid >> 3, sc = tid & 7;
    bf16_t* P = (bf16_t*)(p.ws + WS_R);
    const float* ropec = (const float*)(p.ws + WS_ROPE); const float* ropes = ropec + 4096 * 64;
    const float l2g = log2f(1.0f - exp2f(-5.0f - (float)h));
    const float gT = exp2f(64.0f * l2g);
    const float dq = exp2f((float)(sj + 1) * l2g), dkk = exp2f(-(float)(sj + 1) * l2g) * 0.08838834764831845f;
    const bf16_t* qrow = P + ((size_t)b * 4096 + sj) * NPE + h * 128 + sc * 8;
    bf16_t* orow = P + ((size_t)b * 4096) * NPE + 1024 + h * 128 + 16 * (hv * 4 + (w & 3)) + 4 * fq;
    f32x4 Sacc[4];
#pragma unroll
    for (int i = 0; i < 4; ++i) Sacc[i] = (f32x4){0.f, 0.f, 0.f, 0.f};
    u32x4 rq1, rq2, rk1, rk2, rv; f32x4 c0, c1, s0, s1;
#define RETM_LOAD(t0) do { const bf16_t* qp_ = qrow + (size_t)(t0) * NPE; rq1 = *(const u32x4*)qp_; rq2 = *(const u32x4*)(qp_ + 64); rk1 = *(const u32x4*)(qp_ + 512); rk2 = *(const u32x4*)(qp_ + 576); \
        rv = *(const u32x4*)(qp_ + 1024 + hv * 64); \
        const float* cp_ = ropec + ((t0) + sj) * 64 + sc * 8; c0 = *(const f32x4*)cp_; c1 = *(const f32x4*)(cp_ + 4); \
        const float* sp_ = ropes + ((t0) + sj) * 64 + sc * 8; s0 = *(const f32x4*)sp_; s1 = *(const f32x4*)(sp_ + 4); } while (0)
#define RETM_STAGE(bi) do { LAS bf16_t* Qd = Qb + (bi) * TB; LAS bf16_t* Kd = Kb + (bi) * TB; LAS bf16_t* Vd = Vb + (bi) * TB; \
            float a[8], bb[8], o1[8], o2[8]; \
            unpack8(rq1, a); unpack8(rq2, bb); \
            _Pragma("unroll") for (int i = 0; i < 4; ++i) { o1[i] = (a[i] * c0[i] - bb[i] * s0[i]) * dq; o2[i] = (a[i] * s0[i] + bb[i] * c0[i]) * dq; \
                                          o1[4 + i] = (a[4 + i] * c1[i] - bb[4 + i] * s1[i]) * dq; o2[4 + i] = (a[4 + i] * s1[i] + bb[4 + i] * c1[i]) * dq; } \
            *(LAS u32x4*)(Qd + sj * LD + sc * 8) = pack8(o1); *(LAS u32x4*)(Qd + sj * LD + 64 + sc * 8) = pack8(o2); \
            unpack8(rk1, a); unpack8(rk2, bb); \
            _Pragma("unroll") for (int i = 0; i < 4; ++i) { o1[i] = (a[i] * c0[i] - bb[i] * s0[i]) * dkk; o2[i] = (a[i] * s0[i] + bb[i] * c0[i]) * dkk; \
                                          o1[4 + i] = (a[4 + i] * c1[i] - bb[4 + i] * s1[i]) * dkk; o2[4 + i] = (a[4 + i] * s1[i] + bb[4 + i] * c1[i]) * dkk; } \
            *(LAS u32x4*)(Kd + sj * LD + sc * 8) = pack8(o1); *(LAS u32x4*)(Kd + sj * LD + 64 + sc * 8) = pack8(o2); \
            *(LAS u32x4*)(Vd + sj * LD + hv * 64 + sc * 8) = rv; } while (0)
    RETM_LOAD(0);
    RETM_STAGE(0);
    __syncthreads();
    RETM_LOAD(64);
    for (int tile = 0; tile < 64; ++tile) {
        const int cur = tile & 1;
        mfma_chunk_p<128, 0>(Qb + cur * TB, Kb + cur * TB, Pb, nullptr, w, lane);
        __syncthreads();
        mfma_chunk_os<128, 0>(Qb + cur * TB, Kb + cur * TB, Vb + cur * TB, STb, Pb, Sacc, orow, NPE, tile, gT, 1.0f, nullptr, w, lane, hv);
        if (tile + 1 < 64) { RETM_STAGE(cur ^ 1); if (tile + 2 < 64) RETM_LOAD((tile + 2) * 64); }
        __syncthreads();
    }
#undef RETM_STAGE
#undef RETM_LOAD
}

template <int ROLE>
__device__ __forceinline__ void mix_mlstm_mfma(const Params& p, ldsp_t lds, int item) {
    const int b = (ROLE == 0) ? (item >> 3) : (item >> 2), h = (ROLE == 0) ? ((item >> 1) & 3) : (item & 3), hv = (ROLE == 0) ? (item & 1) : 0;
    constexpr int LD = 136, PLD = 72;
    LAS bf16_t* Qb = (LAS bf16_t*)lds; LAS bf16_t* Kb = Qb + 64 * LD; LAS bf16_t* Vb = Kb + 64 * LD; LAS bf16_t* STb = Vb + 64 * LD; LAS bf16_t* Pb = STb + 128 * LD;
    LAS float* DP = (LAS float*)(Pb + 64 * PLD); LAS float* NV = DP + 256; LAS float* KS = NV + 128;
    const int tid = threadIdx.x, lane = tid & 63, w = __builtin_amdgcn_readfirstlane(tid >> 6), fq = lane >> 4;
    const int sj = tid >> 3, sc = tid & 7;
    bf16_t* P = (bf16_t*)(p.ws + WS_R); const bf16_t* QKB = (const bf16_t*)(p.ws + WS_QKB);
    float* DEN = (float*)(p.ws + WS_DEN); float* EN = (float*)(p.ws + WS_EN);
    const bf16_t* qrow = QKB + ((size_t)b * 4096 + sj) * 1024 + h * 128 + sc * 8;
    const bf16_t* vrow = P + ((size_t)b * 4096 + sj) * NPO + 1536 + h * 128 + hv * 64 + sc * 8;
    const bf16_t* irow = P + ((size_t)b * 4096 + lane) * NPO + 2560 + h;
    bf16_t* orow = P + ((size_t)b * 4096) * NPO + 1536 + h * 128 + 16 * (hv * 4 + (w & 3)) + 4 * fq;
    const float bi = p.in[25][h], bfv = p.in[26][h];
    float m_prev = 0.f;
    f32x4 Sacc[4];
#pragma unroll
    for (int i = 0; i < 4; ++i) Sacc[i] = (f32x4){0.f, 0.f, 0.f, 0.f};
    if (ROLE == 1 && tid < 128) NV[tid] = 0.f;
    u32x4 rq1, rq2, rk1, rk2, rv1 = (u32x4){0u, 0u, 0u, 0u}; bf16_t ri, rf;
#define MLM_LOAD(t0) do { const bf16_t* qp_ = qrow + (size_t)(t0) * 1024; rq1 = *(const u32x4*)qp_; rq2 = *(const u32x4*)(qp_ + 64); rk1 = *(const u32x4*)(qp_ + 512); rk2 = *(const u32x4*)(qp_ + 576); \
        if (ROLE == 0) { rv1 = *(const u32x4*)(vrow + (size_t)(t0) * NPO); } \
        ri = irow[(size_t)(t0) * NPO]; rf = irow[(size_t)(t0) * NPO + 4]; } while (0)
    MLM_LOAD(0);
    for (int tile = 0; tile < 64; ++tile) {
        float wv, qscv, env, cs;
        {
            const float fi = bf2f(ri) + bi, lf = logsigmoid_f(bf2f(rf) + bfv);
            const float F = wave_scan_add(lf, lane);
            const float g = fi - F;
            const float pm = wave_scan_max(g, lane);
            const float Mj = fmaxf(m_prev, pm);
            const float mu = readlane_f(Mj, 63);
            wv = __expf(g - mu); qscv = __expf(mu - Mj); env = __expf(-(F + Mj)); cs = __expf(m_prev - mu);
            m_prev = readlane_f(F, 63) + mu;
        }
        {
            const float wvs = __shfl(wv, sj);
            float a[8];
            *(LAS u32x4*)(Qb + sj * LD + sc * 8) = rq1; *(LAS u32x4*)(Qb + sj * LD + 64 + sc * 8) = rq2;
            unpack8(rk1, a);
#pragma unroll
            for (int i = 0; i < 8; ++i) a[i] *= wvs;
            *(LAS u32x4*)(Kb + sj * LD + sc * 8) = pack8(a);
            unpack8(rk2, a);
#pragma unroll
            for (int i = 0; i < 8; ++i) a[i] *= wvs;
            *(LAS u32x4*)(Kb + sj * LD + 64 + sc * 8) = pack8(a);
            if (ROLE == 0) { *(LAS u32x4*)(Vb + sj * LD + hv * 64 + sc * 8) = rv1; }
        }
        __syncthreads();
        if (tile + 1 < 64) MLM_LOAD((tile + 1) * 64);
        if (ROLE == 1) {
            const int kd = tid & 127, kp = tid >> 7;
            float ks = 0.f;
#pragma unroll
            for (int s2 = 0; s2 < 16; ++s2) ks += bf2f(Kb[(kp * 16 + s2) * LD + kd]);
            KS[kp * 128 + kd] = ks;
        }
        if (ROLE == 1) mfma_chunk_p<128, 2>(Qb, Kb, Pb, DP, w, lane); else mfma_chunk_p<128, 0>(Qb, Kb, Pb, nullptr, w, lane);
        __syncthreads();
        if (ROLE == 1) {
            const int l = tid >> 3, part = tid & 7;
            float qn = 0.f;
#pragma unroll
            for (int i = 0; i < 2; ++i) { float qv[8]; unpack8(*(const LAS u32x4*)(Qb + l * LD + part * 16 + i * 8), qv);
                const f32x4 n0 = *(const LAS f32x4*)(NV + part * 16 + i * 8), n1 = *(const LAS f32x4*)(NV + part * 16 + i * 8 + 4);
                qn += qv[0] * n0[0] + qv[1] * n0[1] + qv[2] * n0[2] + qv[3] * n0[3] + qv[4] * n1[0] + qv[5] * n1[1] + qv[6] * n1[2] + qv[7] * n1[3]; }
            qn = reduce8(qn);
            const float qs_l = __shfl(qscv, l), en_l = __shfl(env, l);
            if (part == 0) {
                const float dsum = (DP[l] + DP[64 + l]) + (DP[128 + l] + DP[192 + l]);
                const size_t o = ((size_t)b * 4096 + tile * 64 + l) * 4 + h;
                DEN[o] = (dsum + cs * qn) * qs_l; EN[o] = en_l;
            }
        }
        if (ROLE == 0) mfma_chunk_os<128, 2>(Qb, Kb, Vb, STb, Pb, Sacc, orow, NPO, tile, cs, qscv, nullptr, w, lane, hv);
        __syncthreads();
        if (ROLE == 1 && tid < 128) NV[tid] = cs * NV[tid] + ((KS[tid] + KS[128 + tid]) + (KS[256 + tid] + KS[384 + tid]));
    }
#undef MLM_LOAD
}

__device__ __forceinline__ void mix_mlstm_num_db(const Params& p, ldsp_t lds, int item) {
    const int b = item >> 3, h = (item >> 1) & 3, hv = item & 1;
    constexpr int LD = 136, PLD = 72, TB = 64 * LD;
    LAS bf16_t* Qb = (LAS bf16_t*)lds; LAS bf16_t* Kb = Qb + 2 * TB; LAS bf16_t* Vb = Kb + 2 * TB; LAS bf16_t* STb = Vb + 2 * TB; LAS bf16_t* Pb = STb + 128 * LD;
    const int tid = threadIdx.x, lane = tid & 63, w = __builtin_amdgcn_readfirstlane(tid >> 6), fq = lane >> 4;
    const int sj = tid >> 3, sc = tid & 7;
    bf16_t* P = (bf16_t*)(p.ws + WS_R); const bf16_t* QKB = (const bf16_t*)(p.ws + WS_QKB);
    const bf16_t* qrow = QKB + ((size_t)b * 4096 + sj) * 1024 + h * 128 + sc * 8;
    const bf16_t* vrow = P + ((size_t)b * 4096 + sj) * NPO + 1536 + h * 128 + hv * 64 + sc * 8;
    const bf16_t* irow = P + ((size_t)b * 4096 + lane) * NPO + 2560 + h;
    bf16_t* orow = P + ((size_t)b * 4096) * NPO + 1536 + h * 128 + 16 * (hv * 4 + (w & 3)) + 4 * fq;
    const float bi = p.in[25][h], bfv = p.in[26][h];
    float m_prev = 0.f;
    f32x4 Sacc[4];
#pragma unroll
    for (int i = 0; i < 4; ++i) Sacc[i] = (f32x4){0.f, 0.f, 0.f, 0.f};
    u32x4 rq1, rq2, rk1, rk2, rv1; bf16_t ri, rf;
    float qs_n, cs_n;
#define MLN_LOAD(t0) do { const bf16_t* qp_ = qrow + (size_t)(t0) * 1024; rq1 = *(const u32x4*)qp_; rq2 = *(const u32x4*)(qp_ + 64); rk1 = *(const u32x4*)(qp_ + 512); rk2 = *(const u32x4*)(qp_ + 576); \
        rv1 = *(const u32x4*)(vrow + (size_t)(t0) * NPO); ri = irow[(size_t)(t0) * NPO]; rf = irow[(size_t)(t0) * NPO + 4]; } while (0)
#define MLN_STAGE(bi_) do { \
        const float fi = bf2f(ri) + bi, lf = logsigmoid_f(bf2f(rf) + bfv); \
        const float F = wave_scan_add(lf, lane); \
        const float g = fi - F; \
        const float pm = wave_scan_max(g, lane); \
        const float Mj = fmaxf(m_prev, pm); \
        const float mu = readlane_f(Mj, 63); \
        const float wv = __expf(g - mu); qs_n = __expf(mu - Mj); cs_n = __expf(m_prev - mu); \
        m_prev = readlane_f(F, 63) + mu; \
        const float wvs = __shfl(wv, sj); \
        LAS bf16_t* Qd = Qb + (bi_) * TB; LAS bf16_t* Kd = Kb + (bi_) * TB; LAS bf16_t* Vd = Vb + (bi_) * TB; \
        float a[8]; \
        *(LAS u32x4*)(Qd + sj * LD + sc * 8) = rq1; *(LAS u32x4*)(Qd + sj * LD + 64 + sc * 8) = rq2; \
        unpack8(rk1, a); _Pragma("unroll") for (int i = 0; i < 8; ++i) a[i] *= wvs; \
        *(LAS u32x4*)(Kd + sj * LD + sc * 8) = pack8(a); \
        unpack8(rk2, a); _Pragma("unroll") for (int i = 0; i < 8; ++i) a[i] *= wvs; \
        *(LAS u32x4*)(Kd + sj * LD + 64 + sc * 8) = pack8(a); \
        *(LAS u32x4*)(Vd + sj * LD + hv * 64 + sc * 8) = rv1; } while (0)
    MLN_LOAD(0);
    MLN_STAGE(0);
    float qscv = qs_n, cs = cs_n;
    __syncthreads();
    MLN_LOAD(64);
    for (int tile = 0; tile < 64; ++tile) {
        const int cur = tile & 1;
        mfma_chunk_p<128, 0>(Qb + cur * TB, Kb + cur * TB, Pb, nullptr, w, lane);
        __syncthreads();
        mfma_chunk_os<128, 2>(Qb + cur * TB, Kb + cur * TB, Vb + cur * TB, STb, Pb, Sacc, orow, NPO, tile, cs, qscv, nullptr, w, lane, hv);
        if (tile + 1 < 64) { MLN_STAGE(cur ^ 1); if (tile + 2 < 64) MLN_LOAD((tile + 2) * 64); }
        __syncthreads();
        qscv = qs_n; cs = cs_n;
    }
#undef MLN_LOAD
#undef MLN_STAGE
}

__device__ __forceinline__ void mix_mlstm_den(const Params& p, ldsp_t lds, int item) {
    const int b = item >> 2, h = item & 3;
    LAS float* PART = (LAS float*)lds;
    const int tid = threadIdx.x, lane = tid & 63, w = __builtin_amdgcn_readfirstlane(tid >> 6);
    const bf16_t* P = (const bf16_t*)(p.ws + WS_R); const bf16_t* QKB = (const bf16_t*)(p.ws + WS_QKB);
    float* DEN = (float*)(p.ws + WS_DEN); float* EN = (float*)(p.ws + WS_EN);
    const bf16_t* qrow = QKB + ((size_t)b * 4096 + lane) * 1024 + h * 128 + 16 * w;
    const bf16_t* irow = P + ((size_t)b * 4096 + lane) * NPO + 2560 + h;
    const float bi = p.in[25][h], bfv = p.in[26][h];
    float m_prev = 0.f;
    float nst[16];
#pragma unroll
    for (int i = 0; i < 16; ++i) nst[i] = 0.f;
    u32x4 rq1, rq2, rk1, rk2; bf16_t ri, rf;
#define MLD_LOAD(t0) do { const bf16_t* qp_ = qrow + (size_t)(t0) * 1024; rq1 = *(const u32x4*)qp_; rq2 = *(const u32x4*)(qp_ + 8); rk1 = *(const u32x4*)(qp_ + 512); rk2 = *(const u32x4*)(qp_ + 520); \
        ri = irow[(size_t)(t0) * NPO]; rf = irow[(size_t)(t0) * NPO + 4]; } while (0)
    MLD_LOAD(0);
    for (int tile = 0; tile < 64; ++tile) {
        const float fi = bf2f(ri) + bi, lf = logsigmoid_f(bf2f(rf) + bfv);
        const float F = wave_scan_add(lf, lane);
        const float g = fi - F;
        const float pm = wave_scan_max(g, lane);
        const float Mj = fmaxf(m_prev, pm);
        const float mu = readlane_f(Mj, 63);
        const float wv = __expf(g - mu), qscv = __expf(mu - Mj), env = __expf(-(F + Mj)), cs = __expf(m_prev - mu);
        m_prev = readlane_f(F, 63) + mu;
        float q[16], k[16];
        { float t8[8]; unpack8(rq1, t8);
#pragma unroll
          for (int i = 0; i < 8; ++i) q[i] = t8[i];
          unpack8(rq2, t8);
#pragma unroll
          for (int i = 0; i < 8; ++i) q[8 + i] = t8[i];
          unpack8(rk1, t8);
#pragma unroll
          for (int i = 0; i < 8; ++i) k[i] = t8[i];
          unpack8(rk2, t8);
#pragma unroll
          for (int i = 0; i < 8; ++i) k[8 + i] = t8[i]; }
        if (tile + 1 < 64) MLD_LOAD((tile + 1) * 64);
        float part = 0.f;
#pragma unroll
        for (int i = 0; i < 16; ++i) {
            const float c = wave_scan_add(k[i] * wv, lane);
            part = fmaf(q[i], fmaf(cs, nst[i], c), part);
            nst[i] = fmaf(cs, nst[i], readlane_f(c, 63));
        }
        PART[((tile & 1) * 8 + w) * 64 + lane] = part;
        __syncthreads();
        if (w == 0) {
            const LAS float* pp = PART + (tile & 1) * 512 + lane;
            const float d = ((pp[0] + pp[64]) + (pp[128] + pp[192])) + ((pp[256] + pp[320]) + (pp[384] + pp[448]));
            const size_t o = ((size_t)b * 4096 + tile * 64 + lane) * 4 + h;
            DEN[o] = d * qscv; EN[o] = env;
        }
    }
#undef MLD_LOAD
}

__device__ __forceinline__ void mix_gla_mfma(const Params& p, ldsp_t lds, int item) {
    const int b = item >> 3, h = (item >> 1) & 3, hv = item & 1;
    constexpr int LD = 72, PLD = 72;
    constexpr int TQ = 64 * LD, TV = 64 * 136;
    LAS bf16_t* Qb = (LAS bf16_t*)lds; LAS bf16_t* Kb = Qb + 2 * TQ; LAS bf16_t* Vb = Kb + 2 * TQ; LAS bf16_t* STb = Vb + 2 * TV; LAS bf16_t* Pb = STb + 128 * LD;
    LAS float* EBE = (LAS float*)(Pb + 64 * PLD);
    const int tid = threadIdx.x, lane = tid & 63, w = __builtin_amdgcn_readfirstlane(tid >> 6), fq = lane >> 4;
    const int sj = tid >> 3, sc = tid & 7;
    bf16_t* P = (bf16_t*)(p.ws + WS_R);
    float bl[8];
    { const f32x4 b0 = *(const f32x4*)(p.in[10] + h * 64 + 8 * w), b1 = *(const f32x4*)(p.in[10] + h * 64 + 8 * w + 4);
      bl[0] = b0[0]; bl[1] = b0[1]; bl[2] = b0[2]; bl[3] = b0[3]; bl[4] = b1[0]; bl[5] = b1[1]; bl[6] = b1[2]; bl[7] = b1[3]; }
    const bf16_t* trow = P + ((size_t)b * 4096 + lane) * NPE + h * 64 + 8 * w;
    const bf16_t* vrow = P + ((size_t)b * 4096 + sj) * NPE + 2560 + h * 128 + hv * 64 + sc * 8;
    bf16_t* orow = P + ((size_t)b * 4096) * NPE + 2560 + h * 128 + 16 * (hv * 4 + (w & 3)) + 4 * fq;
    f32x4 Sacc[2];
#pragma unroll
    for (int i = 0; i < 2; ++i) Sacc[i] = (f32x4){0.f, 0.f, 0.f, 0.f};
    u32x4 rq, rk, rz, rv1;
#define GLM_LOAD(t0) do { const bf16_t* tp_ = trow + (size_t)(t0) * NPE; rq = *(const u32x4*)(tp_ + 2048); rk = *(const u32x4*)(tp_ + 2304); rz = *(const u32x4*)(tp_ + 3584); \
        rv1 = *(const u32x4*)(vrow + (size_t)(t0) * NPE); } while (0)
#define GLM_STAGE(bi) do { float z[8], q[8], k[8]; \
            unpack8(rz, z); unpack8(rq, q); unpack8(rk, k); \
            _Pragma("unroll") for (int i = 0; i < 8; ++i) { \
                const float la = logsigmoid_fast(z[i] + bl[i]) * (1.0f / 16.0f); \
                const float bs = wave_scan_add(la, lane); \
                const float e = __expf(bs); \
                q[i] *= e; k[i] *= 0.125f * __expf(-bs); \
                if (lane == 63) EBE[(bi) * 64 + 8 * w + i] = e; } \
            *(LAS u32x4*)(Qb + (bi) * TQ + lane * LD + 8 * w) = pack8(q); \
            *(LAS u32x4*)(Kb + (bi) * TQ + lane * LD + 8 * w) = pack8(k); \
            *(LAS u32x4*)(Vb + (bi) * TV + sj * 136 + hv * 64 + sc * 8) = rv1; } while (0)
    GLM_LOAD(0);
    GLM_STAGE(0);
    __syncthreads();
    GLM_LOAD(64);
    for (int tile = 0; tile < 64; ++tile) {
        const int cur = tile & 1;
        mfma_chunk_p<64, 1>(Qb + cur * TQ, Kb + cur * TQ, Pb, nullptr, w, lane);
        __syncthreads();
        mfma_chunk_os<64, 1>(Qb + cur * TQ, Kb + cur * TQ, Vb + cur * TV, STb, Pb, Sacc, orow, NPE, tile, 1.0f, 1.0f, EBE + cur * 64, w, lane, hv);
        if (tile + 1 < 64) { GLM_STAGE(cur ^ 1); if (tile + 2 < 64) GLM_LOAD((tile + 2) * 64); }
        __syncthreads();
    }
#undef GLM_STAGE
#undef GLM_LOAD
}

__device__ __forceinline__ void mix_lru_fused(const Params& p, ldsp_t lds, int item) {
    const int b = item >> 4, g = (item >> 1) & 7, ch = item & 1;
    constexpr int LD = 72;
    LAS bf16_t* Wg = (LAS bf16_t*)lds; LAS bf16_t* XCb = Wg + 64 * LD;
    LAS float* LAs = (LAS float*)(XCb + 64 * LD); LAS float* Us = LAs + 2048; LAS float* AA = Us + 2048; LAS float* BB = AA + 512;
    const int tid = threadIdx.x, lane = tid & 63, w = __builtin_amdgcn_readfirstlane(tid >> 6), fr = lane & 15, fq = lane >> 4;
    const int j = tid & 31, seg = tid >> 5, c = g * 64 + ch * 32 + j;
    const int r_ = tid >> 3, cc = tid & 7, mt = w & 3, q2 = w >> 2;
    const bf16_t* P = (const bf16_t*)(p.ws + WS_R); bf16_t* OB = (bf16_t*)(p.ws + WS_OB);
#pragma unroll
    for (int k = 0; k < 8; ++k) { const int idx = tid + 512 * k, n = idx >> 6, i = idx & 63;
        const float v = (n < 32) ? p.in[16][g * 4096 + i * 64 + ch * 32 + n] : p.in[18][g * 4096 + i * 64 + ch * 32 + (n - 32)];
        Wg[n * LD + i] = f2bf(v); }
    float ba_[4], bx_[4], sp_[4], cw[4][8], cb[8];
#pragma unroll
    for (int r = 0; r < 4; ++r) { const int cch = g * 64 + ch * 32 + 16 * q2 + 4 * fq + r;
        ba_[r] = p.in[17][cch]; bx_[r] = p.in[19][cch]; sp_[r] = 8.0f * log1pf(__expf(-p.in[20][cch])); }
#pragma unroll
    for (int q = 0; q < 4; ++q) { const f32x4 a0 = *(const f32x4*)(p.in[14] + q * 512 + g * 64 + cc * 8), a1 = *(const f32x4*)(p.in[14] + q * 512 + g * 64 + cc * 8 + 4);
        cw[q][0] = a0[0]; cw[q][1] = a0[1]; cw[q][2] = a0[2]; cw[q][3] = a0[3]; cw[q][4] = a1[0]; cw[q][5] = a1[1]; cw[q][6] = a1[2]; cw[q][7] = a1[3]; }
    { const f32x4 a0 = *(const f32x4*)(p.in[15] + g * 64 + cc * 8), a1 = *(const f32x4*)(p.in[15] + g * 64 + cc * 8 + 4);
        cb[0] = a0[0]; cb[1] = a0[1]; cb[2] = a0[2]; cb[3] = a0[3]; cb[4] = a1[0]; cb[5] = a1[1]; cb[6] = a1[2]; cb[7] = a1[3]; }
    const bf16_t* lxp = P + ((size_t)b * 4096 + r_) * NPO + 512 + g * 64 + cc * 8;
    const bf16_t* lyp = P + ((size_t)b * 4096 + seg * 4) * NPO + c;
    bf16_t* obp = OB + ((size_t)b * 4096 + seg * 4) * 1024 + c;
    float hc = 0.f;
    u32x4 rx[4]; bf16_t ry[4];
#define LRF_LOAD(t0) do { _Pragma("unroll") for (int q = 0; q < 4; ++q) { rx[q] = (u32x4){0u, 0u, 0u, 0u}; if ((t0) + r_ - 3 + q >= 0) rx[q] = *(const u32x4*)(lxp + ((long)(t0) - 3 + q) * NPO); } \
        _Pragma("unroll") for (int q = 0; q < 4; ++q) ry[q] = lyp[(size_t)((t0) + q) * NPO]; } while (0)
    LRF_LOAD(0);
    for (int tile = 0; tile < 64; ++tile) {
        float lyv[4];
        {
            float acc[8];
#pragma unroll
            for (int e = 0; e < 8; ++e) acc[e] = cb[e];
#pragma unroll
            for (int q = 0; q < 4; ++q) { float x[8]; unpack8(rx[q], x);
#pragma unroll
                for (int e = 0; e < 8; ++e) acc[e] = fmaf(cw[q][e], x[e], acc[e]); }
            *(LAS u32x4*)(XCb + r_ * LD + cc * 8) = pack8(acc);
#pragma unroll
            for (int q = 0; q < 4; ++q) lyv[q] = bf2f(ry[q]);
        }
        __syncthreads();
        if (tile + 1 < 64) LRF_LOAD((tile + 1) * 64);
        {
            f32x4 accA = (f32x4){0.f, 0.f, 0.f, 0.f}, accX = (f32x4){0.f, 0.f, 0.f, 0.f};
#pragma unroll
            for (int kk = 0; kk < 2; ++kk) { const bf16x8 xf = row_frag(XCb, LD, mt, kk, fr, fq);
                accA = __builtin_amdgcn_mfma_f32_16x16x32_bf16(row_frag(Wg, LD, q2, kk, fr, fq), xf, accA, 0, 0, 0);
                accX = __builtin_amdgcn_mfma_f32_16x16x32_bf16(row_frag(Wg, LD, 2 + q2, kk, fr, fq), xf, accX, 0, 0, 0); }
            const int c0 = 16 * q2 + 4 * fq;
            const u32x2 xw = *(const LAS u32x2*)(XCb + (16 * mt + fr) * LD + ch * 32 + c0);
            const float xc4[4] = {bflo(xw.x), bfhi(xw.x), bflo(xw.y), bfhi(xw.y)};
            f32x4 lav, uv;
#pragma unroll
            for (int r = 0; r < 4; ++r) {
                const float rr = sigmoid_f(accA[r] + ba_[r]), ig = sigmoid_f(accX[r] + bx_[r]);
                const float la = -sp_[r] * rr;
                const float x2 = 2.0f * la;
                const float om = -x2 * fmaf(x2, fmaf(x2, fmaf(x2, fmaf(x2, fmaf(x2, 1.0f / 720.0f, 1.0f / 120.0f), 1.0f / 24.0f), 1.0f / 6.0f), 0.5f), 1.0f);
                lav[r] = la; uv[r] = __builtin_amdgcn_sqrtf(om) * (ig * xc4[r]);
            }
            *(LAS f32x4*)(LAs + (16 * mt + fr) * 32 + c0) = lav; *(LAS f32x4*)(Us + (16 * mt + fr) * 32 + c0) = uv;
        }
        __syncthreads();
        float ap[4], hl[4]; float A = 1.f, hloc = 0.f;
#pragma unroll
        for (int q = 0; q < 4; ++q) { const float a = __expf(LAs[(seg * 4 + q) * 32 + j]); hloc = fmaf(a, hloc, Us[(seg * 4 + q) * 32 + j]); A *= a; ap[q] = A; hl[q] = hloc; }
        AA[seg * 32 + j] = A; BB[seg * 32 + j] = hloc;
        __syncthreads();
        float hin = hc, run = hc;
#pragma unroll
        for (int s2 = 0; s2 < 16; ++s2) { run = fmaf(AA[s2 * 32 + j], run, BB[s2 * 32 + j]); if (s2 < seg) hin = run; }
        hc = run;
#pragma unroll
        for (int q = 0; q < 4; ++q) {
            const float hv = fmaf(ap[q], hin, hl[q]);
            const float y = lyv[q];
            const float u3 = 0.7978845608028654f * (y + 0.044715f * y * y * y);
            const float th = 1.0f - 2.0f * __builtin_amdgcn_rcpf(1.0f + __expf(2.0f * u3));
            obp[(size_t)(tile * 64 + q) * 1024] = f2bf(hv * 0.5f * y * (1.0f + th));
        }
    }
#undef LRF_LOAD
}

__device__ __forceinline__ void phase_qkproj(const Params& p, ldsp_t lds) {
    constexpr int LD = 136;
    LAS bf16_t* MCb = (LAS bf16_t*)lds;
    const bf16_t* MLQK = (const bf16_t*)(p.ws + WS_MLQK); const bf16_t* P = (const bf16_t*)(p.ws + WS_R); bf16_t* QKB = (bf16_t*)(p.ws + WS_QKB);
    const int tid = threadIdx.x, lane = tid & 63, w = __builtin_amdgcn_readfirstlane(tid >> 6), fr = lane & 15, fq = lane >> 4;
    const int tp = tid >> 4, c16 = tid & 15;
    int hcur = -1;
    bf16x8 wf[2][4];
    float cw[4][8], cb[8];
    u32x4 rx[5];
#define QKP_LOAD(job_) do { const int h_ = (job_) & 3, t_ = ((job_) >> 2) * 64 + 2 * tp; const int pos_ = t_ & 4095; \
        _Pragma("unroll") for (int q = 0; q < 5; ++q) { rx[q] = (u32x4){0u, 0u, 0u, 0u}; if (pos_ - 3 + q >= 0) rx[q] = *(const u32x4*)(P + (size_t)(t_ - 3 + q) * NPO + 1024 + h_ * 128 + c16 * 8); } } while (0)
    int job = blockIdx.x;
    if (job < 2048) QKP_LOAD(job);
    for (; job < 2048; job += gridDim.x) {
        const int h = job & 3, tk0 = (job >> 2) * 64;
        if (h != hcur) {
            hcur = h;
#pragma unroll
            for (int q2 = 0; q2 < 2; ++q2) { const int n = 2 * w + q2; const int gr = (n < 8) ? (h * 128 + 16 * n + fr) : (512 + h * 128 + 16 * (n - 8) + fr);
#pragma unroll
                for (int kk = 0; kk < 4; ++kk) wf[q2][kk] = *(const bf16x8*)(MLQK + (size_t)gr * 512 + h * 128 + 32 * kk + 8 * fq); }
#pragma unroll
            for (int q = 0; q < 4; ++q) { const f32x4 a0 = *(const f32x4*)(p.in[21] + q * 512 + h * 128 + c16 * 8), a1 = *(const f32x4*)(p.in[21] + q * 512 + h * 128 + c16 * 8 + 4);
                cw[q][0] = a0[0]; cw[q][1] = a0[1]; cw[q][2] = a0[2]; cw[q][3] = a0[3]; cw[q][4] = a1[0]; cw[q][5] = a1[1]; cw[q][6] = a1[2]; cw[q][7] = a1[3]; }
            { const f32x4 a0 = *(const f32x4*)(p.in[22] + h * 128 + c16 * 8), a1 = *(const f32x4*)(p.in[22] + h * 128 + c16 * 8 + 4);
                cb[0] = a0[0]; cb[1] = a0[1]; cb[2] = a0[2]; cb[3] = a0[3]; cb[4] = a1[0]; cb[5] = a1[1]; cb[6] = a1[2]; cb[7] = a1[3]; }
        }
        {
            float x[5][8];
#pragma unroll
            for (int q = 0; q < 5; ++q) unpack8(rx[q], x[q]);
#pragma unroll
            for (int tt = 0; tt < 2; ++tt) {
                float o[8];
#pragma unroll
                for (int e = 0; e < 8; ++e) o[e] = silu_f(cb[e] + cw[0][e] * x[tt][e] + cw[1][e] * x[tt + 1][e] + cw[2][e] * x[tt + 2][e] + cw[3][e] * x[tt + 3][e]);
                *(LAS u32x4*)(MCb + (2 * tp + tt) * LD + c16 * 8) = pack8(o);
            }
        }
        __syncthreads();
        if (job + (int)gridDim.x < 2048) QKP_LOAD(job + (int)gridDim.x);
#pragma unroll
        for (int m = 0; m < 4; ++m) {
            bf16x8 af[4];
#pragma unroll
            for (int kk = 0; kk < 4; ++kk) af[kk] = row_frag(MCb, LD, m, kk, fr, fq);
#pragma unroll
            for (int q2 = 0; q2 < 2; ++q2) {
                f32x4 acc = (f32x4){0.f, 0.f, 0.f, 0.f};
#pragma unroll
                for (int kk = 0; kk < 4; ++kk) acc = __builtin_amdgcn_mfma_f32_16x16x32_bf16(wf[q2][kk], af[kk], acc, 0, 0, 0);
                const int n = 2 * w + q2;
                const int dstcol = (n < 8) ? (h * 128 + 16 * n + 4 * fq) : (512 + h * 128 + 16 * (n - 8) + 4 * fq);
                u32x2 pk; pk.x = pg8::cvt_pk_bf16(acc[0], acc[1]); pk.y = pg8::cvt_pk_bf16(acc[2], acc[3]);
                *(u32x2*)(QKB + (size_t)(tk0 + 16 * m + fr) * 1024 + dstcol) = pk;
            }
        }
        __syncthreads();
    }
#undef QKP_LOAD
}

__device__ __forceinline__ void phase_fin_even(const Params& p) {
    const bf16_t* P = (const bf16_t*)(p.ws + WS_R); bf16_t* OB = (bf16_t*)(p.ws + WS_OB); const float* hw = p.in[11];
    const int tid = threadIdx.x, lane = tid & 63, w = tid >> 6, hh = lane >> 4, l16 = lane & 15;
    for (int idx = blockIdx.x * 8 + w; idx < 2 * M; idx += gridDim.x * 8) {
        const int t = idx >> 1, grp = idx & 1;
        const bf16_t* row = P + (size_t)t * NPE;
        const int ocol = (grp ? 2560 : 1024) + hh * 128 + l16 * 8, gcol = (grp ? 3072 : 1536) + hh * 128 + l16 * 8;
        float o[8], g[8];
        unpack8(*(const u32x4*)(row + ocol), o); unpack8(*(const u32x4*)(row + gcol), g);
        float ss = 0.f;
#pragma unroll
        for (int i = 0; i < 8; ++i) ss = fmaf(o[i], o[i], ss);
        ss = reduce16(ss);
        const float rs = rsqrtf(ss * (1.0f / 128.0f) + EPS);
        const int oc = grp * 512 + hh * 128 + l16 * 8;
        const f32x4 w0 = *(const f32x4*)(hw + oc), w1 = *(const f32x4*)(hw + oc + 4);
        float y[8];
#pragma unroll
        for (int i = 0; i < 8; ++i) y[i] = o[i] * rs * silu_f(g[i]) * (i < 4 ? w0[i & 3] : w1[i & 3]);
        *(u32x4*)(OB + (size_t)t * 1024 + oc) = pack8(y);
    }
}
__device__ __forceinline__ void phase_fin_odd(const Params& p) {
    const bf16_t* P = (const bf16_t*)(p.ws + WS_R); bf16_t* OB = (bf16_t*)(p.ws + WS_OB); const float* nw = p.in[27];
    const float* DEN = (const float*)(p.ws + WS_DEN); const float* EN = (const float*)(p.ws + WS_EN);
    const int tid = threadIdx.x, lane = tid & 63, w = tid >> 6, hh = lane >> 4, l16 = lane & 15;
    for (int t = blockIdx.x * 8 + w; t < M; t += gridDim.x * 8) {
        const bf16_t* row = P + (size_t)t * NPO;
        float nu[8], g[8];
        unpack8(*(const u32x4*)(row + 1536 + hh * 128 + l16 * 8), nu); unpack8(*(const u32x4*)(row + 2048 + hh * 128 + l16 * 8), g);
        const float den = DEN[(size_t)t * 4 + hh], en = EN[(size_t)t * 4 + hh];
        const float inv = __builtin_amdgcn_rcpf(fmaxf(fabsf(den), en));
        float hm[8]; float ss = 0.f;
#pragma unroll
        for (int i = 0; i < 8; ++i) { hm[i] = sigmoid_f(g[i]) * nu[i] * inv; ss = fmaf(hm[i], hm[i], ss); }
        ss = reduce16(ss);
        const float rs = rsqrtf(ss * (1.0f / 128.0f) + EPS);
        const int oc = hh * 128 + l16 * 8;
        const f32x4 w0 = *(const f32x4*)(nw + oc), w1 = *(const f32x4*)(nw + oc + 4);
        float y[8];
#pragma unroll
        for (int i = 0; i < 8; ++i) { y[i] = hm[i] * rs * (i < 4 ? w0[i & 3] : w1[i & 3]); }
        *(u32x4*)(OB + (size_t)t * 1024 + 512 + oc) = pack8(y);
    }
}
__device__ __forceinline__ void phase_final(const Params& p) {
    float* out = p.out; const bf16_t* XB = (const bf16_t*)(p.ws + WS_XB); const float* SS = (const float*)(p.ws + WS_SS) + (size_t)6 * 16 * M; const float* fw = p.in[29];
    const int tid = threadIdx.x, lane = tid & 63, w = tid >> 6;
    for (int row = blockIdx.x * 8 + w; row < M; row += gridDim.x * 8) {
        const float rs = row_rs(SS, row);
#pragma unroll
        for (int i = 0; i < 2; ++i) {
            float h[8]; unpack8(*(const u32x4*)(XB + (size_t)row * 1024 + (lane + 64 * i) * 8), h);
            const f32x4 w0 = *(const f32x4*)(fw + (lane + 64 * i) * 8), w1 = *(const f32x4*)(fw + (lane + 64 * i) * 8 + 4);
            f32x4 o0, o1;
            o0[0] = h[0] * rs * w0[0]; o0[1] = h[1] * rs * w0[1]; o0[2] = h[2] * rs * w0[2]; o0[3] = h[3] * rs * w0[3];
            o1[0] = h[4] * rs * w1[0]; o1[1] = h[5] * rs * w1[1]; o1[2] = h[6] * rs * w1[2]; o1[3] = h[7] * rs * w1[3];
            *(f32x4*)(out + (size_t)row * 1024 + (lane + 64 * i) * 8) = o0; *(f32x4*)(out + (size_t)row * 1024 + (lane + 64 * i) * 8 + 4) = o1;
        }
    }
}

__host__ __device__ inline bool phase_active(int ph) { return !(ph == 4 || ph == 5 || ph == 15); }
constexpr int N_PHASES = 22;
__device__ __forceinline__ void load_params(Params& q, ldsp_t lds) {
    const LAS unsigned* tab = (const LAS unsigned*)(lds + LDS_CTRL);
#pragma unroll
    for (int k = 0; k < 32; ++k) {
        const unsigned lo = __builtin_amdgcn_readfirstlane(tab[2 * k]), hi = __builtin_amdgcn_readfirstlane(tab[2 * k + 1]);
        const unsigned long long v = ((unsigned long long)hi << 32) | lo;
        if (k < 30) q.in[k] = (const float*)(const __attribute__((address_space(1))) float*)v; else if (k == 30) q.out = (float*)(__attribute__((address_space(1))) float*)v; else q.ws = (unsigned char*)(__attribute__((address_space(1))) unsigned char*)v;
    }
}
#define PHASE_BEGIN(k) if (lo <= (k) && (k) < hi) { asm volatile("" ::: "memory"); Params p; load_params(p, lds); unsigned char* ws = p.ws; (void)ws;
#define PHASE_END(k) if ((k) + 1 < hi) { xcd_barrier(xb); } }
template <int L> __device__ __forceinline__ void layer_phases(ldsp_t lds, cg::grid_group& grid, XcdBarrier& xb, const int lo, const int hi) {
    constexpr int B0 = 1 + 10 * L;
    PHASE_BEGIN(B0 + 0)
        { EpiSwiGLU E{(bf16_t*)(ws + WS_R), (const float*)(ws + WS_SS) + (size_t)(3 * L + 0) * 16 * M, (LAS float*)(lds + LDS_CTRL + 512), -1};
        run_gemm<EpiSwiGLU>(lds, (const bf16_t*)(ws + WS_XB), (const bf16_t*)(ws + WS_WGU + (size_t)(L * 2 + 0) * SZ_WGU), 5632, 1024, E); }
    PHASE_END(B0 + 0)
    PHASE_BEGIN(B0 + 1)
        { EpiResid E{(bf16_t*)(ws + WS_XB), (float*)(ws + WS_SS) + (size_t)(3 * L + 1) * 16 * M, 0.5f};
        run_gemm<EpiResid>(lds, (const bf16_t*)(ws + WS_R), (const bf16_t*)(ws + WS_WD + (size_t)(L * 2 + 0) * SZ_WD), 1024, 2816, E); }
    PHASE_END(B0 + 1)
    PHASE_BEGIN(B0 + 2)
        { EpiProj E{(bf16_t*)(ws + WS_R), L ? NPO : NPE, (const float*)(ws + WS_SS) + (size_t)(3 * L + 1) * 16 * M, (LAS float*)(lds + LDS_CTRL + 512), -1};
        run_gemm_ord<EpiProj>(lds, (const bf16_t*)(ws + WS_XB), (const bf16_t*)(ws + (L ? WS_OWIN : WS_EWIN)), L ? NPO : NPE, 1024, E, (L == 0 && gridDim.x == 256) ? 13 : -1, -1, (int)blockIdx.x); }
    PHASE_END(B0 + 2)
    if (L == 1) {
        PHASE_BEGIN(B0 + 3)
            phase_qkproj(p, lds);
        PHASE_END(B0 + 3)
    }
    PHASE_BEGIN(B0 + 5)
        if (L == 0) {
            for (int it = blockIdx.x; it < 128; it += gridDim.x) { if (it < 64) mix_retention_mfma(p, lds, it); else mix_gla_mfma(p, lds, it - 64); __syncthreads(); }
            if (gridDim.x == 256 && blockIdx.x >= 128) {
                EpiProj E{(bf16_t*)(ws + WS_R), NPE, (const float*)(ws + WS_SS) + (size_t)1 * 16 * M, (LAS float*)(lds + LDS_CTRL + 512), -1};
                run_gemm_ord<EpiProj>(lds, (const bf16_t*)(ws + WS_XB), (const bf16_t*)(ws + WS_EWIN), NPE, 1024, E, -1, 13, (int)blockIdx.x - 128);
            }
        } else {
            for (int it = blockIdx.x; it < 224; it += gridDim.x) { if (it < 64) mix_mlstm_num_db(p, lds, it); else if (it < 96) mix_mlstm_den(p, lds, it - 64); else mix_lru_fused(p, lds, it - 96); __syncthreads(); }
        }
    PHASE_END(B0 + 5)
    PHASE_BEGIN(B0 + 6)
        { if (L == 0) phase_fin_even(p); else phase_fin_odd(p); }
    PHASE_END(B0 + 6)
    PHASE_BEGIN(B0 + 7)
        { EpiResid E{(bf16_t*)(ws + WS_XB), (float*)(ws + WS_SS) + (size_t)(3 * L + 2) * 16 * M, 1.0f};
        run_gemm<EpiResid>(lds, (const bf16_t*)(ws + WS_OB), (const bf16_t*)(ws + (L ? WS_OWOUT : WS_EWOUT)), 1024, 1024, E); }
    PHASE_END(B0 + 7)
    PHASE_BEGIN(B0 + 8)
        { EpiSwiGLU E{(bf16_t*)(ws + WS_R), (const float*)(ws + WS_SS) + (size_t)(3 * L + 2) * 16 * M, (LAS float*)(lds + LDS_CTRL + 512), -1};
        run_gemm<EpiSwiGLU>(lds, (const bf16_t*)(ws + WS_XB), (const bf16_t*)(ws + WS_WGU + (size_t)(L * 2 + 1) * SZ_WGU), 5632, 1024, E); }
    PHASE_END(B0 + 8)
    PHASE_BEGIN(B0 + 9)
        { EpiResid E{(bf16_t*)(ws + WS_XB), (float*)(ws + WS_SS) + (size_t)(3 * L + 3) * 16 * M, 0.5f};
        run_gemm<EpiResid>(lds, (const bf16_t*)(ws + WS_R), (const bf16_t*)(ws + WS_WD + (size_t)(L * 2 + 1) * SZ_WD), 1024, 2816, E); }
    PHASE_END(B0 + 9)
}
__global__ void __launch_bounds__(512, 2) mega(Params p0) {
    extern __shared__ __attribute__((aligned(16))) unsigned char ldsraw[];
    ldsp_t lds = (ldsp_t)ldsraw;
    cg::grid_group grid = cg::this_grid();
    if (threadIdx.x == 0) {
        LAS unsigned long long* tab = (LAS unsigned long long*)(lds + LDS_CTRL);
#pragma unroll
        for (int k = 0; k < 30; ++k) tab[k] = (unsigned long long)p0.in[k];
        tab[30] = (unsigned long long)p0.out; tab[31] = (unsigned long long)p0.ws;
        LAS unsigned* st = (LAS unsigned*)(lds + LDS_CTRL + 256); st[0] = 0u; st[1] = 0u; st[2] = 0u; st[3] = 0u;
    }
    __syncthreads();
    const int lo = p0.ph_lo, hi = p0.ph_hi;
    if (hi > 1000) grid.sync();
    XcdBarrier xb; xb.bar = nullptr; xb.x = 0u; xb.st = nullptr;
    if (hi - lo > 1) xb = xcd_barrier_post((unsigned*)(p0.ws + WS_BAR), (volatile LAS unsigned*)(lds + LDS_CTRL + 256));
    PHASE_BEGIN(0)
        phase_prep(p, lds);
    PHASE_END(0)
    layer_phases<0>(lds, grid, xb, lo, hi);
    layer_phases<1>(lds, grid, xb, lo, hi);
    PHASE_BEGIN(21)
        phase_final(p);
    PHASE_END(21)
}

extern "C" void kernel_launch(void* const* d_in, const int* in_sizes, int n_in, void* d_out, int out_size, void* d_ws, size_t ws_size, hipStream_t stream) {
    static int grid = 0;
    if (grid == 0) {
        if (n_in != 30 || out_size != M * 1024 || ws_size < WS_END) { fprintf(stderr, "kernel_launch: unexpected problem (n_in %d out %d ws %zu need %zu)\n", n_in, out_size, ws_size, (size_t)WS_END); grid = -1; return; }
        int dev = 0, cus = 0, per_cu = 0;
        hipGetDevice(&dev); hipDeviceGetAttribute(&cus, hipDeviceAttributeMultiprocessorCount, dev);
        if (hipFuncSetAttribute((const void*)mega, hipFuncAttributeMaxDynamicSharedMemorySize, LDS_BYTES) != hipSuccess) { fprintf(stderr, "kernel_launch: hipFuncSetAttribute failed\n"); }
        if (hipOccupancyMaxActiveBlocksPerMultiprocessor(&per_cu, (const void*)mega, 512, LDS_BYTES) != hipSuccess || per_cu < 1) { fprintf(stderr, "kernel_launch: occupancy query says %d\n", per_cu); per_cu = 1; }
        (void)hipGetLastError();
        grid = cus * per_cu; if (grid > 256) grid = 256; if (grid < 1) grid = 256;
    }
    if (grid < 0) return;
    Params p{};
    for (int i = 0; i < 30; ++i) p.in[i] = (const float*)d_in[i];
    p.out = (float*)d_out; p.ws = (unsigned char*)d_ws;
#if MK_N_LAUNCHES == 1
    p.ph_lo = 0; p.ph_hi = N_PHASES;
    if (hipMemsetAsync((unsigned char*)d_ws + WS_BAR, 0, 16384, stream) != hipSuccess) { fprintf(stderr, "kernel_launch: hipMemsetAsync of the barrier words failed\n"); return; }
    void* args[] = {&p};
    hipError_t e = hipLaunchCooperativeKernel((const void*)mega, dim3(grid), dim3(512), args, LDS_BYTES, stream);
    if (e != hipSuccess) fprintf(stderr, "kernel_launch: cooperative launch failed: %s (grid %d)\n", hipGetErrorString(e), grid);
#else
    for (int ph = 0; ph < N_PHASES; ++ph) {
        if (!phase_active(ph)) continue;
        p.ph_lo = ph; p.ph_hi = ph + 1;
        hipLaunchKernelGGL(mega, dim3(grid), dim3(512), LDS_BYTES, stream, p);
    }
#endif
}
```
